# Optimizing an MI355X kernel written in HIP

```python
import jax
import jax.numpy as jnp
from jax import lax
import numpy as np

D_MODEL = 1024
BATCH = 16
SEQ = 4096
DEPTH = 2

CTX_LEN = 256
GRID_W = 64
HEAD_DIM = 64
A_HEADS = 8
A_KV_HEADS = 2
A_GROUP = A_HEADS // A_KV_HEADS
B_HEADS = 4
B_Q_RANK = 192
B_KV_RANK = 128
B_NOPE = 64
B_ROPE = 32
B_V = 64
C_HEADS = 4
C_DK = 64
C_DV = 64
D_FF = 4 * D_MODEL
A_OUT = A_HEADS * HEAD_DIM
B_OUT = B_HEADS * B_V
C_OUT = C_HEADS * C_DV
D_MIX = A_OUT + B_OUT + C_OUT
IN_SIZES = (A_HEADS * HEAD_DIM, A_KV_HEADS * HEAD_DIM, A_KV_HEADS * HEAD_DIM,
            B_Q_RANK, B_KV_RANK, B_ROPE,
            C_HEADS * C_DK, C_HEADS * C_DK, C_HEADS * C_DK, C_HEADS * C_DV, C_HEADS * C_DV)
D_IN = sum(IN_SIZES)
SPLIT_AT = tuple(int(v) for v in np.cumsum(IN_SIZES)[:-1])
Q_BLOCK = 128
SCAN_CHUNK = 64
ROPE_THETA = 10000.0
EPS = 1e-6
F_TINY = 1e-30
F32 = jnp.float32

kernel_name = 'hybrid_parallel_heads_dit_block'


def rms_norm(x, gain):
    xf = x.astype(F32)
    y = xf * lax.rsqrt(jnp.mean(xf * xf, axis=-1, keepdims=True) + EPS)
    return (y * gain.astype(F32)).astype(x.dtype)


def modulate(h, shift, scale):
    return h * (1 + scale) + shift


def axial_rope(row_ids, col_ids, rot_dim):
    n_freq = rot_dim // 4
    inv = ROPE_THETA ** (-jnp.arange(n_freq, dtype=F32) / n_freq)
    ang = jnp.concatenate([row_ids.astype(F32)[:, None] * inv, col_ids.astype(F32)[:, None] * inv], axis=-1)
    return jnp.cos(ang)[:, None, :], jnp.sin(ang)[:, None, :]


def apply_rope(x, rope):
    cos, sin = rope
    xf = x.astype(F32)
    x1, x2 = jnp.split(xf, 2, axis=-1)
    return jnp.concatenate([x1 * cos - x2 * sin, x2 * cos + x1 * sin], axis=-1).astype(x.dtype)


def forget_gate(z, lb):
    zf = z.astype(F32)
    f = lb + (1.0 - lb) * jax.nn.sigmoid(zf)
    log_f = jnp.log(jnp.maximum(f, F_TINY))
    k = (1.0 - lb) * jax.nn.sigmoid(-zf)
    return log_f, k.astype(z.dtype)


def block_attention(q, k, v, scale):
    bsz, t = q.shape[:2]
    nb = t // Q_BLOCK
    qb = jnp.moveaxis(q.reshape(bsz, nb, Q_BLOCK, *q.shape[2:]), 1, 0)

    def one_block(qi):
        s = jnp.einsum('bqhgd,bkhd->bhgqk', qi, k, preferred_element_type=F32) * scale
        p = jax.nn.softmax(s, axis=-1).astype(v.dtype)
        return jnp.einsum('bhgqk,bkhv->bqhgv', p, v)

    out = lax.map(one_block, qb)
    return jnp.moveaxis(out, 0, 1).reshape(bsz, t, *out.shape[3:])


def gla_chunk_scan(q, k, v, g, s0):
    bsz, n_tok, n_h, dk = q.shape
    dv = v.shape[-1]
    n_chunk = n_tok // SCAN_CHUNK

    def to_chunks(a):
        return a.astype(F32).reshape(bsz, n_chunk, SCAN_CHUNK, n_h, a.shape[-1]).transpose(1, 0, 3, 2, 4)

    lower_tri = jnp.tril(jnp.ones((SCAN_CHUNK, SCAN_CHUNK), dtype=bool))[:, :, None]

    def step(state, inp):
        q_, k_, v_, g_ = inp
        b = jnp.cumsum(g_, axis=-2)
        diff = b[..., :, None, :] - b[..., None, :, :]
        decay = jnp.where(lower_tri, jnp.exp(jnp.where(lower_tri, diff, 0.0)), 0.0)
        scores = jnp.einsum('bhtd,bhsd,bhtsd->bhts', q_, k_, decay)
        o = jnp.einsum('bhts,bhsv->bhtv', scores, v_) + jnp.einsum('bhtd,bhdv->bhtv', q_ * jnp.exp(b), state)
        b_last = b[..., -1:, :]
        new_state = state * jnp.exp(b_last[..., 0, :])[..., None] + jnp.einsum('bhsd,bhsv->bhdv', k_ * jnp.exp(b_last - b), v_)
        return new_state, o

    s_fin, o = lax.scan(step, s0, (to_chunks(q), to_chunks(k), to_chunks(v), to_chunks(g)))
    o = o.transpose(1, 0, 3, 2, 4).reshape(bsz, n_tok, n_h, dv)
    return o.astype(v.dtype), s_fin


def mixer_features(h, w_in, a_q_norm, a_k_norm, b_q_norm, w_q_up, b_kv_norm, w_kv_up, lb, rope_a, rope_b):
    bsz, t, _ = h.shape
    aq, ak, av, bqd, bkvd, bkr, cq, cff, cfb, ci, cg = jnp.split(h @ w_in, SPLIT_AT, axis=-1)
    aq = rms_norm(aq.reshape(bsz, t, A_HEADS, HEAD_DIM), a_q_norm)
    ak = rms_norm(ak.reshape(bsz, t, A_KV_HEADS, HEAD_DIM), a_k_norm)
    av = av.reshape(bsz, t, A_KV_HEADS, HEAD_DIM)
    bq = (rms_norm(bqd, b_q_norm) @ w_q_up).reshape(bsz, t, B_HEADS, B_NOPE + B_ROPE)
    bkv = (rms_norm(bkvd, b_kv_norm) @ w_kv_up).reshape(bsz, t, B_HEADS, B_NOPE + B_V)
    bq_nope, bq_pe = jnp.split(bq, [B_NOPE], axis=-1)
    bk_nope, bv = jnp.split(bkv, [B_NOPE], axis=-1)
    bk_pe = bkr[:, :, None, :]
    if rope_a is not None:
        aq = apply_rope(aq, rope_a)
        ak = apply_rope(ak, rope_a)
        bq_pe = apply_rope(bq_pe, rope_b)
        bk_pe = apply_rope(bk_pe, rope_b)
    bq = jnp.concatenate([bq_nope, bq_pe], axis=-1)
    bk = jnp.concatenate([bk_nope, jnp.broadcast_to(bk_pe, (bsz, t, B_HEADS, B_ROPE))], axis=-1)
    heads = lambda a: a.reshape(bsz, t, C_HEADS, -1)
    g_f, k_f = forget_gate(cff, lb[0])
    g_b, k_b = forget_gate(cfb, lb[1])
    return {'aq': aq, 'ak': ak, 'av': av, 'bq': bq, 'bk': bk, 'bv': bv,
            'cq': heads(jax.nn.silu(cq)), 'cv': heads(ci), 'cgate': heads(cg),
            'ck_f': heads(k_f), 'cg_f': heads(g_f), 'ck_b': heads(k_b), 'cg_b': heads(g_b)}


def attention_groups(fq, fkv_list):
    bsz, t = fq['aq'].shape[:2]
    cat = lambda name: jnp.concatenate([f[name] for f in fkv_list], axis=1)
    ya = block_attention(fq['aq'].reshape(bsz, t, A_KV_HEADS, A_GROUP, HEAD_DIM), cat('ak'), cat('av'), HEAD_DIM ** -0.5)
    yb = block_attention(fq['bq'][:, :, :, None, :], cat('bk'), cat('bv'), (B_NOPE + B_ROPE) ** -0.5)
    return ya.reshape(bsz, t, A_OUT), yb.reshape(bsz, t, B_OUT)


def hgrn2_bidirectional(fl, fc, out_norm, need_ctx_out):
    bsz = fl['cq'].shape[0]
    zero = jnp.zeros((bsz, C_HEADS, C_DK, C_DV), F32)
    rev = lambda a: jnp.flip(a, axis=1)
    oc_f, s_f = gla_chunk_scan(fc['cq'], fc['ck_f'], fc['cv'], fc['cg_f'], zero)
    oc_b, s_b = gla_chunk_scan(rev(fc['cq']), rev(fc['ck_b']), rev(fc['cv']), rev(fc['cg_b']), zero)
    ol_f, _ = gla_chunk_scan(fl['cq'], fl['ck_f'], fl['cv'], fl['cg_f'], s_f)
    ol_b, _ = gla_chunk_scan(rev(fl['cq']), rev(fl['ck_b']), rev(fl['cv']), rev(fl['cg_b']), s_b)

    def readout(o, gate):
        y = rms_norm(o, out_norm) * jax.nn.silu(gate)
        return y.reshape(*y.shape[:2], C_OUT)

    y_lat = readout(ol_f + rev(ol_b), fl['cgate'])
    y_ctx = readout(oc_f + rev(oc_b), fc['cgate']) if need_ctx_out else None
    return y_lat, y_ctx


def sq_relu_mlp(h, w1, w2):
    return jnp.square(jax.nn.relu(h @ w1)) @ w2


def setup_inputs(seed: int = 0) -> dict:
    key = jax.random.key(seed)
    ks = jax.random.split(key, 24)
    nrm = lambda k, shape, scale: jax.random.normal(k, shape, F32) * scale
    gain = lambda k, shape: 1.0 + 0.05 * jax.random.normal(k, shape, F32)
    return {
        'x': nrm(ks[0], (BATCH, SEQ, D_MODEL), 1.0),
        'c': nrm(ks[1], (BATCH, D_MODEL), 1.0),
        'ctx': nrm(ks[2], (BATCH, CTX_LEN, D_MODEL), 1.0),
        'c_ctx': nrm(ks[3], (D_MODEL,), 1.0),
        'w_ada': nrm(ks[4], (DEPTH, D_MODEL, 6 * D_MODEL), 0.5 * D_MODEL ** -0.5),
        'b_ada': nrm(ks[5], (DEPTH, 6 * D_MODEL), 0.02),
        'g_pre_mix': gain(ks[6], (DEPTH, D_MODEL)),
        'g_post_mix': gain(ks[7], (DEPTH, D_MODEL)),
        'g_pre_ffn': gain(ks[8], (DEPTH, D_MODEL)),
        'g_post_ffn': gain(ks[9], (DEPTH, D_MODEL)),
        'w_in': nrm(ks[10], (DEPTH, D_MODEL, D_IN), D_MODEL ** -0.5),
        'a_q_norm': gain(ks[11], (DEPTH, HEAD_DIM)),
        'a_k_norm': gain(ks[12], (DEPTH, HEAD_DIM)),
        'b_q_norm': gain(ks[13], (DEPTH, B_Q_RANK)),
        'w_q_up': nrm(ks[14], (DEPTH, B_Q_RANK, B_HEADS * (B_NOPE + B_ROPE)), B_Q_RANK ** -0.5),
        'b_kv_norm': gain(ks[15], (DEPTH, B_KV_RANK)),
        'w_kv_up': nrm(ks[16], (DEPTH, B_KV_RANK, B_HEADS * (B_NOPE + B_V)), B_KV_RANK ** -0.5),
        'c_lower_bounds': nrm(ks[17], (DEPTH, 2, C_HEADS * C_DK), 0.5),
        'c_out_norm': gain(ks[18], (DEPTH, C_DV)),
        'w_out': nrm(ks[19], (DEPTH, D_MIX, D_MODEL), D_MIX ** -0.5),
        'w_ff1': nrm(ks[20], (DEPTH, D_MODEL, D_FF), D_MODEL ** -0.5),
        'w_ff2': nrm(ks[21], (DEPTH, D_FF, D_MODEL), D_FF ** -0.5),
    }


def reference(x, c, ctx, c_ctx, w_ada, b_ada, g_pre_mix, g_post_mix, g_pre_ffn, g_post_ffn,
              w_in, a_q_norm, a_k_norm, b_q_norm, w_q_up, b_kv_norm, w_kv_up,
              c_lower_bounds, c_out_norm, w_out, w_ff1, w_ff2):
    n_lat = x.shape[1]
    rows = n_lat // GRID_W
    row_ids = jnp.repeat(jnp.arange(rows, dtype=jnp.int32), GRID_W)
    col_ids = jnp.tile(jnp.arange(GRID_W, dtype=jnp.int32), rows)
    rope_a = axial_rope(row_ids, col_ids, HEAD_DIM)
    rope_b = axial_rope(row_ids, col_ids, B_ROPE)
    p_lb = jax.nn.softmax(c_lower_bounds.astype(F32), axis=0)
    lower = jnp.cumsum(p_lb, axis=0) - p_lb[:1]

    xc = ctx
    for l in range(DEPTH):
        need_ctx = l < DEPTH - 1
        sh_m, sc_m, gt_m, sh_f, sc_f, gt_f = jnp.split((jax.nn.silu(c) @ w_ada[l] + b_ada[l])[:, None, :], 6, axis=-1)
        csh_m, csc_m, cgt_m, csh_f, csc_f, cgt_f = jnp.split((jax.nn.silu(c_ctx) @ w_ada[l] + b_ada[l])[None, None, :], 6, axis=-1)
        feat_args = (w_in[l], a_q_norm[l], a_k_norm[l], b_q_norm[l], w_q_up[l], b_kv_norm[l], w_kv_up[l], lower[l])

        f_lat = mixer_features(modulate(rms_norm(x, g_pre_mix[l]), sh_m, sc_m), *feat_args, rope_a, rope_b)
        f_ctx = mixer_features(modulate(rms_norm(xc, g_pre_mix[l]), csh_m, csc_m), *feat_args, None, None)
        ya, yb = attention_groups(f_lat, [f_lat, f_ctx])
        yc, yc_ctx = hgrn2_bidirectional(f_lat, f_ctx, c_out_norm[l], need_ctx)
        x = x + gt_m * rms_norm(jnp.concatenate([ya, yb, yc], axis=-1) @ w_out[l], g_post_mix[l])

        x = x + gt_f * rms_norm(sq_relu_mlp(modulate(rms_norm(x, g_pre_ffn[l]), sh_f, sc_f), w_ff1[l], w_ff2[l]), g_post_ffn[l])

        if need_ctx:
            ya_c, yb_c = attention_groups(f_ctx, [f_ctx])
            xc = xc + cgt_m * rms_norm(jnp.concatenate([ya_c, yb_c, yc_ctx], axis=-1) @ w_out[l], g_post_mix[l])
            xc = xc + cgt_f * rms_norm(sq_relu_mlp(modulate(rms_norm(xc, g_pre_ffn[l]), csh_f, csc_f), w_ff1[l], w_ff2[l]), g_post_ffn[l])
    return x
```

```cpp
#include <hip/hip_runtime.h>
#include <cstdio>
#include <cstdint>
namespace pg8 {
#define PG8_LAS __attribute__((address_space(3)))
typedef unsigned short bf16_t;
typedef short bf16x8 __attribute__((ext_vector_type(8)));
typedef float f32x4 __attribute__((ext_vector_type(4)));
typedef unsigned u32x4 __attribute__((ext_vector_type(4)));
constexpr int BM = 256, BK = 64, HALF = 128, HTB = HALF * BK * 2  , STAGE_BYTES = 8 * HTB, NXCD = 8, WGM = 8;

__host__ __device__ __forceinline__ int lds_byte(int r, int c) { const int st = (r >> 4) * 2 + (c >> 5), rr = r & 15, cc = c & 31, ob = rr * 64 + cc * 2; return st * 1024 + (ob ^ (((ob >> 9) & 1) << 5)); }
__host__ __device__ __forceinline__ void stage_rc(int b, int& R, int& C) { const int st = b / 1024, sb = b % 1024, swz = sb ^ (((sb >> 9) & 1) << 5); R = (st >> 1) * 16 + swz / 64; C = (st & 1) * 32 + (swz % 64) / 2; }
__host__ __device__ __forceinline__ int perm32(int rho) { const int n = rho >> 4, i = rho & 15; return 8 * (i >> 2) + 4 * n + (i & 3); }

struct Unit { int pm, pn; };
struct Gemm { const bf16_t* A; const bf16_t* Bt; int M, N, K; };

struct StaticOrder {
    int nM, nN, nwg, G, c;
    __host__ __device__ void init(int M, int N, int G_, int c_) { nM = M / BM; nN = N / BM; nwg = nM * nN; G = G_; c = c_; }
    __host__ __device__ bool next(int i, Unit& u) const {
        const long L = (long)i * G + c; if (L >= nwg) return false;
        int wgid = (int)L; { const int q = nwg / NXCD, r = nwg % NXCD, xcd = wgid % NXCD, off = wgid / NXCD; wgid = (xcd < r ? xcd * (q + 1) : r * (q + 1) + (xcd - r) * q) + off; }
        const int nig = WGM * nN, gid = wgid / nig, fm = gid * WGM, gsz = (nM - fm) < WGM ? (nM - fm) : WGM;
        u.pm = fm + ((wgid % nig) % gsz); u.pn = (wgid % nig) / gsz; return true;
    }
    __device__ __forceinline__ void a_ready(const Unit&) const {}
    __device__ __forceinline__ void done(const Unit&) const {}
};

struct LatOrder {
    StaticOrder s;
    __host__ __device__ void init(int N, int G_, int c_) { s.init(65536, N, G_, c_); }
    __host__ __device__ bool next(int i, Unit& u) const { if (!s.next(i, u)) return false; u.pm = (u.pm >> 4) * 17 + (u.pm & 15); return true; }
    __device__ __forceinline__ void a_ready(const Unit&) const {}
    __device__ __forceinline__ void done(const Unit&) const {}
};
struct OneUnit {
    int pm, pn;
    __host__ __device__ bool next(int i, Unit& u) const { if (i > 0) return false; u.pm = pm; u.pn = pn; return true; }
    __device__ __forceinline__ void a_ready(const Unit&) const {}
    __device__ __forceinline__ void done(const Unit&) const {}
};
struct LatRange {
    StaticOrder s; int p0;
    __host__ __device__ void init(int np, int N, int G_, int c_, int p0_) { s.init(np * BM, N, G_, c_); p0 = p0_; }
    __host__ __device__ bool next(int i, Unit& u) const { if (!s.next(i, u)) return false; const int p = u.pm + p0; u.pm = (p >> 4) * 17 + (p & 15); return true; }
    __device__ __forceinline__ void a_ready(const Unit&) const {}
    __device__ __forceinline__ void done(const Unit&) const {}
};
typedef float f32x2c_t __attribute__((ext_vector_type(2))); typedef __bf16 bf16x2c_t __attribute__((ext_vector_type(2)));
__device__ __forceinline__ unsigned cvt_pk_bf16(float lo, float hi) { f32x2c_t v = {lo, hi}; bf16x2c_t b = __builtin_convertvector(v, bf16x2c_t); return __builtin_bit_cast(unsigned, b); }
typedef float f32x2 __attribute__((ext_vector_type(2)));

constexpr int TPB_ = 4352;
template <int ACT  > struct EpiStore {
    static constexpr bool PERM = true, AFTER_DRAIN = false;
    bf16_t* O; int ldc;
    __device__ __forceinline__ void operator()(const f32x4 (&acc)[2][2][4][2], const Unit& u, int wr, int wc, int fr, int fq) const {
        const int row0 = u.pm * BM + wr * 64 + fr, col0 = u.pn * BM + wc * 32 + 8 * fq;
#pragma unroll
        for (int ai = 0; ai < 2; ++ai)
#pragma unroll
            for (int m = 0; m < 4; ++m) { bf16_t* rowp = O + (size_t)(row0 + ai * HALF + m * 16) * ldc + col0;
#pragma unroll
                for (int bj = 0; bj < 2; ++bj) { f32x4 v0 = acc[ai][bj][m][0], v1 = acc[ai][bj][m][1];
                    if (ACT == 1) {
#pragma unroll
                        for (int e = 0; e < 4; ++e) { float a = v0[e] > 0.f ? v0[e] : 0.f, b = v1[e] > 0.f ? v1[e] : 0.f; v0[e] = a * a; v1[e] = b * b; } }
                    u32x4 w; w.x = cvt_pk_bf16(v0[0], v0[1]); w.y = cvt_pk_bf16(v0[2], v0[3]); w.z = cvt_pk_bf16(v1[0], v1[1]); w.w = cvt_pk_bf16(v1[2], v1[3]);
                    *(u32x4*)(rowp + bj * HALF) = w; } }
    }
};
struct EpiQup {
    static constexpr bool PERM = false, AFTER_DRAIN = false;
    bf16_t* O; const float* cosB; const float* sinB; float scale;
    __device__ __forceinline__ void operator()(const f32x4 (&acc)[2][2][4][2], const Unit& u, int wr, int wc, int fr, int fq) const {
        typedef unsigned u32x2v __attribute__((ext_vector_type(2)));
        const int row0 = u.pm * BM + wr * 64 + fr;
#pragma unroll
        for (int bj = 0; bj < 2; ++bj) {
            const int cg = u.pn * BM + bj * HALF + wc * 32;
            if (cg >= 384) continue;
            const bool pe = ((cg >> 5) % 3) == 2;
#pragma unroll
            for (int ai = 0; ai < 2; ++ai)
#pragma unroll
                for (int m = 0; m < 4; ++m) {
                    const int row = row0 + ai * HALF + m * 16; const int j = row % TPB_;
                    f32x4 v0 = acc[ai][bj][m][0], v1 = acc[ai][bj][m][1];
                    if (pe && j < 4096) {
                        const int pos = (fq < 2) ? (j >> 6) : (j & 63);
                        const f32x4 cs = *(const f32x4*)(cosB + pos * 8 + 4 * (fq & 1)), sn = *(const f32x4*)(sinB + pos * 8 + 4 * (fq & 1));
                        const f32x4 a = v0 * cs - v1 * sn, b = v1 * cs + v0 * sn; v0 = a; v1 = b;
                    }
                    v0 = v0 * scale; v1 = v1 * scale;
                    bf16_t* p = O + (size_t)row * 384 + cg + 4 * fq;
                    u32x2v w0, w1; w0.x = cvt_pk_bf16(v0[0], v0[1]); w0.y = cvt_pk_bf16(v0[2], v0[3]); w1.x = cvt_pk_bf16(v1[0], v1[1]); w1.y = cvt_pk_bf16(v1[2], v1[3]);
                    *(u32x2v*)p = w0; *(u32x2v*)(p + 16) = w1;
                    asm volatile("" ::: "memory");
                }
        }
    }
};
struct EpiKVup {
    static constexpr bool PERM = true, AFTER_DRAIN = false;
    bf16_t* KB; bf16_t* VB;
    __device__ __forceinline__ void operator()(const f32x4 (&acc)[2][2][4][2], const Unit& u, int wr, int wc, int fr, int fq) const {
        const int row0 = u.pm * BM + wr * 64 + fr;
#pragma unroll
        for (int bj = 0; bj < 2; ++bj) {
            const int head = u.pn * 2 + bj; const int within = wc * 32 + 8 * fq;
#pragma unroll
            for (int ai = 0; ai < 2; ++ai)
#pragma unroll
                for (int m = 0; m < 4; ++m) {
                    const int row = row0 + ai * HALF + m * 16;
                    const f32x4 v0 = acc[ai][bj][m][0], v1 = acc[ai][bj][m][1];
                    u32x4 w; w.x = cvt_pk_bf16(v0[0], v0[1]); w.y = cvt_pk_bf16(v0[2], v0[3]); w.z = cvt_pk_bf16(v1[0], v1[1]); w.w = cvt_pk_bf16(v1[2], v1[3]);
                    bf16_t* p = (within < 64) ? (KB + (size_t)row * 384 + head * 96 + within) : (VB + (size_t)row * 256 + head * 64 + (within - 64));
                    *(u32x4*)p = w;
                }
        }
    }
};

struct EpiFeat {
    static constexpr bool PERM = true, AFTER_DRAIN = false;
    bf16_t* FEAT; int ldf; bf16_t* CFQ; bf16_t* CKF; bf16_t* CKB; bf16_t* CFV; bf16_t* CFG; const float* clb; int layer;
    __device__ __forceinline__ void operator()(const f32x4 (&acc)[2][2][4][2], const Unit& u, int wr, int wc, int fr, int fq) const {
        const int row0 = u.pm * BM + wr * 64 + fr;
#pragma unroll
        for (int bj = 0; bj < 2; ++bj) {
            const int c0 = u.pn * BM + bj * HALF + wc * 32 + 8 * fq;
            if (c0 >= 2400) continue;
            const int seg = (c0 < 1120) ? -1 : ((c0 - 1120) >> 8); const int ch = (c0 - 1120) & 255;
            float om[8];
#pragma unroll
            for (int e = 0; e < 8; ++e) om[e] = 1.0f;
            if (layer > 0 && (seg == 1 || seg == 2)) {
                const float* c1 = clb + 512 + (seg - 1) * 256 + ch; const float* c0p = clb + (seg - 1) * 256 + ch;
#pragma unroll
                for (int e = 0; e < 8; ++e) om[e] = 1.0f - 1.0f / (1.0f + __expf(-(c1[e] - c0p[e])));
            }
            bf16_t* dst; int ld;
            if (seg < 0) { dst = FEAT + c0; ld = ldf; } else { dst = (seg == 0 ? CFQ : seg == 1 ? CKF : seg == 2 ? CKB : seg == 3 ? CFV : CFG) + ch; ld = 256; }
#pragma unroll
            for (int ai = 0; ai < 2; ++ai)
#pragma unroll
                for (int m = 0; m < 4; ++m) {
                    const int row = row0 + ai * HALF + m * 16;
                    f32x4 v0 = acc[ai][bj][m][0], v1 = acc[ai][bj][m][1];
                    if (seg == 0) {
#pragma unroll
                        for (int e = 0; e < 4; ++e) { v0[e] = v0[e] / (1.0f + __expf(-v0[e])); v1[e] = v1[e] / (1.0f + __expf(-v1[e])); }
                    } else if (seg == 1 || seg == 2) {
#pragma unroll
                        for (int e = 0; e < 4; ++e) { v0[e] = om[e] / (1.0f + __expf(v0[e])); v1[e] = om[4 + e] / (1.0f + __expf(v1[e])); }
                    }
                    u32x4 w; w.x = cvt_pk_bf16(v0[0], v0[1]); w.y = cvt_pk_bf16(v0[2], v0[3]); w.z = cvt_pk_bf16(v1[0], v1[1]); w.w = cvt_pk_bf16(v1[2], v1[3]);
                    *(u32x4*)(dst + (size_t)row * ld) = w;
                }
        }
    }
};
template <class Epi, class Sched, bool ALIGN_EPI = false, bool SP2 = false>
__device__ __forceinline__ void gemm_phase(PG8_LAS unsigned char* lds, const Gemm g, const Sched& S, const Epi& E) {
    int tid_l = threadIdx.x; asm volatile("" : "+v"(tid_l)); const int tid = tid_l, wid = __builtin_amdgcn_readfirstlane(tid >> 6), lane = tid & 63, wr = wid >> 2, wc = wid & 3, fr = lane & 15, fq = lane >> 4;
    const int K = g.K, nt = K / BK;
    unsigned voffA[2], voffB[2];
#pragma unroll
    for (int i = 0; i < 2; ++i) { int R, C; stage_rc(tid * 16 + i * 8192, R, C); const int Rb = Epi::PERM ? ((R & ~31) + perm32(R & 31)) : R;
        voffA[i] = (unsigned)(R * K + C) * 2u; voffB[i] = (unsigned)(Rb * K + C) * 2u; }
    const size_t kstep = (size_t)(BK * 2);
    const size_t hstep = (size_t)HALF * K * 2;
    const size_t tstep = 2 * hstep;
    const unsigned ldsw = (unsigned)wid * 1024u;
    const int aoff = lds_byte(wr * 64 + fr, fq * 8), boff = lds_byte(wc * 32 + fr, fq * 8);
#define PG8_SA(b, h) (((b) * 2 + (h)) * HTB)
#define PG8_SB(b, h) ((4 + (b) * 2 + (h)) * HTB)
#define PG8_STAGE(bufoff, gbase, voff) do { _Pragma("unroll") for (int _i = 0; _i < 2; ++_i) \
        __builtin_amdgcn_global_load_lds((const unsigned*)((const char*)(gbase) + (voff)[_i]), (PG8_LAS unsigned*)(lds + (bufoff) + ldsw + _i * 8192), 16, 0, 0); } while (0)
#define PG8_LDA(dst, b, h) do { _Pragma("unroll") for (int m = 0; m < 4; ++m) _Pragma("unroll") for (int k = 0; k < 2; ++k) dst[m][k] = *(const PG8_LAS bf16x8*)(lds + PG8_SA(b, h) + aoff + m * 2048 + k * 1024); } while (0)
#define PG8_LDB(dst, b, h) do { _Pragma("unroll") for (int n = 0; n < 2; ++n) _Pragma("unroll") for (int k = 0; k < 2; ++k) dst[n][k] = *(const PG8_LAS bf16x8*)(lds + PG8_SB(b, h) + boff + n * 2048 + k * 1024); } while (0)
#define PG8_MMA(ai, bj, At, Bt) do { __builtin_amdgcn_s_setprio(1); _Pragma("unroll") for (int m = 0; m < 4; ++m) _Pragma("unroll") for (int n = 0; n < 2; ++n) _Pragma("unroll") for (int k = 0; k < 2; ++k) \
        acc[ai][bj][m][n] = __builtin_amdgcn_mfma_f32_16x16x32_bf16(Bt[n][k], At[m][k], acc[ai][bj][m][n], 0, 0, 0); __builtin_amdgcn_s_setprio(0); } while (0)
#define PG8_WAIT_V(n) asm volatile("s_waitcnt vmcnt(" #n ")" ::: "memory")
#define PG8_WAIT_L(n) asm volatile("s_waitcnt lgkmcnt(" #n ")" ::: "memory")
#define PG8_BAR __builtin_amdgcn_s_barrier()
#define PG8_SCHED __builtin_amdgcn_sched_barrier(0)
    Unit cur, nxt; int ui = 0;
    if (!S.next(0, cur)) return;
    f32x4 acc[2][2][4][2];
#pragma unroll
    for (int a = 0; a < 2; ++a)
#pragma unroll
        for (int b = 0; b < 2; ++b)
#pragma unroll
            for (int m = 0; m < 4; ++m)
#pragma unroll
                for (int n = 0; n < 2; ++n) acc[a][b][m][n] = (f32x4){0.f, 0.f, 0.f, 0.f};
    bf16x8 At[4][2], B0[2][2], B1[2][2];
    const char* cA = (const char*)g.A + (size_t)cur.pm * tstep; const char* cB = (const char*)g.Bt + (size_t)cur.pn * tstep;
    S.a_ready(cur);
    if constexpr (SP2) {
        PG8_STAGE(PG8_SB(0, 0), cB, voffB); PG8_STAGE(PG8_SB(0, 1), cB + hstep, voffB); PG8_STAGE(PG8_SA(0, 0), cA, voffA); PG8_STAGE(PG8_SA(0, 1), cA + hstep, voffA);
        if (wr == 1) PG8_BAR;
        PG8_WAIT_V(2); PG8_BAR;
        PG8_STAGE(PG8_SB(1, 0), cB + kstep, voffB); PG8_STAGE(PG8_SA(1, 0), cA + kstep, voffA); PG8_STAGE(PG8_SB(1, 1), cB + hstep + kstep, voffB);
        PG8_WAIT_V(6); PG8_BAR;
    } else {
        PG8_STAGE(PG8_SB(0, 0), cB, voffB); PG8_STAGE(PG8_SA(0, 0), cA, voffA); PG8_STAGE(PG8_SB(0, 1), cB + hstep, voffB); PG8_STAGE(PG8_SA(0, 1), cA + hstep, voffA);
        if (wr == 1) PG8_BAR;
        PG8_WAIT_V(4); PG8_BAR;
        PG8_STAGE(PG8_SB(1, 0), cB + kstep, voffB); PG8_STAGE(PG8_SA(1, 0), cA + kstep, voffA); PG8_STAGE(PG8_SB(1, 1), cB + hstep + kstep, voffB);
        PG8_WAIT_V(6); PG8_BAR;
    }
    for (;;) {
        const bool has_next = S.next(ui + 1, nxt);
        const char* nA = has_next ? (const char*)g.A + (size_t)nxt.pm * tstep : cA; const char* nB = has_next ? (const char*)g.Bt + (size_t)nxt.pn * tstep : cB;
        for (int t = 0; t < nt; t += 2) {
            const bool last = (t == nt - 2);
            const char* a1 = cA + (size_t)(t + 1) * kstep;
            const char* a2 = last ? nA : cA + (size_t)(t + 2) * kstep; const char* b2 = last ? nB : cB + (size_t)(t + 2) * kstep;
            const char* a3 = a2 + kstep; const char* b3 = b2 + kstep;
            if (last && has_next) S.a_ready(nxt);
            if constexpr (SP2) {
            PG8_LDB(B0, 0, 0); PG8_LDB(B1, 0, 1); PG8_SCHED; PG8_LDA(At, 0, 0); PG8_STAGE(PG8_SA(1, 1), a1 + hstep, voffA);
            PG8_WAIT_V(8); PG8_WAIT_L(0); PG8_BAR; PG8_MMA(0, 0, At, B0); PG8_MMA(0, 1, At, B1); PG8_BAR; PG8_SCHED;
            PG8_LDA(At, 0, 1); PG8_STAGE(PG8_SB(0, 0), b2, voffB); PG8_STAGE(PG8_SB(0, 1), b2 + hstep, voffB); PG8_STAGE(PG8_SA(0, 0), a2, voffA);
            PG8_WAIT_V(8); PG8_WAIT_L(0); PG8_BAR; PG8_MMA(1, 0, At, B0); PG8_MMA(1, 1, At, B1); PG8_BAR; PG8_SCHED;
            PG8_LDB(B0, 1, 0); PG8_LDB(B1, 1, 1); PG8_SCHED; PG8_LDA(At, 1, 0); PG8_STAGE(PG8_SA(0, 1), a2 + hstep, voffA);
            PG8_WAIT_V(8); PG8_WAIT_L(0); PG8_BAR; PG8_MMA(0, 0, At, B0); PG8_MMA(0, 1, At, B1); PG8_BAR; PG8_SCHED;
            PG8_LDA(At, 1, 1); PG8_STAGE(PG8_SB(1, 0), b3, voffB); PG8_STAGE(PG8_SB(1, 1), b3 + hstep, voffB); PG8_STAGE(PG8_SA(1, 0), a3, voffA);
            PG8_WAIT_V(8); PG8_WAIT_L(0); PG8_BAR; PG8_MMA(1, 0, At, B0); PG8_MMA(1, 1, At, B1); PG8_BAR; PG8_SCHED;
            } else {
            PG8_LDB(B0, 0, 0); PG8_SCHED; PG8_LDA(At, 0, 0); PG8_STAGE(PG8_SA(1, 1), a1 + hstep, voffA);
            PG8_WAIT_L(8); PG8_BAR; PG8_WAIT_L(0); PG8_MMA(0, 0, At, B0); PG8_BAR; PG8_SCHED;
            PG8_LDB(B1, 0, 1); PG8_STAGE(PG8_SB(0, 0), b2, voffB);
            PG8_BAR; PG8_WAIT_L(0); PG8_MMA(0, 1, At, B1); PG8_BAR;
            PG8_LDA(At, 0, 1); PG8_STAGE(PG8_SA(0, 0), a2, voffA);
            PG8_BAR; PG8_WAIT_L(0); PG8_MMA(1, 0, At, B0); PG8_BAR; PG8_SCHED;
            PG8_STAGE(PG8_SB(0, 1), b2 + hstep, voffB);
            PG8_WAIT_V(6); PG8_BAR; PG8_MMA(1, 1, At, B1); PG8_BAR;
            PG8_LDB(B0, 1, 0); PG8_SCHED; PG8_LDA(At, 1, 0); PG8_STAGE(PG8_SA(0, 1), a2 + hstep, voffA);
            PG8_WAIT_L(8); PG8_BAR; PG8_WAIT_L(0); PG8_MMA(0, 0, At, B0); PG8_BAR; PG8_SCHED;
            PG8_LDB(B1, 1, 1); PG8_STAGE(PG8_SB(1, 0), b3, voffB);
            PG8_BAR; PG8_WAIT_L(0); PG8_MMA(0, 1, At, B1); PG8_BAR;
            PG8_LDA(At, 1, 1); PG8_STAGE(PG8_SA(1, 0), a3, voffA);
            PG8_BAR; PG8_WAIT_L(0); PG8_MMA(1, 0, At, B0); PG8_BAR; PG8_SCHED;
            PG8_STAGE(PG8_SB(1, 1), b3 + hstep, voffB);
            PG8_WAIT_V(6); PG8_BAR; PG8_MMA(1, 1, At, B1); PG8_BAR;
            }
        }
        if constexpr (ALIGN_EPI) { if (wr == 0) PG8_BAR; }
        if constexpr (!Epi::AFTER_DRAIN) { E(acc, cur, wr, wc, fr, fq); S.done(cur); }
        if (!has_next) break;
#pragma unroll
        for (int a = 0; a < 2; ++a)
#pragma unroll
            for (int b = 0; b < 2; ++b)
#pragma unroll
                for (int m = 0; m < 4; ++m)
#pragma unroll
                    for (int n = 0; n < 2; ++n) acc[a][b][m][n] = (f32x4){0.f, 0.f, 0.f, 0.f};
        cur = nxt; cA = nA; cB = nB; ++ui;
        if constexpr (ALIGN_EPI) { if (wr == 1) PG8_BAR; }
    }
    PG8_WAIT_V(0);
    if constexpr (!ALIGN_EPI) { if (wr == 0) PG8_BAR; }
    PG8_BAR;
    if constexpr (Epi::AFTER_DRAIN) { E.fused(acc, cur, wr, wc, fr, fq, lds, wid, lane); S.done(cur); }
#undef PG8_SA
#undef PG8_SB
#undef PG8_STAGE
#undef PG8_LDA
#undef PG8_LDB
#undef PG8_MMA
#undef PG8_WAIT_V
#undef PG8_WAIT_L
#undef PG8_BAR
#undef PG8_SCHED
}
}

#include <hip/hip_cooperative_groups.h>
namespace cg = cooperative_groups;
#define LAS __attribute__((address_space(3)))
typedef unsigned short bf16;
typedef short bf16x8 __attribute__((ext_vector_type(8)));
typedef float f32x4 __attribute__((ext_vector_type(4)));
typedef float f32x16 __attribute__((ext_vector_type(16)));
typedef unsigned u32x4 __attribute__((ext_vector_type(4)));
typedef unsigned u32x2 __attribute__((ext_vector_type(2)));
typedef short s16x4 __attribute__((ext_vector_type(4)));

constexpr int NB = 16, SEQ = 4096, CTX = 256, TPB = 4352, MROWS = NB * TPB, DM = 1024, DIN = 2400, DINP = 2560, DFF = 4096, DEPTH = 2;
constexpr int NTHR = 512, NWAVES = 8;
constexpr float EPS = 1e-6f;
constexpr float LOG2E = 1.4426950408889634f;
constexpr float QSCALE_A = 0.125f * LOG2E;
constexpr float QSCALE_B = 0.10206207261596577f * LOG2E;
constexpr int C_AQ = 0, C_AK = 512, C_AV = 640, C_BQD = 768, C_BKVD = 960, C_BKR = 1088, C_CQ = 1120, C_CFF = 1376, C_CFB = 1632, C_CI = 1888, C_CG = 2144;

constexpr size_t MiB = 1u << 20;
constexpr size_t WS_CTL = 0;
constexpr size_t WS_ADA = 1 * MiB;
constexpr size_t WS_TAB = 2 * MiB;
constexpr size_t WS_SSQ_Q = 1020 * MiB, WS_SSQ_KV = 1022 * MiB + 262144;
constexpr size_t WS_PART = 1004 * MiB;
constexpr size_t WS_W = 4 * MiB, W_LAYER = 24 * MiB;
constexpr size_t WO_IN = 0, WO_OUT = 5 * MiB, WO_1 = 7 * MiB, WO_2 = 15 * MiB, WO_QU = 23 * MiB, WO_KVU = 23 * MiB + 512 * 1024;
constexpr size_t WS_XC = 52 * MiB;
constexpr size_t WS_HN = 68 * MiB;
constexpr size_t WS_T = 204 * MiB;
constexpr size_t WS_Y = 340 * MiB;
constexpr size_t WS_T2 = WS_Y;
constexpr size_t WS_OV = 476 * MiB;
constexpr size_t WS_HB = WS_OV;
constexpr size_t WS_FEAT = WS_OV;
constexpr size_t WS_QA = 816 * MiB, WS_KB = 884 * MiB, WS_CFQ = 935 * MiB, WS_CFV = 969 * MiB, WS_KA = 1003 * MiB;
constexpr size_t WS_VA = WS_T, WS_CFG = WS_T + 17 * MiB, WS_CKF = WS_T + 51 * MiB, WS_CKB = WS_T + 85 * MiB;
constexpr size_t WS_BQD = WS_Y, WS_BKVD = WS_Y + 34 * MiB;
constexpr size_t WS_QB = WS_OV, WS_VB = WS_OV + 51 * MiB, WS_OF = WS_OV + 85 * MiB, WS_OB = WS_OV + 153 * MiB;
constexpr size_t WS_END = 1024 * MiB;

constexpr int LDS_BYTES = 131072 + 1024;
constexpr int LDS_MISC = 131072;

__device__ __forceinline__ unsigned pk2(float lo, float hi) { return pg8::cvt_pk_bf16(lo, hi); }
__device__ __forceinline__ float bf_lo(unsigned w) { return __uint_as_float(w << 16); }
__device__ __forceinline__ float bf_hi(unsigned w) { return __uint_as_float(w & 0xffff0000u); }
__device__ __forceinline__ void unpack8(const u32x4 w, float (&f)[8]) { f[0] = bf_lo(w.x); f[1] = bf_hi(w.x); f[2] = bf_lo(w.y); f[3] = bf_hi(w.y); f[4] = bf_lo(w.z); f[5] = bf_hi(w.z); f[6] = bf_lo(w.w); f[7] = bf_hi(w.w); }
__device__ __forceinline__ u32x4 pack8(const float (&f)[8]) { u32x4 w; w.x = pk2(f[0], f[1]); w.y = pk2(f[2], f[3]); w.z = pk2(f[4], f[5]); w.w = pk2(f[6], f[7]); return w; }
__device__ __forceinline__ float wave_sum(float v) {
#pragma unroll
    for (int o = 1; o < 64; o <<= 1) v += __shfl_xor(v, o);
    return v;
}
__device__ __forceinline__ float sigmoidf_(float z) { return 1.0f / (1.0f + __expf(-z)); }
__device__ __forceinline__ float siluf_(float z) { return z / (1.0f + __expf(-z)); }

#define XB_TMO      128
#define XB_XCNT(j)  (256  + 64 * (j))
#define XB_XSUB(j)  (1280 + 64 * (j))
#define XB_XGEN(j)  (2304 + 64 * (j))
#define XB_TOP      3328
#define XB_TOPGEN   3392
#define XCD_BAR_WORDS 3456
#define XB_SPIN_CAP (1u << 18)

__device__ __forceinline__ unsigned xb_ld(unsigned* p)              { return __hip_atomic_load(p, __ATOMIC_RELAXED, __HIP_MEMORY_SCOPE_AGENT); }
__device__ __forceinline__ unsigned xb_add(unsigned* p, unsigned v) { return __hip_atomic_fetch_add(p, v, __ATOMIC_RELAXED, __HIP_MEMORY_SCOPE_AGENT); }
__device__ __forceinline__ unsigned xb_xcc_id() { return (unsigned)__builtin_amdgcn_s_getreg((3 << 11) | 20) & 0xFu; }
#define XB_SPIN(cond, bar) do { unsigned _sp = 0; while (cond) { __builtin_amdgcn_s_sleep(1); \
    if ((++_sp & 255u) == 0u) { if (xb_ld(&(bar)[XB_TMO])) break; if (_sp > XB_SPIN_CAP) { atomicAdd(&(bar)[XB_TMO], 1u); break; } } } } while (0)

struct XcdBarrier {
    unsigned* bar; unsigned x;
    volatile LAS unsigned* st;
};

__device__ __forceinline__ XcdBarrier xcd_barrier_post(unsigned* bar, volatile LAS unsigned* st) {
    XcdBarrier b; b.bar = bar; b.x = xb_xcc_id(); b.st = st;
    if (threadIdx.x == 0) (void)xb_add(&bar[XB_XCNT(b.x)], 1u);
    return b;
}
__device__ __forceinline__ void xcd_barrier_complete(unsigned* bar, unsigned x, unsigned& nloc, unsigned& nx) {
    const unsigned G = gridDim.x * gridDim.y * gridDim.z;
    unsigned sum, cnt, mine, sp = 0u;
    for (;;) {
        sum = 0u; cnt = 0u; mine = 0u;
#pragma unroll
        for (unsigned j = 0; j < 16; ++j) { const unsigned c = xb_ld(&bar[XB_XCNT(j)]); sum += c; cnt += (c > 0u) ? 1u : 0u; mine = (j == x) ? c : mine; }
        if (sum == G) break;
        __builtin_amdgcn_s_sleep(1);
        if ((++sp & 255u) == 0u) { if (xb_ld(&bar[XB_TMO])) break; if (sp > XB_SPIN_CAP) { atomicAdd(&bar[XB_TMO], 1u); break; } }
    }
    nloc = mine > 0u ? mine : 1u; nx = cnt > 0u ? cnt : 1u;
}

__device__ __forceinline__ void xcd_barrier(const XcdBarrier& b) {
    asm volatile("s_waitcnt vmcnt(0)" ::: "memory");
    __syncthreads();
    if (threadIdx.x == 0) {
        unsigned* bar = b.bar;
        __builtin_amdgcn_s_waitcnt(0);
        unsigned nloc = b.st[0], nx = b.st[1];
        if (nloc == 0u) { xcd_barrier_complete(bar, b.x, nloc, nx); b.st[0] = nloc; b.st[1] = nx; }
        const unsigned old = xb_add(&bar[XB_XSUB(b.x)], 1u);
        const unsigned gen = old / nloc;
        if (old + 1u == (gen + 1u) * nloc) {
            __builtin_amdgcn_fence(__ATOMIC_RELEASE, "agent");
            asm volatile("s_waitcnt vmcnt(0)" ::: "memory");
            const unsigned og = xb_add(&bar[XB_TOP], 1u);
            const unsigned tg = og / nx;
            if (og + 1u == (tg + 1u) * nx) xb_add(&bar[XB_TOPGEN], 1u);
            else XB_SPIN(xb_ld(&bar[XB_TOPGEN]) == tg, bar);
            __builtin_amdgcn_fence(__ATOMIC_ACQUIRE, "agent");
            xb_add(&bar[XB_XGEN(b.x)], 1u);
            asm volatile("s_waitcnt vmcnt(0)" ::: "memory");
        } else {
            XB_SPIN(xb_ld(&bar[XB_XGEN(b.x)]) == gen, bar);
            __builtin_amdgcn_fence(__ATOMIC_ACQUIRE, "agent");
            asm volatile("s_waitcnt vmcnt(0)" ::: "memory");
        }
    }
    __syncthreads();
}

struct Args {
    const float* in[22];
    float* out; unsigned char* ws;
    int ph_lo, ph_hi, coop, pad;
};
enum { I_X = 0, I_C, I_CTX, I_CCTX, I_WADA, I_BADA, I_GPREMIX, I_GPOSTMIX, I_GPREFFN, I_GPOSTFFN, I_WIN, I_AQN, I_AKN, I_BQN, I_WQUP, I_BKVN, I_WKVUP, I_CLB, I_CON, I_WOUT, I_WFF1, I_WFF2 };

__device__ __forceinline__ void transpose_item(const float* W, int K, int N, bf16* WT, int Kp, int Np, LAS float* scr, int item, int lane, const float* kscale = nullptr, bool headsplit = false) {
    const int nblk = Np / 32, kb = item / nblk, nb = item % nblk, k0 = 64 * kb, n0 = 32 * nb;
    const int n0o = (headsplit && n0 < 768) ? ((n0 & ~255) + ((n0 >> 5) & 1) * 128 + ((n0 >> 6) & 3) * 32) : n0;
    const int n = n0 + (lane & 31);
#pragma unroll
    for (int i = 0; i < 32; ++i) { const int kk = 2 * i + (lane >> 5); const int k = k0 + kk; scr[kk * 33 + (lane & 31)] = (k < K && n < N) ? W[(size_t)k * N + n] * (kscale ? kscale[k] : 1.0f) : 0.f; }
    asm volatile("s_waitcnt lgkmcnt(0)" ::: "memory");
    const int c = lane & 7;
#pragma unroll
    for (int j = 0; j < 4; ++j) { const int nn = (lane >> 3) + 8 * j; const LAS float* s = scr + (8 * c) * 33 + nn;
        u32x4 o; o.x = pk2(s[0 * 33], s[1 * 33]); o.y = pk2(s[2 * 33], s[3 * 33]); o.z = pk2(s[4 * 33], s[5 * 33]); o.w = pk2(s[6 * 33], s[7 * 33]);
        *(u32x4*)(WT + (size_t)(n0o + nn) * Kp + k0 + 8 * c) = o; }
    asm volatile("s_waitcnt lgkmcnt(0)" ::: "memory");
}
__device__ __forceinline__ void phase0(const Args& a, LAS unsigned char* lds, int gw, int NGW, int wave, int lane, int tid) {
    LAS float* scr = (LAS float*)(lds + wave * 16384);
    constexpr int I_IN = 16 * 80, I_OUT = 16 * 32, I_1 = 16 * 128, I_2 = 64 * 32, I_QU = 4 * 16, I_KVU = 2 * 16, I_L = I_IN + I_OUT + I_1 + I_2 + I_QU + I_KVU;
    for (int it = gw; it < 2 * I_L; it += NGW) {
        const int l = it / I_L; int r = it % I_L; unsigned char* wb = a.ws + WS_W + (size_t)l * W_LAYER;
        if (r < I_IN) { transpose_item(a.in[I_WIN] + (size_t)l * DM * DIN, DM, DIN, (bf16*)(wb + WO_IN), DM, DINP, scr, r, lane, nullptr, true); continue; } r -= I_IN;
        if (r < I_OUT) { transpose_item(a.in[I_WOUT] + (size_t)l * DM * DM, DM, DM, (bf16*)(wb + WO_OUT), DM, DM, scr, r, lane); continue; } r -= I_OUT;
        if (r < I_1) { transpose_item(a.in[I_WFF1] + (size_t)l * DM * DFF, DM, DFF, (bf16*)(wb + WO_1), DM, DFF, scr, r, lane); continue; } r -= I_1;
        if (r < I_2) { transpose_item(a.in[I_WFF2] + (size_t)l * DFF * DM, DFF, DM, (bf16*)(wb + WO_2), DFF, DM, scr, r, lane); continue; } r -= I_2;
        if (r < I_QU) { transpose_item(a.in[I_WQUP] + (size_t)l * 192 * 384, 192, 384, (bf16*)(wb + WO_QU), 256, 512, scr, r, lane, a.in[I_BQN] + l * 192); continue; } r -= I_QU;
        transpose_item(a.in[I_WKVUP] + (size_t)l * 128 * 512, 128, 512, (bf16*)(wb + WO_KVU), 128, 512, scr, r, lane, a.in[I_BKVN] + l * 128);
    }
    float* PART = (float*)(a.ws + WS_PART);
    for (int it = gw; it < 16 * 2 * 96; it += NGW) {
        const int nb = it % 96, l = (it / 96) % 2, ks = it / 192; const int n = nb * 64 + lane;
        float creg[17];
#pragma unroll
        for (int r = 0; r < 17; ++r) { const float cv = (r < 16) ? a.in[I_C][r * DM + ks * 64 + lane] : a.in[I_CCTX][ks * 64 + lane]; creg[r] = siluf_(cv); }
        float acc[17];
#pragma unroll
        for (int r = 0; r < 17; ++r) acc[r] = 0.f;
        const float* wp = a.in[I_WADA] + ((size_t)l * DM + ks * 64) * 6144 + n;
#pragma unroll 32
        for (int kk = 0; kk < 64; ++kk) { const float w = wp[(size_t)kk * 6144];
#pragma unroll
            for (int r = 0; r < 17; ++r) acc[r] += __shfl(creg[r], kk) * w; }
#pragma unroll
        for (int r = 0; r < 17; ++r) PART[(((size_t)ks * 2 + l) * 17 + r) * 6144 + n] = acc[r];
    }
    if (blockIdx.x == 0) {
        float* tab = (float*)(a.ws + WS_TAB);
        for (int e = tid; e < 64 * 16 + 64 * 8; e += NTHR) {
            int pos, f, nf; float* cdst; float* sdst;
            if (e < 1024) { pos = e >> 4; f = e & 15; nf = 16; cdst = tab + e; sdst = tab + 1024 + e; }
            else { const int e2 = e - 1024; pos = e2 >> 3; f = e2 & 7; nf = 8; cdst = tab + 2048 + e2; sdst = tab + 2560 + e2; }
            const float inv = exp2f(-(float)f / (float)nf * 13.287712379549449f);
            const float ang = (float)pos * inv;
            const float kf = rintf(ang * 0.15915494309189535f);
            float rr = fmaf(-kf, 6.28125f, ang); rr = fmaf(-kf, 1.9353071795864769e-3f, rr);
            *cdst = __cosf(rr); *sdst = __sinf(rr);
        }
    }
}
__device__ __forceinline__ void phase_ada_reduce(const Args& a, int tid) {
    const float* PART = (const float*)(a.ws + WS_PART); float* ADA = (float*)(a.ws + WS_ADA);
    for (int e = blockIdx.x * NTHR + tid; e < 2 * 17 * 6144; e += gridDim.x * NTHR) {
        const int n = e % 6144, l = e / (17 * 6144);
        float s = a.in[I_BADA][l * 6144 + n];
#pragma unroll
        for (int ks = 0; ks < 16; ++ks) s += PART[(size_t)ks * (2 * 17 * 6144) + e];
        ADA[e] = s;
    }
}

__device__ __forceinline__ const float* ada_ptr(const Args& a, int l, int R, int chunk) { const int b = R / TPB, j = R % TPB; const int r = (j < SEQ) ? b : 16; return (const float*)(a.ws + WS_ADA) + ((size_t)l * 17 + r) * 6144 + chunk * DM; }
__device__ __forceinline__ size_t xrow_off(int R, bool& lat) { const int b = R / TPB, j = R % TPB; lat = j < SEQ; return lat ? ((size_t)b * SEQ + j) * DM : ((size_t)b * CTX + (j - SEQ)) * DM; }
#define RCOL(q) (8 * lane + 512 * ((q) >> 1) + 4 * ((q) & 1))
struct RowIn { f32x4 x[4]; u32x4 t[2]; u32x4 t2[2]; };
__device__ __forceinline__ void row_load(const Args& a, int R, int lane, bool has_upd, bool xin_from_inputs, RowIn& r, bool has_upd2 = false) {
    bool lat; const size_t xo = xrow_off(R, lat);
    const float* xin = xin_from_inputs ? (lat ? a.in[I_X] : a.in[I_CTX]) : (lat ? (const float*)a.out : (const float*)(a.ws + WS_XC));
#pragma unroll
    for (int q = 0; q < 4; ++q) r.x[q] = *(const f32x4*)(xin + xo + RCOL(q));
    if (has_upd) { const bf16* T = (const bf16*)(a.ws + WS_T) + (size_t)R * DM;
#pragma unroll
        for (int h = 0; h < 2; ++h) r.t[h] = *(const u32x4*)(T + 8 * lane + 512 * h); }
    if (has_upd2) { const bf16* T2 = (const bf16*)(a.ws + WS_T2) + (size_t)R * DM;
#pragma unroll
        for (int h = 0; h < 2; ++h) r.t2[h] = *(const u32x4*)(T2 + 8 * lane + 512 * h); }
}
__device__ __forceinline__ void row_compute(const Args& a, int R, int lane, const RowIn& in, bool has_upd, const float* gpost, int l_gate, int gate_chunk,
                                            bool write_x, bool has_hn, const float* gpre, int l_mod, int sh_chunk, bool has_upd2 = false, const float* gpost2 = nullptr, int gate_chunk2 = 0) {
    bool lat; const size_t xo = xrow_off(R, lat);
    float* xout = lat ? a.out : (float*)(a.ws + WS_XC);
    f32x4 v[4];
#pragma unroll
    for (int q = 0; q < 4; ++q) v[q] = in.x[q];
    if (has_upd) {
        f32x4 t[4]; float ss = 0.f;
#pragma unroll
        for (int q = 0; q < 4; ++q) { const u32x4 w4 = in.t[q >> 1]; const unsigned wx = (q & 1) ? w4.z : w4.x, wy = (q & 1) ? w4.w : w4.y; t[q] = (f32x4){bf_lo(wx), bf_hi(wx), bf_lo(wy), bf_hi(wy)}; ss += t[q].x * t[q].x + t[q].y * t[q].y + t[q].z * t[q].z + t[q].w * t[q].w; }
        const float rinv = rsqrtf(wave_sum(ss) * (1.0f / DM) + EPS);
        const float* gate = ada_ptr(a, l_gate, R, gate_chunk);
#pragma unroll
        for (int q = 0; q < 4; ++q) { const f32x4 g = *(const f32x4*)(gpost + RCOL(q)), gt = *(const f32x4*)(gate + RCOL(q)); v[q] = v[q] + gt * (t[q] * rinv * g); }
    }
    if (has_upd2) {
        f32x4 t[4]; float ss = 0.f;
#pragma unroll
        for (int q = 0; q < 4; ++q) { const u32x4 w4 = in.t2[q >> 1]; const unsigned wx = (q & 1) ? w4.z : w4.x, wy = (q & 1) ? w4.w : w4.y; t[q] = (f32x4){bf_lo(wx), bf_hi(wx), bf_lo(wy), bf_hi(wy)}; ss += t[q].x * t[q].x + t[q].y * t[q].y + t[q].z * t[q].z + t[q].w * t[q].w; }
        const float rinv = rsqrtf(wave_sum(ss) * (1.0f / DM) + EPS);
        const float* gate = ada_ptr(a, l_gate, R, gate_chunk2);
#pragma unroll
        for (int q = 0; q < 4; ++q) { const f32x4 g = *(const f32x4*)(gpost2 + RCOL(q)), gt = *(const f32x4*)(gate + RCOL(q)); v[q] = v[q] + gt * (t[q] * rinv * g); }
    }
    if (has_upd || has_upd2) {
        if (write_x) {
#pragma unroll
            for (int q = 0; q < 4; ++q) *(f32x4*)(xout + xo + RCOL(q)) = v[q];
        }
    }
    if (has_hn) {
        float ss = 0.f;
#pragma unroll
        for (int q = 0; q < 4; ++q) ss += v[q].x * v[q].x + v[q].y * v[q].y + v[q].z * v[q].z + v[q].w * v[q].w;
        const float rinv = rsqrtf(wave_sum(ss) * (1.0f / DM) + EPS);
        const float* sh = ada_ptr(a, l_mod, R, sh_chunk); const float* sc = sh + DM;
        bf16* HN = (bf16*)(a.ws + WS_HN) + (size_t)R * DM; u32x2 hw[4];
#pragma unroll
        for (int q = 0; q < 4; ++q) { const f32x4 g = *(const f32x4*)(gpre + RCOL(q)), s1 = *(const f32x4*)(sc + RCOL(q)), s0 = *(const f32x4*)(sh + RCOL(q));
            const f32x4 h = (v[q] * rinv * g) * (s1 + 1.0f) + s0; hw[q].x = pk2(h.x, h.y); hw[q].y = pk2(h.z, h.w); }
#pragma unroll
        for (int h2 = 0; h2 < 2; ++h2) *(u32x4*)(HN + 8 * lane + 512 * h2) = (u32x4){hw[2 * h2].x, hw[2 * h2].y, hw[2 * h2 + 1].x, hw[2 * h2 + 1].y};
    }
}
__device__ __forceinline__ void rows_update(const Args& a, int gw, int NGW, int lane, bool has_upd, bool xin_from_inputs, const float* gpost, int l_gate, int gate_chunk,
                                            bool write_x, bool has_hn, const float* gpre, int l_mod, int sh_chunk, bool lat_only = false, bool has_upd2 = false, const float* gpost2 = nullptr, int gate_chunk2 = 0) {
    const int NR = lat_only ? NB * SEQ : MROWS;
#define ROWMAP(i) (lat_only ? (((i) >> 12) * TPB + ((i) & 4095)) : (i))
    int Ri = gw; if (Ri >= NR) return;
    int R = ROWMAP(Ri);
    RowIn cur, nxt; row_load(a, R, lane, has_upd, xin_from_inputs, cur, has_upd2);
    nxt = cur; { const int Ri1 = Ri + NGW; if (Ri1 < NR) row_load(a, ROWMAP(Ri1), lane, has_upd, xin_from_inputs, nxt, has_upd2); }
    for (;;) {
        const int Ri2 = Ri + 2 * NGW; RowIn nx2 = nxt;
        if (Ri2 < NR) row_load(a, ROWMAP(Ri2), lane, has_upd, xin_from_inputs, nx2, has_upd2);
        row_compute(a, R, lane, cur, has_upd, gpost, l_gate, gate_chunk, write_x, has_hn, gpre, l_mod, sh_chunk, has_upd2, gpost2, gate_chunk2);
        Ri += NGW; if (Ri >= NR) break;
        R = ROWMAP(Ri); cur = nxt; nxt = nx2;
    }
#undef ROWMAP
}

struct FeatIn { u32x4 w[5]; };
__device__ __forceinline__ void feat_load(const Args& a, int R, int lane, FeatIn& in) {
    const bf16* F = (const bf16*)(a.ws + WS_FEAT) + (size_t)R * DINP; const u32x4 zero4 = (u32x4){0u, 0u, 0u, 0u};
    in.w[0] = *(const u32x4*)(F + C_AQ + 8 * lane);
    in.w[1] = (lane < 32) ? *(const u32x4*)(F + C_AK + 8 * lane) : zero4;
    in.w[2] = (lane < 24) ? *(const u32x4*)(F + C_BQD + 8 * lane) : zero4;
    in.w[3] = (lane < 16) ? *(const u32x4*)(F + C_BKVD + 8 * lane) : zero4;
    in.w[4] = (lane < 4) ? *(const u32x4*)(F + C_BKR + 8 * lane) : zero4;
}
__device__ __forceinline__ void feat_row(const Args& a, int l, int R, int lane, const FeatIn& in) {
    const float* tab = (const float*)(a.ws + WS_TAB); const float* cosA = tab, *sinA = tab + 1024, *cosB = tab + 2048, *sinB = tab + 2560;
    const int j = R % TPB; const bool lat = j < SEQ; const int rowid = j >> 6, colid = j & 63;
    {
        float f[8]; unpack8(in.w[0], f);
        float ss = 0.f;
#pragma unroll
        for (int e = 0; e < 8; ++e) ss += f[e] * f[e];
        ss += __shfl_xor(ss, 1); ss += __shfl_xor(ss, 2); ss += __shfl_xor(ss, 4);
        const float rinv = rsqrtf(ss * (1.0f / 64.0f) + EPS);
        const float* gn = a.in[I_AQN] + l * 64 + 8 * (lane & 7);
#pragma unroll
        for (int e = 0; e < 8; ++e) f[e] = f[e] * rinv * gn[e];
        float pr[8];
#pragma unroll
        for (int e = 0; e < 8; ++e) pr[e] = __shfl_xor(f[e], 4);
        if (lat) {
            const int blk = lane & 3; const int pos = (blk < 2) ? rowid : colid; const float* cp = cosA + pos * 16 + 8 * (blk & 1), *sp = sinA + pos * 16 + 8 * (blk & 1);
            const float sg = ((lane & 7) < 4) ? -1.0f : 1.0f;
#pragma unroll
            for (int e = 0; e < 8; ++e) f[e] = f[e] * cp[e] + sg * pr[e] * sp[e];
        }
#pragma unroll
        for (int e = 0; e < 8; ++e) f[e] *= QSCALE_A;
        *(u32x4*)((bf16*)(a.ws + WS_QA) + (size_t)R * 512 + 8 * lane) = pack8(f);
    }
    {
        float f[8]; const u32x4 w = in.w[1]; unpack8(w, f);
        float ss = 0.f;
#pragma unroll
        for (int e = 0; e < 8; ++e) ss += f[e] * f[e];
        ss += __shfl_xor(ss, 1); ss += __shfl_xor(ss, 2); ss += __shfl_xor(ss, 4);
        const float rinv = rsqrtf(ss * (1.0f / 64.0f) + EPS);
        const float* gn = a.in[I_AKN] + l * 64 + 8 * (lane & 7);
        float g[8];
#pragma unroll
        for (int e = 0; e < 8; ++e) g[e] = f[e] * rinv * gn[e];
        float pr[8];
#pragma unroll
        for (int e = 0; e < 8; ++e) pr[e] = __shfl_xor(g[e], 4);
        if (lat) {
            const int blk = lane & 3; const int pos = (blk < 2) ? rowid : colid; const float* cp = cosA + pos * 16 + 8 * (blk & 1), *sp = sinA + pos * 16 + 8 * (blk & 1);
            const float sg = ((lane & 7) < 4) ? -1.0f : 1.0f;
#pragma unroll
            for (int e = 0; e < 8; ++e) g[e] = g[e] * cp[e] + sg * pr[e] * sp[e];
        }
        if (lane < 16) *(u32x4*)((bf16*)(a.ws + WS_KA) + (size_t)R * 128 + 8 * lane) = pack8(g);
        else if (lane < 32) *(u32x4*)((bf16*)(a.ws + WS_VA) + (size_t)R * 128 + 8 * (lane - 16)) = w;
    }
    {
        float f[8]; unpack8(in.w[2], f);
        float ss = 0.f;
#pragma unroll
        for (int e = 0; e < 8; ++e) ss += f[e] * f[e];
        const float rinv = rsqrtf(wave_sum(ss) * (1.0f / 192.0f) + EPS);
        if (lane < 24) { const float* gn = a.in[I_BQN] + l * 192 + 8 * lane;
#pragma unroll
            for (int e = 0; e < 8; ++e) f[e] = f[e] * rinv * gn[e]; }
        if (lane < 32) *(u32x4*)((bf16*)(a.ws + WS_BQD) + (size_t)R * 256 + 8 * lane) = pack8(f);
    }
    {
        float f[8]; unpack8(in.w[3], f);
        float ss = 0.f;
#pragma unroll
        for (int e = 0; e < 8; ++e) ss += f[e] * f[e];
        const float rinv = rsqrtf(wave_sum(ss) * (1.0f / 128.0f) + EPS);
        if (lane < 16) { const float* gn = a.in[I_BKVN] + l * 128 + 8 * lane;
#pragma unroll
            for (int e = 0; e < 8; ++e) f[e] = f[e] * rinv * gn[e];
            *(u32x4*)((bf16*)(a.ws + WS_BKVD) + (size_t)R * 128 + 8 * lane) = pack8(f); }
    }
    {
        float f[8]; unpack8(in.w[4], f);
        float pr[8];
#pragma unroll
        for (int e = 0; e < 8; ++e) pr[e] = __shfl_xor(f[e], 2);
        if (lat) {
            const int pos = ((lane & 1) == 0) ? rowid : colid; const float* cp = cosB + pos * 8, *sp = sinB + pos * 8;
            const float sg = ((lane & 3) < 2) ? -1.0f : 1.0f;
#pragma unroll
            for (int e = 0; e < 8; ++e) f[e] = f[e] * cp[e] + sg * pr[e] * sp[e];
        }
        if (lane < 4) { const u32x4 o = pack8(f); bf16* kb = (bf16*)(a.ws + WS_KB) + (size_t)R * 384 + 64 + 8 * lane;
#pragma unroll
            for (int h = 0; h < 4; ++h) *(u32x4*)(kb + h * 96) = o; }
    }
}

struct ReadIn { f32x4 of, ob; u32x2 g; };
__device__ __forceinline__ void readout_load(const Args& a, int R, int lane, ReadIn& in) {
    in.of = *(const f32x4*)((const float*)(a.ws + WS_OF) + (size_t)R * 256 + 4 * lane); in.ob = *(const f32x4*)((const float*)(a.ws + WS_OB) + (size_t)R * 256 + 4 * lane);
    in.g = *(const u32x2*)((const bf16*)(a.ws + WS_CFG) + (size_t)R * 256 + 4 * lane);
}
__device__ __forceinline__ void readout_row(const Args& a, int l, int R, int lane, const ReadIn& in) {
    const f32x4 of = in.of, ob = in.ob;
    const f32x4 o = of + ob;
    float ss = o.x * o.x + o.y * o.y + o.z * o.z + o.w * o.w;
    ss += __shfl_xor(ss, 1); ss += __shfl_xor(ss, 2); ss += __shfl_xor(ss, 4); ss += __shfl_xor(ss, 8);
    const float rinv = rsqrtf(ss * (1.0f / 64.0f) + EPS);
    const f32x4 gn = *(const f32x4*)(a.in[I_CON] + l * 64 + 4 * (lane & 15));
    const u32x2 gw = in.g;
    const f32x4 y = o * rinv * gn;
    u32x2 w; w.x = pk2(y.x * siluf_(bf_lo(gw.x)), y.y * siluf_(bf_hi(gw.x))); w.y = pk2(y.z * siluf_(bf_lo(gw.y)), y.w * siluf_(bf_hi(gw.y)));
    *(u32x2*)((bf16*)(a.ws + WS_Y) + (size_t)R * DM + 768 + 4 * lane) = w;
}

typedef float att_f32x2 __attribute__((ext_vector_type(2)));
__device__ __forceinline__ int att_imax(int a, int b) { return a > b ? a : b; }
typedef short att_v4i16 __attribute__((ext_vector_type(4)));
__device__ __forceinline__ s16x4 att_vtr(const LAS unsigned char* p) { return __builtin_bit_cast(s16x4, __builtin_amdgcn_ds_read_tr16_b64_v4i16((LAS att_v4i16*)p)); }
template <int DQ>
__device__ __forceinline__ void attn_unit(LAS unsigned char* lds, const bf16* Q, int qpitch, const bf16* K, int kpitch, const bf16* V, int vpitch, bf16* O, int opitch, int ns) {
    constexpr int KS = DQ * 2 + 16, VS = 144  , NKC = DQ / 8  , NKL = (128 * NKC) / NTHR, KBYTES = 128 * KS, BUF = KBYTES + 128 * VS;
    constexpr float THR = 64.0f;
    int tid_l = threadIdx.x; asm volatile("" : "+v"(tid_l)); const int tid = tid_l, lane = tid & 63, wid = tid >> 6, r32 = lane & 31, hi = lane >> 5;
    bf16x8 qf[DQ / 16];
#pragma unroll
    for (int d0 = 0; d0 < DQ / 16; ++d0) qf[d0] = *(const bf16x8*)(Q + (size_t)(wid * 32 + r32) * qpitch + d0 * 16 + hi * 8);
    f32x16 o0, o1;
#pragma unroll
    for (int r = 0; r < 16; ++r) { o0[r] = 0.f; o1[r] = 0.f; }
    bool mz = true;
    float mrun = 0.f, lrun = 0.f;
    u32x4 kreg[NKL], vreg[2];
#define ATT_LOAD(t) do { _Pragma("unroll") for (int i_ = 0; i_ < NKL; ++i_) { const int c_ = tid + NTHR * i_; kreg[i_] = *(const u32x4*)(K + (size_t)((t) * 128 + c_ / NKC) * kpitch + (c_ % NKC) * 8); } \
        _Pragma("unroll") for (int j_ = 0; j_ < 2; ++j_) { const int c_ = tid + NTHR * j_; vreg[j_] = *(const u32x4*)(V + (size_t)((t) * 128 + (c_ >> 3)) * vpitch + (c_ & 7) * 8); } } while (0)
#define ATT_PUT(buf) do { LAS unsigned char* kb_ = lds + (buf) * BUF; \
        _Pragma("unroll") for (int i_ = 0; i_ < NKL; ++i_) { const int c_ = tid + NTHR * i_; *(LAS u32x4*)(kb_ + (c_ / NKC) * KS + (c_ % NKC) * 16) = kreg[i_]; } \
        _Pragma("unroll") for (int j_ = 0; j_ < 2; ++j_) { const int c_ = tid + NTHR * j_; *(LAS u32x4*)(kb_ + KBYTES + (c_ >> 3) * VS + (c_ & 7) * 16) = vreg[j_]; } } while (0)
    ATT_LOAD(0);
    ATT_PUT(0);
    if (ns > 1) ATT_LOAD(1);
    __syncthreads();
    for (int t = 0; t < ns; ++t) {
        if (t + 1 < ns) { ATT_PUT((t + 1) & 1); if (t + 2 < ns) ATT_LOAD(t + 2); }
        const LAS unsigned char* Ks = lds + (t & 1) * BUF; const LAS unsigned char* Vt = Ks + KBYTES;
        constexpr int ND = DQ / 16;
#define ATT_KRD(SUB, KF) do { _Pragma("unroll") for (int d0 = 0; d0 < ND; ++d0) { KF[2 * d0] = *(const LAS bf16x8*)(Ks + (64 * (SUB) + r32) * KS + d0 * 32 + hi * 16); KF[2 * d0 + 1] = *(const LAS bf16x8*)(Ks + (64 * (SUB) + 32 + r32) * KS + d0 * 32 + hi * 16); } } while (0)
#define ATT_VRD(SUB, VF) do { const LAS unsigned char* vl_ = Vt + ((((lane & 15) >> 2) + 4 * hi) * VS + (16 * ((lane >> 4) & 1) + 4 * (lane & 3)) * 2); \
            _Pragma("unroll") for (int ks = 0; ks < 4; ++ks) { const LAS unsigned char* vr_ = vl_ + (64 * (SUB) + 16 * ks) * VS; \
            VF[4 * ks + 0] = att_vtr(vr_); VF[4 * ks + 1] = att_vtr(vr_ + 8 * VS); VF[4 * ks + 2] = att_vtr(vr_ + 64); VF[4 * ks + 3] = att_vtr(vr_ + 8 * VS + 64); } } while (0)
#define ATT_QK(KF, S0, S1) do { _Pragma("unroll") for (int d0 = 0; d0 < ND; ++d0) { \
            if (d0 == 0) { if (mz) { const f32x16 z_ = {0.f, 0.f, 0.f, 0.f, 0.f, 0.f, 0.f, 0.f, 0.f, 0.f, 0.f, 0.f, 0.f, 0.f, 0.f, 0.f}; \
                    S0 = __builtin_amdgcn_mfma_f32_32x32x16_bf16(KF[0], qf[0], z_, 0, 0, 0); S1 = __builtin_amdgcn_mfma_f32_32x32x16_bf16(KF[1], qf[0], z_, 0, 0, 0); } \
                else { f32x16 nm_; _Pragma("unroll") for (int r = 0; r < 16; ++r) nm_[r] = -mrun; \
                    S0 = __builtin_amdgcn_mfma_f32_32x32x16_bf16(KF[0], qf[0], nm_, 0, 0, 0); S1 = __builtin_amdgcn_mfma_f32_32x32x16_bf16(KF[1], qf[0], nm_, 0, 0, 0); } } \
            else { S0 = __builtin_amdgcn_mfma_f32_32x32x16_bf16(KF[2 * d0], qf[d0], S0, 0, 0, 0); S1 = __builtin_amdgcn_mfma_f32_32x32x16_bf16(KF[2 * d0 + 1], qf[d0], S1, 0, 0, 0); } } } while (0)
#define ATT_MAX(S0, S1, RM) do { float a_ = fmaxf(fmaxf(S0[0], S0[1]), S1[0]), b_ = fmaxf(fmaxf(S0[2], S0[3]), S1[1]); a_ = fmaxf(fmaxf(a_, S1[2]), S1[3]); \
            _Pragma("unroll") for (int r = 4; r < 16; r += 4) { a_ = fmaxf(fmaxf(a_, S0[r]), S0[r + 1]); b_ = fmaxf(fmaxf(b_, S0[r + 2]), S0[r + 3]); a_ = fmaxf(fmaxf(a_, S1[r]), S1[r + 1]); b_ = fmaxf(fmaxf(b_, S1[r + 2]), S1[r + 3]); } \
            RM = fmaxf(a_, b_); auto rr_ = __builtin_amdgcn_permlane32_swap(__float_as_uint(RM), __float_as_uint(RM), false, false); RM = fmaxf(__uint_as_float(rr_[0]), __uint_as_float(rr_[1])); } while (0)
#define ATT_IMAX3(a, b, c) att_imax(att_imax((a), (b)), (c))
#define ATT_SCREEN(S0, S1, HOT) do { int a_ = ATT_IMAX3(__float_as_int(S0[0]), __float_as_int(S0[1]), __float_as_int(S1[0])), b_ = ATT_IMAX3(__float_as_int(S0[2]), __float_as_int(S0[3]), __float_as_int(S1[1])); \
            a_ = ATT_IMAX3(a_, __float_as_int(S1[2]), __float_as_int(S1[3])); \
            _Pragma("unroll") for (int r = 4; r < 16; r += 4) { a_ = ATT_IMAX3(a_, __float_as_int(S0[r]), __float_as_int(S0[r + 1])); b_ = ATT_IMAX3(b_, __float_as_int(S0[r + 2]), __float_as_int(S0[r + 3])); \
                a_ = ATT_IMAX3(a_, __float_as_int(S1[r]), __float_as_int(S1[r + 1])); b_ = ATT_IMAX3(b_, __float_as_int(S1[r + 2]), __float_as_int(S1[r + 3])); } \
            HOT = __any(att_imax(a_, b_) > 0x42800000); } while (0)
#define ATT_RESC(FIRST, S0, S1, RM) do { if ((FIRST) ? __any(fabsf(RM) > THR) : __any(RM > THR)) { const float dl_ = (FIRST) ? RM : fmaxf(RM, 0.f); mrun += dl_; mz = false; \
            _Pragma("unroll") for (int r = 0; r < 16; ++r) { S0[r] -= dl_; S1[r] -= dl_; } \
            if (!(FIRST)) { const float f_ = __builtin_amdgcn_exp2f(-dl_); lrun *= f_; _Pragma("unroll") for (int r = 0; r < 16; ++r) { o0[r] *= f_; o1[r] *= f_; } } } } while (0)
#define ATT_EXP(S0, S1, PB) do { _Pragma("unroll") for (int r = 0; r < 16; ++r) { S0[r] = __builtin_amdgcn_exp2f(S0[r]); S1[r] = __builtin_amdgcn_exp2f(S1[r]); } \
            { att_f32x2 pa_ = (att_f32x2){S0[0], S0[1]} + (att_f32x2){S1[0], S1[1]}, pb_ = (att_f32x2){S0[2], S0[3]} + (att_f32x2){S1[2], S1[3]}; \
              _Pragma("unroll") for (int r = 4; r < 16; r += 4) { pa_ += (att_f32x2){S0[r], S0[r + 1]}; pb_ += (att_f32x2){S0[r + 2], S0[r + 3]}; pa_ += (att_f32x2){S1[r], S1[r + 1]}; pb_ += (att_f32x2){S1[r + 2], S1[r + 3]}; } \
              pa_ += pb_; lrun += pa_.x + pa_.y; } \
            _Pragma("unroll") for (int ks = 0; ks < 4; ++ks) { u32x4 w_; const int b_ = 8 * (ks & 1); \
                if (ks < 2) { w_.x = pk2(S0[b_ + 0], S0[b_ + 1]); w_.y = pk2(S0[b_ + 2], S0[b_ + 3]); w_.z = pk2(S0[b_ + 4], S0[b_ + 5]); w_.w = pk2(S0[b_ + 6], S0[b_ + 7]); } \
                else { w_.x = pk2(S1[b_ + 0], S1[b_ + 1]); w_.y = pk2(S1[b_ + 2], S1[b_ + 3]); w_.z = pk2(S1[b_ + 4], S1[b_ + 5]); w_.w = pk2(S1[b_ + 6], S1[b_ + 7]); } \
                PB[ks] = __builtin_bit_cast(bf16x8, w_); } } while (0)
#define ATT_EXPK(S0, S1, PB, PS) do { att_f32x2 pa_ = (att_f32x2){0.f, 0.f}, pb_ = (att_f32x2){0.f, 0.f}; \
            _Pragma("unroll") for (int ks = 0; ks < 4; ++ks) { const int b_ = 8 * (ks & 1); float e_[8]; \
                _Pragma("unroll") for (int i_ = 0; i_ < 8; ++i_) e_[i_] = __builtin_amdgcn_exp2f((ks < 2) ? S0[b_ + i_] : S1[b_ + i_]); \
                pa_ += (att_f32x2){e_[0], e_[1]}; pb_ += (att_f32x2){e_[2], e_[3]}; pa_ += (att_f32x2){e_[4], e_[5]}; pb_ += (att_f32x2){e_[6], e_[7]}; \
                u32x4 w_; w_.x = pk2(e_[0], e_[1]); w_.y = pk2(e_[2], e_[3]); w_.z = pk2(e_[4], e_[5]); w_.w = pk2(e_[6], e_[7]); PB[ks] = __builtin_bit_cast(bf16x8, w_); } \
            pa_ += pb_; PS = pa_.x + pa_.y; } while (0)
#define ATT_FORCE(S0, S1, RM) do { const float dl_ = fmaxf(RM, 0.f); mrun += dl_; mz = false; const float f_ = __builtin_amdgcn_exp2f(-dl_); lrun *= f_; \
            _Pragma("unroll") for (int r = 0; r < 16; ++r) { S0[r] -= dl_; S1[r] -= dl_; o0[r] *= f_; o1[r] *= f_; } } while (0)
#define ATT_PV(VF, PB) do { _Pragma("unroll") for (int ks = 0; ks < 4; ++ks) { \
            const s16x4 a0_ = VF[4 * ks + 0], a1_ = VF[4 * ks + 1], c0_ = VF[4 * ks + 2], c1_ = VF[4 * ks + 3]; \
            const bf16x8 va_ = (bf16x8){a0_[0], a0_[1], a0_[2], a0_[3], a1_[0], a1_[1], a1_[2], a1_[3]}, vc_ = (bf16x8){c0_[0], c0_[1], c0_[2], c0_[3], c1_[0], c1_[1], c1_[2], c1_[3]}; \
            o0 = __builtin_amdgcn_mfma_f32_32x32x16_bf16(va_, PB[ks], o0, 0, 0, 0); o1 = __builtin_amdgcn_mfma_f32_32x32x16_bf16(vc_, PB[ks], o1, 0, 0, 0); } } while (0)
#define ATT_SB() __builtin_amdgcn_sched_barrier(0)
        f32x16 s0, s1; bf16x8 kf[2 * ND], pb[4]; s16x4 vf[16]; float rm;
        ATT_KRD(0, kf); ATT_SB();
        ATT_QK(kf, s0, s1); ATT_SB();
        ATT_VRD(0, vf); ATT_SB();
        if constexpr (DQ != 64) { ATT_MAX(s0, s1, rm); ATT_RESC(t == 0, s0, s1, rm); ATT_EXP(s0, s1, pb); }
        else {
            if (t == 0) { ATT_MAX(s0, s1, rm); ATT_RESC(true, s0, s1, rm); }
            float ps_; ATT_EXPK(s0, s1, pb, ps_);
            if (__any(!(ps_ <= 0x1p64f))) { ATT_MAX(s0, s1, rm); ATT_FORCE(s0, s1, rm); ATT_EXPK(s0, s1, pb, ps_); }
            lrun += ps_;
        }
        ATT_PV(vf, pb); ATT_SB();
        ATT_KRD(1, kf); ATT_SB();
        ATT_QK(kf, s0, s1); ATT_SB();
        ATT_VRD(1, vf); ATT_SB();
        if constexpr (DQ != 64) { ATT_MAX(s0, s1, rm); ATT_RESC(false, s0, s1, rm); ATT_EXP(s0, s1, pb); }
        else {
            float ps_; ATT_EXPK(s0, s1, pb, ps_);
            if (__any(!(ps_ <= 0x1p64f))) { ATT_MAX(s0, s1, rm); ATT_FORCE(s0, s1, rm); ATT_EXPK(s0, s1, pb, ps_); }
            lrun += ps_;
        }
        ATT_PV(vf, pb);
#undef ATT_KRD
#undef ATT_VRD
#undef ATT_QK
#undef ATT_MAX
#undef ATT_RESC
#undef ATT_SCREEN
#undef ATT_IMAX3
#undef ATT_EXP
#undef ATT_PV
#undef ATT_EXPK
#undef ATT_FORCE
#undef ATT_SB
        __syncthreads();
    }
#undef ATT_LOAD
#undef ATT_PUT
    lrun += __shfl_xor(lrun, 32);
    const float linv = 1.0f / lrun;
    bf16* orow = O + (size_t)(wid * 32 + r32) * opitch;
#pragma unroll
    for (int r4 = 0; r4 < 4; ++r4) {
        u32x2 w0, w1;
        w0.x = pk2(o0[4 * r4 + 0] * linv, o0[4 * r4 + 1] * linv); w0.y = pk2(o0[4 * r4 + 2] * linv, o0[4 * r4 + 3] * linv);
        w1.x = pk2(o1[4 * r4 + 0] * linv, o1[4 * r4 + 1] * linv); w1.y = pk2(o1[4 * r4 + 2] * linv, o1[4 * r4 + 3] * linv);
        *(u32x2*)(orow + 8 * r4 + 4 * hi) = w0; *(u32x2*)(orow + 32 + 8 * r4 + 4 * hi) = w1;
    }
}

typedef float f32x2 __attribute__((ext_vector_type(2)));
__device__ __forceinline__ float dpp_xor1(float v) { return __int_as_float(__builtin_amdgcn_update_dpp(0, __float_as_int(v), 0xB1, 0xF, 0xF, true)); }
__device__ __forceinline__ float dpp_xor2(float v) { return __int_as_float(__builtin_amdgcn_update_dpp(0, __float_as_int(v), 0x4E, 0xF, 0xF, true)); }
__device__ __forceinline__ float dpp_hmir(float v) { return __int_as_float(__builtin_amdgcn_update_dpp(0, __float_as_int(v), 0x141, 0xF, 0xF, true)); }
__device__ __forceinline__ void scan_unit(LAS unsigned char* lds, const Args& a, int l, int b, int h) {
    int tid_l = threadIdx.x; asm volatile("" : "+v"(tid_l)); const int tid = tid_l, lane = tid & 63, wid = tid >> 6, dvl = lane >> 3, dkg = lane & 7;
    const int cw = __builtin_amdgcn_readfirstlane(wid); const int dir = (cw >> 1) & 1, wq = cw & 1;
    LAS float* myq = (LAS float*)(lds + dir * 65536); LAS float* myk = myq + 4096; LAS float* myv = myk + 4096; LAS float* myo = myv + 4096;
    const bf16* CQ = (const bf16*)(a.ws + WS_CFQ); const bf16* CKF = (const bf16*)(a.ws + WS_CKF); const bf16* CKB = (const bf16*)(a.ws + WS_CKB); const bf16* CV = (const bf16*)(a.ws + WS_CFV);
    float* OF = (float*)(a.ws + WS_OF); float* OB = (float*)(a.ws + WS_OB);
    const int rb = b * TPB, col = h * 64;
    f32x2 S[16];
#pragma unroll
    for (int e = 0; e < 16; ++e) S[e] = (f32x2){0.f, 0.f};
    const int li = tid >> 3, lc = tid & 7;
    u32x4 rq0, rk0, rv0, rq1, rk1, rv1;
#define SCAN_FB(c) (((c) < 4) ? (SEQ + 64 * (c)) : 64 * ((c) - 4))
#define SCAN_BB(c) (((c) < 4) ? (TPB - 1 - 64 * (c)) : (SEQ - 1 - 64 * ((c) - 4)))
#define SCAN_LOAD(c) do { const size_t rf_ = (size_t)(rb + SCAN_FB(c) + li) * 256 + col + 8 * lc, rb_ = (size_t)(rb + SCAN_BB(c) - li) * 256 + col + 8 * lc; \
        rq0 = *(const u32x4*)(CQ + rf_); rk0 = *(const u32x4*)(CKF + rf_); rv0 = *(const u32x4*)(CV + rf_); rq1 = *(const u32x4*)(CQ + rb_); rk1 = *(const u32x4*)(CKB + rb_); rv1 = *(const u32x4*)(CV + rb_); } while (0)
#define SCAN_PUT(base, w) do { float f_[8]; unpack8(w, f_); *(LAS f32x4*)((base) + li * 64 + 8 * lc) = (f32x4){f_[0], f_[1], f_[2], f_[3]}; *(LAS f32x4*)((base) + li * 64 + 8 * lc + 4) = (f32x4){f_[4], f_[5], f_[6], f_[7]}; } while (0)
#define SCAN_FLUSH(c) do { LAS float* o0_ = (LAS float*)(lds + 49152) + li * 64 + 8 * lc; LAS float* o1_ = (LAS float*)(lds + 65536 + 49152) + li * 64 + 8 * lc; \
        float* pf_ = OF + (size_t)(rb + SCAN_FB(c) + li) * 256 + col + 8 * lc; float* pb_ = OB + (size_t)(rb + SCAN_BB(c) - li) * 256 + col + 8 * lc; \
        *(f32x4*)pf_ = *(const LAS f32x4*)o0_; *(f32x4*)(pf_ + 4) = *(const LAS f32x4*)(o0_ + 4); *(f32x4*)pb_ = *(const LAS f32x4*)o1_; *(f32x4*)(pb_ + 4) = *(const LAS f32x4*)(o1_ + 4); } while (0)
    SCAN_LOAD(0);
    for (int c = 0; c < 68; ++c) {
        __syncthreads();
        if (c > 0) SCAN_FLUSH(c - 1);
        { LAS float* q0_ = (LAS float*)lds; LAS float* q1_ = (LAS float*)(lds + 65536);
          SCAN_PUT(q0_, rq0); SCAN_PUT(q0_ + 4096, rk0); SCAN_PUT(q0_ + 8192, rv0); SCAN_PUT(q1_, rq1); SCAN_PUT(q1_ + 4096, rk1); SCAN_PUT(q1_ + 8192, rv1); }
        __syncthreads();
        if (c + 1 < 68) SCAN_LOAD(c + 1);
        if (cw < 4) {
        f32x4 q0 = *(const LAS f32x4*)(myq + 8 * dkg), q1 = *(const LAS f32x4*)(myq + 8 * dkg + 4);
        f32x4 k0 = *(const LAS f32x4*)(myk + 8 * dkg), k1 = *(const LAS f32x4*)(myk + 8 * dkg + 4);
        f32x4 vv = *(const LAS f32x4*)(myv + 32 * wq + 4 * dvl);
        const bool lb0 = (lane & 1) != 0, lb1 = (lane & 2) != 0, lb2 = (lane & 4) != 0;
        for (int i0 = 0; i0 < 64; i0 += 4) {
            float val[4][4];
#pragma unroll
            for (int j = 0; j < 4; ++j) {
                const int in_ = (i0 + j + 1) & 63;
                const f32x4 nq0 = *(const LAS f32x4*)(myq + in_ * 64 + 8 * dkg), nq1 = *(const LAS f32x4*)(myq + in_ * 64 + 8 * dkg + 4);
                const f32x4 nk0 = *(const LAS f32x4*)(myk + in_ * 64 + 8 * dkg), nk1 = *(const LAS f32x4*)(myk + in_ * 64 + 8 * dkg + 4);
                const f32x4 nvv = *(const LAS f32x4*)(myv + in_ * 64 + 32 * wq + 4 * dvl);
                const f32x2 va = (f32x2){vv.x, vv.y}, vb = (f32x2){vv.z, vv.w};
                f32x2 a0 = (f32x2){0.f, 0.f}, a1 = a0, b0 = a0, b1 = a0;
#pragma unroll
                for (int e = 0; e < 4; ++e) {
                    const f32x2 kk0 = (f32x2){k0[e], k0[e]}, qq0 = (f32x2){q0[e], q0[e]}, kk1 = (f32x2){k1[e], k1[e]}, qq1 = (f32x2){q1[e], q1[e]};
                    S[e] = kk0 * (va - S[e]) + S[e];             a0 = S[e] * qq0 + a0;
                    S[8 + e] = kk0 * (vb - S[8 + e]) + S[8 + e];   b0 = S[8 + e] * qq0 + b0;
                    S[4 + e] = kk1 * (va - S[4 + e]) + S[4 + e];   a1 = S[4 + e] * qq1 + a1;
                    S[12 + e] = kk1 * (vb - S[12 + e]) + S[12 + e]; b1 = S[12 + e] * qq1 + b1;
                }
                const f32x2 acca = a0 + a1, accb = b0 + b1;
                val[j][0] = acca.x; val[j][1] = acca.y; val[j][2] = accb.x; val[j][3] = accb.y;
                q0 = nq0; q1 = nq1; k0 = nk0; k1 = nk1; vv = nvv;
            }
            float r1[8];
#pragma unroll
            for (int jl = 0; jl < 2; ++jl)
#pragma unroll
                for (int c = 0; c < 4; ++c) { const float lo = val[jl][c], hi = val[2 + jl][c]; const float keep = lb0 ? hi : lo, send = lb0 ? lo : hi; r1[jl * 4 + c] = keep + dpp_xor1(send); }
            float r2[4];
#pragma unroll
            for (int c = 0; c < 4; ++c) { const float lo = r1[c], hi = r1[4 + c]; const float keep = lb1 ? hi : lo, send = lb1 ? lo : hi; r2[c] = keep + dpp_xor2(send); }
            f32x2 r3;
            { const float k0_ = lb2 ? r2[2] : r2[0], s0_ = lb2 ? r2[0] : r2[2], k1_ = lb2 ? r2[3] : r2[1], s1_ = lb2 ? r2[1] : r2[3];
              r3.x = k0_ + __shfl_xor(s0_, 4); r3.y = k1_ + __shfl_xor(s1_, 4); }
            *(LAS f32x2*)(myo + (i0 + 2 * (lane & 1) + ((lane >> 1) & 1)) * 64 + 32 * wq + 4 * dvl + 2 * ((lane >> 2) & 1)) = r3;
        }
        }
    }
    __syncthreads();
    SCAN_FLUSH(67);
    __threadfence();
    __syncthreads();
    {
        const int rl = tid >> 4, c4 = (tid & 15) * 4;
        const f32x4 gn = *(const f32x4*)(a.in[I_CON] + l * 64 + c4);
        const bf16* CG = (const bf16*)(a.ws + WS_CFG); bf16* Y = (bf16*)(a.ws + WS_Y);
        for (int r0 = 0; r0 < TPB; r0 += 128) {
            f32x4 of[4], ob4[4]; u32x2 gw4[4];
#pragma unroll
            for (int p = 0; p < 4; ++p) { const size_t ro = (size_t)(rb + r0 + 32 * p + rl) * 256 + col + c4; of[p] = *(const f32x4*)(OF + ro); ob4[p] = *(const f32x4*)(OB + ro); gw4[p] = *(const u32x2*)(CG + ro); }
#pragma unroll
            for (int p = 0; p < 4; ++p) {
                const f32x4 o = of[p] + ob4[p];
                float ss = o.x * o.x + o.y * o.y + o.z * o.z + o.w * o.w;
                ss += __shfl_xor(ss, 1); ss += __shfl_xor(ss, 2); ss += __shfl_xor(ss, 4); ss += __shfl_xor(ss, 8);
                const float rinv = rsqrtf(ss * (1.0f / 64.0f) + EPS);
                const f32x4 y = o * rinv * gn; const u32x2 g2 = gw4[p];
                u32x2 w; w.x = pk2(y.x * siluf_(bf_lo(g2.x)), y.y * siluf_(bf_hi(g2.x))); w.y = pk2(y.z * siluf_(bf_lo(g2.y)), y.w * siluf_(bf_hi(g2.y)));
                *(u32x2*)(Y + (size_t)(rb + r0 + 32 * p + rl) * DM + 768 + col + c4) = w;
            }
        }
    }
    __syncthreads();
#undef SCAN_FB
#undef SCAN_BB
#undef SCAN_LOAD
#undef SCAN_PUT
#undef SCAN_FLUSH
}

template <class Epi>
__device__ __forceinline__ void run_gemm(LAS unsigned char* lds, const pg8::Gemm& g, const Epi& E, int G, bool lat_only) {
    if (lat_only) { pg8::LatOrder S; S.init(g.N, G, (int)blockIdx.x); pg8::gemm_phase<Epi, pg8::LatOrder, true, true>(lds, g, S, E); }
    else { pg8::StaticOrder S; S.init(g.M, g.N, G, (int)blockIdx.x); pg8::gemm_phase<Epi, pg8::StaticOrder, true, true>(lds, g, S, E); }
}
struct EpiFeat2 {
    static constexpr bool PERM = true, AFTER_DRAIN = false;
    unsigned char* ws; const float* aqn; const float* akn; const float* clb; int layer;
    __device__ __forceinline__ void operator()(const f32x4 (&acc)[2][2][4][2], const pg8::Unit& u, int wr, int wc, int fr, int fq) const {
        const int row0 = u.pm * 256 + wr * 64 + fr, pn = u.pn;
        const float* tab = (const float*)(ws + WS_TAB);
        if (pn <= 2) {
            const bool is_v = (pn == 2 && wc >= 2);
            const float* gain = (pn < 2) ? aqn : akn;
            f32x4 g[2][2];
#pragma unroll
            for (int bj = 0; bj < 2; ++bj)
#pragma unroll
                for (int n = 0; n < 2; ++n) g[bj][n] = *(const f32x4*)(gain + 32 * bj + 8 * fq + 4 * n);
            bf16* dst; int ld;
            if (pn < 2) { dst = (bf16*)(ws + WS_QA) + (4 * pn + wc) * 64; ld = 512; } else if (wc < 2) { dst = (bf16*)(ws + WS_KA) + wc * 64; ld = 128; } else { dst = (bf16*)(ws + WS_VA) + (wc - 2) * 64; ld = 128; }
            const float osc = (pn < 2) ? QSCALE_A : 1.0f;
#pragma unroll
            for (int ai = 0; ai < 2; ++ai)
#pragma unroll
                for (int mm = 0; mm < 4; ++mm) {
                    const int row = row0 + ai * 128 + mm * 16; const int j = row % TPB;
                    f32x4 x[2][2];
#pragma unroll
                    for (int bj = 0; bj < 2; ++bj)
#pragma unroll
                        for (int n = 0; n < 2; ++n) x[bj][n] = acc[ai][bj][mm][n];
                    if (!is_v) {
                        float ss = 0.f;
#pragma unroll
                        for (int bj = 0; bj < 2; ++bj)
#pragma unroll
                            for (int n = 0; n < 2; ++n) ss += x[bj][n].x * x[bj][n].x + x[bj][n].y * x[bj][n].y + x[bj][n].z * x[bj][n].z + x[bj][n].w * x[bj][n].w;
                        ss += __shfl_xor(ss, 16); ss += __shfl_xor(ss, 32);
                        const float rinv = rsqrtf(ss * (1.0f / 64.0f) + EPS);
#pragma unroll
                        for (int bj = 0; bj < 2; ++bj)
#pragma unroll
                            for (int n = 0; n < 2; ++n) x[bj][n] = x[bj][n] * rinv * g[bj][n];
                        if (j < SEQ) {
                            const int pos = (fq < 2) ? (j >> 6) : (j & 63);
#pragma unroll
                            for (int n = 0; n < 2; ++n) { const f32x4 cs = *(const f32x4*)(tab + pos * 16 + 8 * (fq & 1) + 4 * n), sn = *(const f32x4*)(tab + 1024 + pos * 16 + 8 * (fq & 1) + 4 * n);
                                const f32x4 a_ = x[0][n] * cs - x[1][n] * sn, b_ = x[1][n] * cs + x[0][n] * sn; x[0][n] = a_; x[1][n] = b_; }
                        }
#pragma unroll
                        for (int bj = 0; bj < 2; ++bj)
#pragma unroll
                            for (int n = 0; n < 2; ++n) x[bj][n] = x[bj][n] * osc;
                    }
#pragma unroll
                    for (int bj = 0; bj < 2; ++bj) { u32x4 w; w.x = pk2(x[bj][0].x, x[bj][0].y); w.y = pk2(x[bj][0].z, x[bj][0].w); w.z = pk2(x[bj][1].x, x[bj][1].y); w.w = pk2(x[bj][1].z, x[bj][1].w);
                        *(u32x4*)(dst + (size_t)row * ld + 32 * bj + 8 * fq) = w; }
                    asm volatile("" ::: "memory");
                }
            return;
        }
#pragma unroll
        for (int bj = 0; bj < 2; ++bj) {
            const int c0 = pn * 256 + bj * 128 + wc * 32 + 8 * fq;
            if (c0 >= 2400) continue;
            if (c0 < 1088) {
                const bool isq = c0 < 960; const int dd = isq ? (c0 - 768) : (c0 - 960);
                bf16* dst = isq ? ((bf16*)(ws + WS_BQD) + dd) : ((bf16*)(ws + WS_BKVD) + dd); const int ld = isq ? 256 : 128;
                float* ssq = isq ? (float*)(ws + WS_SSQ_Q) : (float*)(ws + WS_SSQ_KV);
                const int grp = dd >> 5;
#pragma unroll
                for (int ai = 0; ai < 2; ++ai)
#pragma unroll
                    for (int mm = 0; mm < 4; ++mm) {
                        const int row = row0 + ai * 128 + mm * 16;
                        const f32x4 v0 = acc[ai][bj][mm][0], v1 = acc[ai][bj][mm][1];
                        float ss = v0.x * v0.x + v0.y * v0.y + v0.z * v0.z + v0.w * v0.w + v1.x * v1.x + v1.y * v1.y + v1.z * v1.z + v1.w * v1.w;
                        ss += __shfl_xor(ss, 16); ss += __shfl_xor(ss, 32);
                        if (fq == 0) ssq[(size_t)row * (isq ? 8 : 4) + grp] = ss;
                        u32x4 w; w.x = pk2(v0.x, v0.y); w.y = pk2(v0.z, v0.w); w.z = pk2(v1.x, v1.y); w.w = pk2(v1.z, v1.w);
                        *(u32x4*)(dst + (size_t)row * ld) = w;
                        if (!isq && grp < 2) *(u32x4*)((bf16*)(ws + WS_BQD) + (size_t)row * 256 + 192 + dd) = (u32x4){0u, 0u, 0u, 0u};
                    }
                continue;
            }
            if (c0 < 1120) {
                const float* cosB = tab + 2048; const float* sinB = tab + 2560;
#pragma unroll
                for (int ai = 0; ai < 2; ++ai)
#pragma unroll
                    for (int mm = 0; mm < 4; ++mm) {
                        const int row = row0 + ai * 128 + mm * 16; const int j = row % TPB;
                        f32x4 v0 = acc[ai][bj][mm][0], v1 = acc[ai][bj][mm][1];
                        f32x4 p0, p1;
#pragma unroll
                        for (int e = 0; e < 4; ++e) { p0[e] = __shfl_xor(v0[e], 32); p1[e] = __shfl_xor(v1[e], 32); }
                        if (j < SEQ) {
                            const int pos = ((fq & 1) == 0) ? (j >> 6) : (j & 63);
                            const f32x4 c0v = *(const f32x4*)(cosB + pos * 8), c1v = *(const f32x4*)(cosB + pos * 8 + 4), s0v = *(const f32x4*)(sinB + pos * 8), s1v = *(const f32x4*)(sinB + pos * 8 + 4);
                            const float sg = (fq < 2) ? -1.0f : 1.0f;
                            v0 = v0 * c0v + p0 * s0v * sg; v1 = v1 * c1v + p1 * s1v * sg;
                        }
                        u32x4 w; w.x = pk2(v0.x, v0.y); w.y = pk2(v0.z, v0.w); w.z = pk2(v1.x, v1.y); w.w = pk2(v1.z, v1.w);
                        bf16* kb = (bf16*)(ws + WS_KB) + (size_t)row * 384 + 64 + 8 * fq;
#pragma unroll
                        for (int h = 0; h < 4; ++h) *(u32x4*)(kb + h * 96) = w;
                    }
                continue;
            }
            const int seg = (c0 - 1120) >> 8; const int ch = (c0 - 1120) & 255;
            float om[8];
#pragma unroll
            for (int e = 0; e < 8; ++e) om[e] = 1.0f;
            if (layer > 0 && (seg == 1 || seg == 2)) {
                const float* c1 = clb + 512 + (seg - 1) * 256 + ch; const float* c0p = clb + (seg - 1) * 256 + ch;
#pragma unroll
                for (int e = 0; e < 8; ++e) om[e] = 1.0f - 1.0f / (1.0f + __expf(-(c1[e] - c0p[e])));
            }
            bf16* dst = (bf16*)(ws + (seg == 0 ? WS_CFQ : seg == 1 ? WS_CKF : seg == 2 ? WS_CKB : seg == 3 ? WS_CFV : WS_CFG)) + ch;
#pragma unroll
            for (int ai = 0; ai < 2; ++ai)
#pragma unroll
                for (int mm = 0; mm < 4; ++mm) {
                    const int row = row0 + ai * 128 + mm * 16;
                    f32x4 v0 = acc[ai][bj][mm][0], v1 = acc[ai][bj][mm][1];
                    if (seg == 0) {
#pragma unroll
                        for (int e = 0; e < 4; ++e) { v0[e] = v0[e] / (1.0f + __expf(-v0[e])); v1[e] = v1[e] / (1.0f + __expf(-v1[e])); }
                    } else if (seg == 1 || seg == 2) {
#pragma unroll
                        for (int e = 0; e < 4; ++e) { v0[e] = om[e] / (1.0f + __expf(v0[e])); v1[e] = om[4 + e] / (1.0f + __expf(v1[e])); }
                    }
                    u32x4 w; w.x = pk2(v0.x, v0.y); w.y = pk2(v0.z, v0.w); w.z = pk2(v1.x, v1.y); w.w = pk2(v1.z, v1.w);
                    *(u32x4*)(dst + (size_t)row * 256) = w;
                }
        }
    }
};
struct EpiQup2 {
    static constexpr bool PERM = false, AFTER_DRAIN = false;
    unsigned char* ws;
    __device__ __forceinline__ void operator()(const f32x4 (&acc)[2][2][4][2], const pg8::Unit& u, int wr, int wc, int fr, int fq) const {
        const int row0 = u.pm * 256 + wr * 64 + fr; const float* tab = (const float*)(ws + WS_TAB); const float* cosB = tab + 2048; const float* sinB = tab + 2560;
        const float* ssq = (const float*)(ws + WS_SSQ_Q); bf16* O = (bf16*)(ws + WS_QB);
#pragma unroll
        for (int bj = 0; bj < 2; ++bj) {
            const int cg_ = u.pn * 256 + bj * 128 + wc * 32;
            if (cg_ >= 384) continue;
            const bool pe = ((cg_ >> 5) % 3) == 2;
#pragma unroll
            for (int ai = 0; ai < 2; ++ai)
#pragma unroll
                for (int mm = 0; mm < 4; ++mm) {
                    const int row = row0 + ai * 128 + mm * 16; const int j = row % TPB;
                    const f32x4 sa = *(const f32x4*)(ssq + (size_t)row * 8), sb = *(const f32x4*)(ssq + (size_t)row * 8 + 4);
                    const float sc = QSCALE_B * rsqrtf((sa.x + sa.y + sa.z + sa.w + sb.x + sb.y) * (1.0f / 192.0f) + EPS);
                    f32x4 v0 = acc[ai][bj][mm][0], v1 = acc[ai][bj][mm][1];
                    if (pe && j < SEQ) {
                        const int pos = (fq < 2) ? (j >> 6) : (j & 63);
                        const f32x4 cs = *(const f32x4*)(cosB + pos * 8 + 4 * (fq & 1)), sn = *(const f32x4*)(sinB + pos * 8 + 4 * (fq & 1));
                        const f32x4 a_ = v0 * cs - v1 * sn, b_ = v1 * cs + v0 * sn; v0 = a_; v1 = b_;
                    }
                    v0 = v0 * sc; v1 = v1 * sc;
                    bf16* p = O + (size_t)row * 384 + cg_ + 4 * fq;
                    u32x2 w0, w1; w0.x = pk2(v0.x, v0.y); w0.y = pk2(v0.z, v0.w); w1.x = pk2(v1.x, v1.y); w1.y = pk2(v1.z, v1.w);
                    *(u32x2*)p = w0; *(u32x2*)(p + 16) = w1;
                    asm volatile("" ::: "memory");
                }
        }
    }
};
struct EpiKVup2 {
    static constexpr bool PERM = true, AFTER_DRAIN = false;
    unsigned char* ws;
    __device__ __forceinline__ void operator()(const f32x4 (&acc)[2][2][4][2], const pg8::Unit& u, int wr, int wc, int fr, int fq) const {
        const int row0 = u.pm * 256 + wr * 64 + fr; const float* ssq = (const float*)(ws + WS_SSQ_KV);
        bf16* KB = (bf16*)(ws + WS_KB); bf16* VB = (bf16*)(ws + WS_VB);
#pragma unroll
        for (int bj = 0; bj < 2; ++bj) {
            const int head = u.pn * 2 + bj; const int within = wc * 32 + 8 * fq;
#pragma unroll
            for (int ai = 0; ai < 2; ++ai)
#pragma unroll
                for (int mm = 0; mm < 4; ++mm) {
                    const int row = row0 + ai * 128 + mm * 16;
                    const f32x4 sa = *(const f32x4*)(ssq + (size_t)row * 4);
                    const float sc = rsqrtf((sa.x + sa.y + sa.z + sa.w) * (1.0f / 128.0f) + EPS);
                    const f32x4 v0 = acc[ai][bj][mm][0] * sc, v1 = acc[ai][bj][mm][1] * sc;
                    u32x4 w; w.x = pk2(v0.x, v0.y); w.y = pk2(v0.z, v0.w); w.z = pk2(v1.x, v1.y); w.w = pk2(v1.z, v1.w);
                    bf16* p = (within < 64) ? (KB + (size_t)row * 384 + head * 96 + within) : (VB + (size_t)row * 256 + head * 64 + (within - 64));
                    *(u32x4*)p = w;
                    asm volatile("" ::: "memory");
                }
        }
    }
};
__device__ __forceinline__ void mixer_phase(const Args& a, LAS unsigned char* lds, int l, unsigned char* wb, int G, int cidx = 0, int ustart = 0) {
    volatile LAS unsigned* misc = (volatile LAS unsigned*)(lds + LDS_MISC);
    unsigned* ctr = (unsigned*)(a.ws + WS_CTL) + 8 * l + cidx;
    const int n_units = 64 + 1024 + 2048 + ((l + 1 < DEPTH) ? 192 : 0);
    const bf16* QA = (const bf16*)(a.ws + WS_QA); const bf16* KA = (const bf16*)(a.ws + WS_KA); const bf16* VA = (const bf16*)(a.ws + WS_VA);
    const bf16* QB = (const bf16*)(a.ws + WS_QB); const bf16* KB = (const bf16*)(a.ws + WS_KB); const bf16* VB = (const bf16*)(a.ws + WS_VB);
    bf16* Y = (bf16*)(a.ws + WS_Y);
    unsigned* gdone = (unsigned*)(a.ws + WS_CTL) + 8 * l + 2;
    { int kq = 256; asm volatile("" : "+s"(kq)); pg8::Gemm g{(const bf16*)(a.ws + WS_BQD), (const bf16*)(wb + WO_QU), MROWS, 512, kq}; pg8::StaticOrder S; S.init(MROWS, 512, G, (int)blockIdx.x);
      EpiQup2 E{a.ws};
      pg8::gemm_phase<EpiQup2, pg8::StaticOrder, true, true>(lds, g, S, E); }
    { int kq = 128; asm volatile("" : "+s"(kq)); pg8::Gemm g{(const bf16*)(a.ws + WS_BKVD), (const bf16*)(wb + WO_KVU), MROWS, 512, kq}; pg8::StaticOrder S; S.init(MROWS, 512, G, (int)blockIdx.x);
      EpiKVup2 E{a.ws};
      pg8::gemm_phase<EpiKVup2, pg8::StaticOrder, true, true>(lds, g, S, E); }
    asm volatile("s_waitcnt vmcnt(0)" ::: "memory");
    __syncthreads();
    if (threadIdx.x == 0) { __builtin_amdgcn_fence(__ATOMIC_RELEASE, "agent"); asm volatile("s_waitcnt vmcnt(0)" ::: "memory"); __hip_atomic_fetch_add(gdone, 1u, __ATOMIC_RELAXED, __HIP_MEMORY_SCOPE_AGENT); }
    bool b_ready = false;
    for (;;) {
        __syncthreads();
        if (threadIdx.x == 0) misc[0] = atomicAdd(ctr, 1u);
        __syncthreads();
        int u = (int)misc[0] + ustart;
        if (u >= n_units) break;
        if (u < 64) { scan_unit(lds, a, l, u >> 2, u & 3); continue; }
        u -= 64;
        int ua = -1;
        if (u < 1024) ua = u; else if (u >= 2048 && u < 3072) ua = u - 1024;
        if (ua >= 0) { const int b = ua >> 7, kvh = (ua >> 6) & 1, qb = (ua >> 2) & 15, g = ua & 3, h = kvh * 4 + g; const size_t r0 = (size_t)b * TPB;
            attn_unit<64>(lds, QA + (r0 + qb * 256) * 512 + h * 64, 512, KA + r0 * 128 + kvh * 64, 128, VA + r0 * 128 + kvh * 64, 128, Y + (r0 + qb * 256) * DM + h * 64, DM, 34); continue; }
        const int n_actx = (l + 1 < DEPTH) ? 128 : 0;
        if (u >= 3072 && u < 3072 + n_actx) { const int uc = u - 3072; const int b = uc >> 3, h = uc & 7, kvh = h >> 2; const size_t r0 = (size_t)b * TPB + SEQ;
            attn_unit<64>(lds, QA + r0 * 512 + h * 64, 512, KA + r0 * 128 + kvh * 64, 128, VA + r0 * 128 + kvh * 64, 128, Y + r0 * DM + h * 64, DM, 2); continue; }
        if (!b_ready) {
            if (threadIdx.x == 0) { unsigned sp = 0; while (__hip_atomic_load(gdone, __ATOMIC_RELAXED, __HIP_MEMORY_SCOPE_AGENT) < (unsigned)G) { __builtin_amdgcn_s_sleep(2); if (++sp > (1u << 22)) break; }
                __builtin_amdgcn_fence(__ATOMIC_ACQUIRE, "agent"); asm volatile("s_waitcnt vmcnt(0)" ::: "memory"); }
            __syncthreads(); b_ready = true;
        }
        if (u < 2048) { const int ub = u - 1024; const int b = ub >> 6, h = (ub >> 4) & 3, qb = ub & 15; const size_t r0 = (size_t)b * TPB;
            attn_unit<96>(lds, QB + (r0 + qb * 256) * 384 + h * 96, 384, KB + r0 * 384 + h * 96, 384, VB + r0 * 256 + h * 64, 256, Y + (r0 + qb * 256) * DM + 512 + h * 64, DM, 34); continue; }
        u -= 3072 + n_actx;
        { const int b = u >> 2, h = u & 3; const size_t r0 = (size_t)b * TPB + SEQ;
            attn_unit<96>(lds, QB + r0 * 384 + h * 96, 384, KB + r0 * 384 + h * 96, 384, VB + r0 * 256 + h * 64, 256, Y + r0 * DM + 512 + h * 64, DM, 2); }
    }
}

constexpr int N_PHASES = 3 + 7 * DEPTH;
#ifndef ONLY
#define ONLY -1
#endif
#ifndef SKIP
#define SKIP -2
#endif
#define EN(id) ((ONLY < 0 || ONLY == (id)) && SKIP != (id))
__global__ void __launch_bounds__(NTHR, 2) fwd_kernel(Args a_in) {
    extern __shared__ __attribute__((aligned(16))) unsigned char lds_raw[];
    LAS unsigned char* lds = (LAS unsigned char*)lds_raw;
    const int G = gridDim.x, NGW = G * NWAVES;
    { volatile LAS unsigned* mz = (volatile LAS unsigned*)(lds + LDS_MISC); if (threadIdx.x < 64) mz[threadIdx.x] = 0u; }
    __syncthreads();
    const XcdBarrier xbar = xcd_barrier_post((unsigned*)(a_in.ws + WS_CTL) + 1024, (volatile LAS unsigned*)(lds + LDS_MISC) + 8);
    bool rep_done = false;
    if (a_in.coop) cg::this_grid().sync();
    for (int ph = a_in.ph_lo; ph < a_in.ph_hi; ++ph) {
        Args a = a_in; { unsigned long long w_ = (unsigned long long)a_in.ws; asm volatile("" : "+s"(w_)); a.ws = (unsigned char*)(__attribute__((address_space(1))) unsigned char*)w_; }
        int tid_l = threadIdx.x; asm volatile("" : "+v"(tid_l));
        const int tid = tid_l, lane = tid & 63, wave = __builtin_amdgcn_readfirstlane(tid >> 6), gw = blockIdx.x * NWAVES + wave;
        if (ph > a.ph_lo) { if (a.coop) xcd_barrier(xbar); }
#if defined(PROBE_SYNCS)
        if (ph == 3) { for (int i_ = 0; i_ < PROBE_SYNCS; ++i_) cg::this_grid().sync(); }
#endif
#if defined(PROBE_PRO)
        if (ph < 3 && !rep_done) { rep_done = true; --ph; } else if (ph < 3) rep_done = false;
#endif
        if (ph == 0) { if constexpr (EN(100)) phase0(a, lds, gw, NGW, wave, lane, tid); continue; }
        if (ph == 1) { if constexpr (EN(101)) phase_ada_reduce(a, tid); continue; }
        if (ph == 2) { if constexpr (EN(102)) rows_update(a, gw, NGW, lane, false, true, nullptr, 0, 0, false, true, a.in[I_GPREMIX], 0, 0); continue; }
        const int l = (ph - 3) / 7, s = (ph - 3) % 7;
#if defined(PROBE_REP)
        if (l == 0 && ((PROBE_REP >> s) & 1) && !rep_done) { rep_done = true; --ph; } else rep_done = false;
#endif
        unsigned char* wb = a.ws + WS_W + (size_t)l * W_LAYER;
        if (s == 0) { if constexpr (EN(0)) {
            pg8::Gemm g{(const bf16*)(a.ws + WS_HN), (const bf16*)(wb + WO_IN), MROWS, DINP, DM}; pg8::StaticOrder S; S.init(MROWS, DINP, G, (int)blockIdx.x);
            EpiFeat2 E{a.ws, a.in[I_AQN] + l * 64, a.in[I_AKN] + l * 64, a.in[I_CLB], l};
            pg8::gemm_phase<EpiFeat2, pg8::StaticOrder, true, true>(lds, g, S, E);
        } } else if (s == 1) { if constexpr (EN(1)) {
            mixer_phase(a, lds, l, wb, G);
#if defined(PROBE_MIXER2)
            if (l == 0) { cg::this_grid().sync(); mixer_phase(a, lds, l, wb, G, 4, PROBE_MIXER2); }
#endif
        } } else if (s == 2) { if constexpr (EN(2)) {
            pg8::Gemm g{(const bf16*)(a.ws + WS_Y), (const bf16*)(wb + WO_OUT), MROWS, DM, DM};
            pg8::EpiStore<0> E{(bf16*)(a.ws + WS_T), DM};
            run_gemm(lds, g, E, G, l + 1 == DEPTH);
        } } else if (s == 3) { if constexpr (EN(3)) {
            rows_update(a, gw, NGW, lane, true, l == 0, a.in[I_GPOSTMIX] + l * DM, l, 2, false, true, a.in[I_GPREFFN] + l * DM, l, 3, l + 1 == DEPTH);
        } } else if (s == 4) { if constexpr (EN(4)) {
            pg8::Gemm g{(const bf16*)(a.ws + WS_HN), (const bf16*)(wb + WO_1), MROWS, DFF, DM};
            pg8::EpiStore<1> E{(bf16*)(a.ws + WS_HB), DFF};
            if (l + 1 < DEPTH && G == 256) {
                const int c = (int)blockIdx.x;
                unsigned* pcnt = (unsigned*)(a.ws + WS_CTL) + 8192 + 1024 * l;
                { pg8::OneUnit S1{(c >> 4) * 17 + 16, c & 15}; pg8::gemm_phase<pg8::EpiStore<1>, pg8::OneUnit, true, true>(lds, g, S1, E); }
                asm volatile("s_waitcnt vmcnt(0)" ::: "memory");
                __syncthreads();
                if (tid == 0) { __builtin_amdgcn_fence(__ATOMIC_RELEASE, "agent"); asm volatile("s_waitcnt vmcnt(0)" ::: "memory"); __hip_atomic_fetch_add(pcnt + 64 * (c >> 4), 1u, __ATOMIC_RELAXED, __HIP_MEMORY_SCOPE_AGENT); }
                if (c < 64) {
                    if (tid == 0) { unsigned sp = 0; while (__hip_atomic_load(pcnt + 64 * (c >> 2), __ATOMIC_RELAXED, __HIP_MEMORY_SCOPE_AGENT) < 16u) { __builtin_amdgcn_s_sleep(2); if (++sp > (1u << 22)) break; }
                        __builtin_amdgcn_fence(__ATOMIC_ACQUIRE, "agent"); asm volatile("s_waitcnt vmcnt(0)" ::: "memory"); }
                    __syncthreads();
                    { pg8::Gemm g2{(const bf16*)(a.ws + WS_HB), (const bf16*)(wb + WO_2), MROWS, DM, DFF}; pg8::EpiStore<0> E2{(bf16*)(a.ws + WS_T2), DM};
                      pg8::OneUnit S2{(c >> 2) * 17 + 16, c & 3}; pg8::gemm_phase<pg8::EpiStore<0>, pg8::OneUnit, true, true>(lds, g2, S2, E2); }
                    { pg8::LatRange S3; S3.init(52, DFF, 64, c, 204); pg8::gemm_phase<pg8::EpiStore<1>, pg8::LatRange, true, true>(lds, g, S3, E); }
                } else {
                    pg8::LatRange S3; S3.init(204, DFF, 192, c - 64, 0); pg8::gemm_phase<pg8::EpiStore<1>, pg8::LatRange, true, true>(lds, g, S3, E);
                }
            } else run_gemm(lds, g, E, G, l + 1 == DEPTH);
        } } else if (s == 5) { if constexpr (EN(5)) {
            pg8::Gemm g{(const bf16*)(a.ws + WS_HB), (const bf16*)(wb + WO_2), MROWS, DM, DFF};
            pg8::EpiStore<0> E{(bf16*)(a.ws + WS_T2), DM};
            run_gemm(lds, g, E, G, (l + 1 == DEPTH) || G == 256);
        } } else { if constexpr (EN(6)) {
            const bool more = (l + 1 < DEPTH);
            rows_update(a, gw, NGW, lane, true, l == 0, a.in[I_GPOSTMIX] + l * DM, l, 2, true, more, a.in[I_GPREMIX] + (more ? (l + 1) : l) * DM, more ? (l + 1) : l, 0, !more, true, a.in[I_GPOSTFFN] + l * DM, 5);
        } }
    }
}

#ifndef ONE_LAUNCH
#define ONE_LAUNCH 1
#endif
extern "C" void kernel_launch(void* const* d_in, const int* in_sizes, int n_in, void* d_out, int out_size, void* d_ws, size_t ws_size, hipStream_t stream) {
    static int grid = 0;
    if (grid == 0) {
        if (n_in != 22 || ws_size < WS_END) { fprintf(stderr, "kernel_launch: expected 22 inputs and >= %zu bytes of workspace (got %d, %zu)\n", (size_t)WS_END, n_in, ws_size); grid = -1; return; }
        int dev = 0, cus = 0, per_cu = 0;
        hipGetDevice(&dev); hipDeviceGetAttribute(&cus, hipDeviceAttributeMultiprocessorCount, dev);
        hipFuncSetAttribute((const void*)fwd_kernel, hipFuncAttributeMaxDynamicSharedMemorySize, LDS_BYTES);
        hipOccupancyMaxActiveBlocksPerMultiprocessor(&per_cu, (const void*)fwd_kernel, NTHR, LDS_BYTES);
        if (per_cu < 1) per_cu = 1;
        grid = cus * 1;
        (void)hipGetLastError();
    }
    if (grid < 0) return;
    (void)hipMemsetAsync((char*)d_ws + WS_CTL, 0, 65536, stream);
    Args a{};
    for (int i = 0; i < 22; ++i) a.in[i] = (const float*)d_in[i];
    a.out = (float*)d_out; a.ws = (unsigned char*)d_ws; a.pad = 0;
#if ONE_LAUNCH
    a.ph_lo = 0; a.ph_hi = N_PHASES; a.coop = 1;
    void* args[] = {&a};
    hipError_t e = hipLaunchCooperativeKernel((const void*)fwd_kernel, dim3(grid), dim3(NTHR), args, LDS_BYTES, stream);
    if (e != hipSuccess) fprintf(stderr, "cooperative launch failed: %s (grid %d)\n", hipGetErrorString(e), grid);
#else
    for (int ph = 0; ph < N_PHASES; ++ph) { a.ph_lo = ph; a.ph_hi = ph + 1; a.coop = 0; hipLaunchKernelGGL(fwd_kernel, dim3(grid), dim3(NTHR), LDS_BYTES, stream, a); }
#endif
}
```

```cpp
#include <hip/hip_runtime.h>
#include <cstdio>
#include <cstdint>
namespace pg8 {
#define PG8_LAS __attribute__((address_space(3)))
typedef unsigned short bf16_t;
typedef short bf16x8 __attribute__((ext_vector_type(8)));
typedef float f32x4 __attribute__((ext_vector_type(4)));
typedef unsigned u32x4 __attribute__((ext_vector_type(4)));
constexpr int BM = 256, BK = 64, HALF = 128, HTB = HALF * BK * 2  , STAGE_BYTES = 8 * HTB, NXCD = 8, WGM = 8;

__host__ __device__ __forceinline__ int lds_byte(int r, int c) { const int st = (r >> 4) * 2 + (c >> 5), rr = r & 15, cc = c & 31, ob = rr * 64 + cc * 2; return st * 1024 + (ob ^ (((ob >> 9) & 1) << 5)); }
__host__ __device__ __forceinline__ void stage_rc(int b, int& R, int& C) { const int st = b / 1024, sb = b % 1024, swz = sb ^ (((sb >> 9) & 1) << 5); R = (st >> 1) * 16 + swz / 64; C = (st & 1) * 32 + (swz % 64) / 2; }
__host__ __device__ __forceinline__ int perm32(int rho) { const int n = rho >> 4, i = rho & 15; return 8 * (i >> 2) + 4 * n + (i & 3); }

struct Unit { int pm, pn; };
struct Gemm { const bf16_t* A; const bf16_t* Bt; int M, N, K; };

struct StaticOrder {
    int nM, nN, nwg, G, c;
    __host__ __device__ void init(int M, int N, int G_, int c_) { nM = M / BM; nN = N / BM; nwg = nM * nN; G = G_; c = c_; }
    __host__ __device__ bool next(int i, Unit& u) const {
        const long L = (long)i * G + c; if (L >= nwg) return false;
        int wgid = (int)L; { const int q = nwg / NXCD, r = nwg % NXCD, xcd = wgid % NXCD, off = wgid / NXCD; wgid = (xcd < r ? xcd * (q + 1) : r * (q + 1) + (xcd - r) * q) + off; }
        const int nig = WGM * nN, gid = wgid / nig, fm = gid * WGM, gsz = (nM - fm) < WGM ? (nM - fm) : WGM;
        u.pm = fm + ((wgid % nig) % gsz); u.pn = (wgid % nig) / gsz; return true;
    }
    __device__ __forceinline__ void a_ready(const Unit&) const {}
    __device__ __forceinline__ void done(const Unit&) const {}
};

struct LatOrder {
    StaticOrder s;
    __host__ __device__ void init(int N, int G_, int c_) { s.init(65536, N, G_, c_); }
    __host__ __device__ bool next(int i, Unit& u) const { if (!s.next(i, u)) return false; u.pm = (u.pm >> 4) * 17 + (u.pm & 15); return true; }
    __device__ __forceinline__ void a_ready(const Unit&) const {}
    __device__ __forceinline__ void done(const Unit&) const {}
};
struct OneUnit {
    int pm, pn;
    __host__ __device__ bool next(int i, Unit& u) const { if (i > 0) return false; u.pm = pm; u.pn = pn; return true; }
    __device__ __forceinline__ void a_ready(const Unit&) const {}
    __device__ __forceinline__ void done(const Unit&) const {}
};
struct LatRange {
    StaticOrder s; int p0;
    __host__ __device__ void init(int np, int N, int G_, int c_, int p0_) { s.init(np * BM, N, G_, c_); p0 = p0_; }
    __host__ __device__ bool next(int i, Unit& u) const { if (!s.next(i, u)) return false; const int p = u.pm + p0; u.pm = (p >> 4) * 17 + (p & 15); return true; }
    __device__ __forceinline__ void a_ready(const Unit&) const {}
    __device__ __forceinline__ void done(const Unit&) const {}
};
typedef float f32x2c_t __attribute__((ext_vector_type(2))); typedef __bf16 bf16x2c_t __attribute__((ext_vector_type(2)));
__device__ __forceinline__ unsigned cvt_pk_bf16(float lo, float hi) { f32x2c_t v = {lo, hi}; bf16x2c_t b = __builtin_convertvector(v, bf16x2c_t); return __builtin_bit_cast(unsigned, b); }
typedef float f32x2 __attribute__((ext_vector_type(2)));

constexpr int TPB_ = 4352;
template <int ACT  > struct EpiStore {
    static constexpr bool PERM = true, AFTER_DRAIN = false;
    bf16_t* O; int ldc;
    __device__ __forceinline__ void operator()(const f32x4 (&acc)[2][2][4][2], const Unit& u, int wr, int wc, int fr, int fq) const {
        const int row0 = u.pm * BM + wr * 64 + fr, col0 = u.pn * BM + wc * 32 + 8 * fq;
#pragma unroll
        for (int ai = 0; ai < 2; ++ai)
#pragma unroll
            for (int m = 0; m < 4; ++m) { bf16_t* rowp = O + (size_t)(row0 + ai * HALF + m * 16) * ldc + col0;
#pragma unroll
                for (int bj = 0; bj < 2; ++bj) { f32x4 v0 = acc[ai][bj][m][0], v1 = acc[ai][bj][m][1];
                    if (ACT == 1) {
#pragma unroll
                        for (int e = 0; e < 4; ++e) { float a = v0[e] > 0.f ? v0[e] : 0.f, b = v1[e] > 0.f ? v1[e] : 0.f; v0[e] = a * a; v1[e] = b * b; } }
                    u32x4 w; w.x = cvt_pk_bf16(v0[0], v0[1]); w.y = cvt_pk_bf16(v0[2], v0[3]); w.z = cvt_pk_bf16(v1[0], v1[1]); w.w = cvt_pk_bf16(v1[2], v1[3]);
                    *(u32x4*)(rowp + bj * HALF) = w; } }
    }
};
struct EpiQup {
    static constexpr bool PERM = false, AFTER_DRAIN = false;
    bf16_t* O; const float* cosB; const float* sinB; float scale;
    __device__ __forceinline__ void operator()(const f32x4 (&acc)[2][2][4][2], const Unit& u, int wr, int wc, int fr, int fq) const {
        typedef unsigned u32x2v __attribute__((ext_vector_type(2)));
        const int row0 = u.pm * BM + wr * 64 + fr;
#pragma unroll
        for (int bj = 0; bj < 2; ++bj) {
            const int cg = u.pn * BM + bj * HALF + wc * 32;
            if (cg >= 384) continue;
            const bool pe = ((cg >> 5) % 3) == 2;
#pragma unroll
            for (int ai = 0; ai < 2; ++ai)
#pragma unroll
                for (int m = 0; m < 4; ++m) {
                    const int row = row0 + ai * HALF + m * 16; const int j = row % TPB_;
                    f32x4 v0 = acc[ai][bj][m][0], v1 = acc[ai][bj][m][1];
                    if (pe && j < 4096) {
                        const int pos = (fq < 2) ? (j >> 6) : (j & 63);
                        const f32x4 cs = *(const f32x4*)(cosB + pos * 8 + 4 * (fq & 1)), sn = *(const f32x4*)(sinB + pos * 8 + 4 * (fq & 1));
                        const f32x4 a = v0 * cs - v1 * sn, b = v1 * cs + v0 * sn; v0 = a; v1 = b;
                    }
                    v0 = v0 * scale; v1 = v1 * scale;
                    bf16_t* p = O + (size_t)row * 384 + cg + 4 * fq;
                    u32x2v w0, w1; w0.x = cvt_pk_bf16(v0[0], v0[1]); w0.y = cvt_pk_bf16(v0[2], v0[3]); w1.x = cvt_pk_bf16(v1[0], v1[1]); w1.y = cvt_pk_bf16(v1[2], v1[3]);
                    *(u32x2v*)p = w0; *(u32x2v*)(p + 16) = w1;
                    asm volatile("" ::: "memory");
                }
        }
    }
};
struct EpiKVup {
    static constexpr bool PERM = true, AFTER_DRAIN = false;
    bf16_t* KB; bf16_t* VB;
    __device__ __forceinline__ void operator()(const f32x4 (&acc)[2][2][4][2], const Unit& u, int wr, int wc, int fr, int fq) const {
        const int row0 = u.pm * BM + wr * 64 + fr;
#pragma unroll
        for (int bj = 0; bj < 2; ++bj) {
            const int head = u.pn * 2 + bj; const int within = wc * 32 + 8 * fq;
#pragma unroll
            for (int ai = 0; ai < 2; ++ai)
#pragma unroll
                for (int m = 0; m < 4; ++m) {
                    const int row = row0 + ai * HALF + m * 16;
                    const f32x4 v0 = acc[ai][bj][m][0], v1 = acc[ai][bj][m][1];
                    u32x4 w; w.x = cvt_pk_bf16(v0[0], v0[1]); w.y = cvt_pk_bf16(v0[2], v0[3]); w.z = cvt_pk_bf16(v1[0], v1[1]); w.w = cvt_pk_bf16(v1[2], v1[3]);
                    bf16_t* p = (within < 64) ? (KB + (size_t)row * 384 + head * 96 + within) : (VB + (size_t)row * 256 + head * 64 + (within - 64));
                    *(u32x4*)p = w;
                }
        }
    }
};

struct EpiFeat {
    static constexpr bool PERM = true, AFTER_DRAIN = false;
    bf16_t* FEAT; int ldf; bf16_t* CFQ; bf16_t* CKF; bf16_t* CKB; bf16_t* CFV; bf16_t* CFG; const float* clb; int layer;
    __device__ __forceinline__ void operator()(const f32x4 (&acc)[2][2][4][2], const Unit& u, int wr, int wc, int fr, int fq) const {
        const int row0 = u.pm * BM + wr * 64 + fr;
#pragma unroll
        for (int bj = 0; bj < 2; ++bj) {
            const int c0 = u.pn * BM + bj * HALF + wc * 32 + 8 * fq;
            if (c0 >= 2400) continue;
            const int seg = (c0 < 1120) ? -1 : ((c0 - 1120) >> 8); const int ch = (c0 - 1120) & 255;
            float om[8];
#pragma unroll
            for (int e = 0; e < 8; ++e) om[e] = 1.0f;
            if (layer > 0 && (seg == 1 || seg == 2)) {
                const float* c1 = clb + 512 + (seg - 1) * 256 + ch; const float* c0p = clb + (seg - 1) * 256 + ch;
#pragma unroll
                for (int e = 0; e < 8; ++e) om[e] = 1.0f - 1.0f / (1.0f + __expf(-(c1[e] - c0p[e])));
            }
            bf16_t* dst; int ld;
            if (seg < 0) { dst = FEAT + c0; ld = ldf; } else { dst = (seg == 0 ? CFQ : seg == 1 ? CKF : seg == 2 ? CKB : seg == 3 ? CFV : CFG) + ch; ld = 256; }
#pragma unroll
            for (int ai = 0; ai < 2; ++ai)
#pragma unroll
                for (int m = 0; m < 4; ++m) {
                    const int row = row0 + ai * HALF + m * 16;
                    f32x4 v0 = acc[ai][bj][m][0], v1 = acc[ai][bj][m][1];
                    if (seg == 0) {
#pragma unroll
                        for (int e = 0; e < 4; ++e) { v0[e] = v0[e] / (1.0f + __expf(-v0[e])); v1[e] = v1[e] / (1.0f + __expf(-v1[e])); }
                    } else if (seg == 1 || seg == 2) {
#pragma unroll
                        for (int e = 0; e < 4; ++e) { v0[e] = om[e] / (1.0f + __expf(v0[e])); v1[e] = om[4 + e] / (1.0f + __expf(v1[e])); }
                    }
                    u32x4 w; w.x = cvt_pk_bf16(v0[0], v0[1]); w.y = cvt_pk_bf16(v0[2], v0[3]); w.z = cvt_pk_bf16(v1[0], v1[1]); w.w = cvt_pk_bf16(v1[2], v1[3]);
                    *(u32x4*)(dst + (size_t)row * ld) = w;
                }
        }
    }
};
template <class Epi, class Sched, bool ALIGN_EPI = false, bool SP2 = false>
__device__ __forceinline__ void gemm_phase(PG8_LAS unsigned char* lds, const Gemm g, const Sched& S, const Epi& E) {
    int tid_l = threadIdx.x; asm volatile("" : "+v"(tid_l)); const int tid = tid_l, wid = __builtin_amdgcn_readfirstlane(tid >> 6), lane = tid & 63, wr = wid >> 2, wc = wid & 3, fr = lane & 15, fq = lane >> 4;
    const int K = g.K, nt = K / BK;
    unsigned voffA[2], voffB[2];
#pragma unroll
    for (int i = 0; i < 2; ++i) { int R, C; stage_rc(tid * 16 + i * 8192, R, C); const int Rb = Epi::PERM ? ((R & ~31) + perm32(R & 31)) : R;
        voffA[i] = (unsigned)(R * K + C) * 2u; voffB[i] = (unsigned)(Rb * K + C) * 2u; }
    const size_t kstep = (size_t)(BK * 2);
    const size_t hstep = (size_t)HALF * K * 2;
    const size_t tstep = 2 * hstep;
    const unsigned ldsw = (unsigned)wid * 1024u;
    const int aoff = lds_byte(wr * 64 + fr, fq * 8), boff = lds_byte(wc * 32 + fr, fq * 8);
#define PG8_SA(b, h) (((b) * 2 + (h)) * HTB)
#define PG8_SB(b, h) ((4 + (b) * 2 + (h)) * HTB)
#define PG8_STAGE(bufoff, gbase, voff) do { _Pragma("unroll") for (int _i = 0; _i < 2; ++_i) \
        __builtin_amdgcn_global_load_lds((const unsigned*)((const char*)(gbase) + (voff)[_i]), (PG8_LAS unsigned*)(lds + (bufoff) + ldsw + _i * 8192), 16, 0, 0); } while (0)
#define PG8_LDA(dst, b, h) do { _Pragma("unroll") for (int m = 0; m < 4; ++m) _Pragma("unroll") for (int k = 0; k < 2; ++k) dst[m][k] = *(const PG8_LAS bf16x8*)(lds + PG8_SA(b, h) + aoff + m * 2048 + k * 1024); } while (0)
#define PG8_LDB(dst, b, h) do { _Pragma("unroll") for (int n = 0; n < 2; ++n) _Pragma("unroll") for (int k = 0; k < 2; ++k) dst[n][k] = *(const PG8_LAS bf16x8*)(lds + PG8_SB(b, h) + boff + n * 2048 + k * 1024); } while (0)
#define PG8_MMA(ai, bj, At, Bt) do { __builtin_amdgcn_s_setprio(1); _Pragma("unroll") for (int m = 0; m < 4; ++m) _Pragma("unroll") for (int n = 0; n < 2; ++n) _Pragma("unroll") for (int k = 0; k < 2; ++k) \
        acc[ai][bj][m][n] = __builtin_amdgcn_mfma_f32_16x16x32_bf16(Bt[n][k], At[m][k], acc[ai][bj][m][n], 0, 0, 0); __builtin_amdgcn_s_setprio(0); } while (0)
#define PG8_WAIT_V(n) asm volatile("s_waitcnt vmcnt(" #n ")" ::: "memory")
#define PG8_WAIT_L(n) asm volatile("s_waitcnt lgkmcnt(" #n ")" ::: "memory")
#define PG8_BAR __builtin_amdgcn_s_barrier()
#define PG8_SCHED __builtin_amdgcn_sched_barrier(0)
    Unit cur, nxt; int ui = 0;
    if (!S.next(0, cur)) return;
    f32x4 acc[2][2][4][2];
#pragma unroll
    for (int a = 0; a < 2; ++a)
#pragma unroll
        for (int b = 0; b < 2; ++b)
#pragma unroll
            for (int m = 0; m < 4; ++m)
#pragma unroll
                for (int n = 0; n < 2; ++n) acc[a][b][m][n] = (f32x4){0.f, 0.f, 0.f, 0.f};
    bf16x8 At[4][2], B0[2][2], B1[2][2];
    const char* cA = (const char*)g.A + (size_t)cur.pm * tstep; const char* cB = (const char*)g.Bt + (size_t)cur.pn * tstep;
    S.a_ready(cur);
    if constexpr (SP2) {
        PG8_STAGE(PG8_SB(0, 0), cB, voffB); PG8_STAGE(PG8_SB(0, 1), cB + hstep, voffB); PG8_STAGE(PG8_SA(0, 0), cA, voffA); PG8_STAGE(PG8_SA(0, 1), cA + hstep, voffA);
        if (wr == 1) PG8_BAR;
        PG8_WAIT_V(2); PG8_BAR;
        PG8_STAGE(PG8_SB(1, 0), cB + kstep, voffB); PG8_STAGE(PG8_SA(1, 0), cA + kstep, voffA); PG8_STAGE(PG8_SB(1, 1), cB + hstep + kstep, voffB);
        PG8_WAIT_V(6); PG8_BAR;
    } else {
        PG8_STAGE(PG8_SB(0, 0), cB, voffB); PG8_STAGE(PG8_SA(0, 0), cA, voffA); PG8_STAGE(PG8_SB(0, 1), cB + hstep, voffB); PG8_STAGE(PG8_SA(0, 1), cA + hstep, voffA);
        if (wr == 1) PG8_BAR;
        PG8_WAIT_V(4); PG8_BAR;
        PG8_STAGE(PG8_SB(1, 0), cB + kstep, voffB); PG8_STAGE(PG8_SA(1, 0), cA + kstep, voffA); PG8_STAGE(PG8_SB(1, 1), cB + hstep + kstep, voffB);
        PG8_WAIT_V(6); PG8_BAR;
    }
    for (;;) {
        const bool has_next = S.next(ui + 1, nxt);
        const char* nA = has_next ? (const char*)g.A + (size_t)nxt.pm * tstep : cA; const char* nB = has_next ? (const char*)g.Bt + (size_t)nxt.pn * tstep : cB;
        for (int t = 0; t < nt; t += 2) {
            const bool last = (t == nt - 2);
            const char* a1 = cA + (size_t)(t + 1) * kstep;
            const char* a2 = last ? nA : cA + (size_t)(t + 2) * kstep; const char* b2 = last ? nB : cB + (size_t)(t + 2) * kstep;
            const char* a3 = a2 + kstep; const char* b3 = b2 + kstep;
            if (last && has_next) S.a_ready(nxt);
            if constexpr (SP2) {
            PG8_LDB(B0, 0, 0); PG8_LDB(B1, 0, 1); PG8_SCHED; PG8_LDA(At, 0, 0); PG8_STAGE(PG8_SA(1, 1), a1 + hstep, voffA);
            PG8_WAIT_V(8); PG8_WAIT_L(0); PG8_BAR; PG8_MMA(0, 0, At, B0); PG8_MMA(0, 1, At, B1); PG8_BAR; PG8_SCHED;
            PG8_LDA(At, 0, 1); PG8_STAGE(PG8_SB(0, 0), b2, voffB); PG8_STAGE(PG8_SB(0, 1), b2 + hstep, voffB); PG8_STAGE(PG8_SA(0, 0), a2, voffA);
            PG8_WAIT_V(8); PG8_WAIT_L(0); PG8_BAR; PG8_MMA(1, 0, At, B0); PG8_MMA(1, 1, At, B1); PG8_BAR; PG8_SCHED;
            PG8_LDB(B0, 1, 0); PG8_LDB(B1, 1, 1); PG8_SCHED; PG8_LDA(At, 1, 0); PG8_STAGE(PG8_SA(0, 1), a2 + hstep, voffA);
            PG8_WAIT_V(8); PG8_WAIT_L(0); PG8_BAR; PG8_MMA(0, 0, At, B0); PG8_MMA(0, 1, At, B1); PG8_BAR; PG8_SCHED;
            PG8_LDA(At, 1, 1); PG8_STAGE(PG8_SB(1, 0), b3, voffB); PG8_STAGE(PG8_SB(1, 1), b3 + hstep, voffB); PG8_STAGE(PG8_SA(1, 0), a3, voffA);
            PG8_WAIT_V(8); PG8_WAIT_L(0); PG8_BAR; PG8_MMA(1, 0, At, B0); PG8_MMA(1, 1, At, B1); PG8_BAR; PG8_SCHED;
            } else {
            PG8_LDB(B0, 0, 0); PG8_SCHED; PG8_LDA(At, 0, 0); PG8_STAGE(PG8_SA(1, 1), a1 + hstep, voffA);
            PG8_WAIT_L(8); PG8_BAR; PG8_WAIT_L(0); PG8_MMA(0, 0, At, B0); PG8_BAR; PG8_SCHED;
            PG8_LDB(B1, 0, 1); PG8_STAGE(PG8_SB(0, 0), b2, voffB);
            PG8_BAR; PG8_WAIT_L(0); PG8_MMA(0, 1, At, B1); PG8_BAR;
            PG8_LDA(At, 0, 1); PG8_STAGE(PG8_SA(0, 0), a2, voffA);
            PG8_BAR; PG8_WAIT_L(0); PG8_MMA(1, 0, At, B0); PG8_BAR; PG8_SCHED;
            PG8_STAGE(PG8_SB(0, 1), b2 + hstep, voffB);
            PG8_WAIT_V(6); PG8_BAR; PG8_MMA(1, 1, At, B1); PG8_BAR;
            PG8_LDB(B0, 1, 0); PG8_SCHED; PG8_LDA(At, 1, 0); PG8_STAGE(PG8_SA(0, 1), a2 + hstep, voffA);
            PG8_WAIT_L(8); PG8_BAR; PG8_WAIT_L(0); PG8_MMA(0, 0, At, B0); PG8_BAR; PG8_SCHED;
            PG8_LDB(B1, 1, 1); PG8_STAGE(PG8_SB(1, 0), b3, voffB);
            PG8_BAR; PG8_WAIT_L(0); PG8_MMA(0, 1, At, B1); PG8_BAR;
            PG8_LDA(At, 1, 1); PG8_STAGE(PG8_SA(1, 0), a3, voffA);
            PG8_BAR; PG8_WAIT_L(0); PG8_MMA(1, 0, At, B0); PG8_BAR; PG8_SCHED;
            PG8_STAGE(PG8_SB(1, 1), b3 + hstep, voffB);
            PG8_WAIT_V(6); PG8_BAR; PG8_MMA(1, 1, At, B1); PG8_BAR;
            }
        }
        if constexpr (ALIGN_EPI) { if (wr == 0) PG8_BAR; }
        if constexpr (!Epi::AFTER_DRAIN) { E(acc, cur, wr, wc, fr, fq); S.done(cur); }
        if (!has_next) break;
#pragma unroll
        for (int a = 0; a < 2; ++a)
#pragma unroll
            for (int b = 0; b < 2; ++b)
#pragma unroll
                for (int m = 0; m < 4; ++m)
#pragma unroll
                    for (int n = 0; n < 2; ++n) acc[a][b][m][n] = (f32x4){0.f, 0.f, 0.f, 0.f};
        cur = nxt; cA = nA; cB = nB; ++ui;
        if constexpr (ALIGN_EPI) { if (wr == 1) PG8_BAR; }
    }
    PG8_WAIT_V(0);
    if constexpr (!ALIGN_EPI) { if (wr == 0) PG8_BAR; }
    PG8_BAR;
    if constexpr (Epi::AFTER_DRAIN) { E.fused(acc, cur, wr, wc, fr, fq, lds, wid, lane); S.done(cur); }
#undef PG8_SA
#undef PG8_SB
#undef PG8_STAGE
#undef PG8_LDA
#undef PG8_LDB
#undef PG8_MMA
#undef PG8_WAIT_V
#undef PG8_WAIT_L
#undef PG8_BAR
#undef PG8_SCHED
}
}

#include <hip/hip_cooperative_groups.h>
namespace cg = cooperative_groups;
#define LAS __attribute__((address_space(3)))
typedef unsigned short bf16;
typedef short bf16x8 __attribute__((ext_vector_type(8)));
typedef float f32x4 __attribute__((ext_vector_type(4)));
typedef float f32x16 __attribute__((ext_vector_type(16)));
typedef unsigned u32x4 __attribute__((ext_vector_type(4)));
typedef unsigned u32x2 __attribute__((ext_vector_type(2)));
typedef short s16x4 __attribute__((ext_vector_type(4)));

constexpr int NB = 16, SEQ = 4096, CTX = 256, TPB = 4352, MROWS = NB * TPB, DM = 1024, DIN = 2400, DINP = 2560, DFF = 4096, DEPTH = 2;
constexpr int NTHR = 512, NWAVES = 8;
constexpr float EPS = 1e-6f;
constexpr float LOG2E = 1.4426950408889634f;
constexpr float QSCALE_A = 0.125f * LOG2E;
constexpr float QSCALE_B = 0.10206207261596577f * LOG2E;
constexpr int C_AQ = 0, C_AK = 512, C_AV = 640, C_BQD = 768, C_BKVD = 960, C_BKR = 1088, C_CQ = 1120, C_CFF = 1376, C_CFB = 1632, C_CI = 1888, C_CG = 2144;

constexpr size_t MiB = 1u << 20;
constexpr size_t WS_CTL = 0;
constexpr size_t WS_ADA = 1 * MiB;
constexpr size_t WS_TAB = 2 * MiB;
constexpr size_t WS_SSQ_Q = 1020 * MiB, WS_SSQ_KV = 1022 * MiB + 262144;
constexpr size_t WS_PART = 1004 * MiB;
constexpr size_t WS_W = 4 * MiB, W_LAYER = 24 * MiB;
constexpr size_t WO_IN = 0, WO_OUT = 5 * MiB, WO_1 = 7 * MiB, WO_2 = 15 * MiB, WO_QU = 23 * MiB, WO_KVU = 23 * MiB + 512 * 1024;
constexpr size_t WS_XC = 52 * MiB;
constexpr size_t WS_HN = 68 * MiB;
constexpr size_t WS_T = 204 * MiB;
constexpr size_t WS_Y = 340 * MiB;
constexpr size_t WS_T2 = WS_Y;
constexpr size_t WS_OV = 476 * MiB;
constexpr size_t WS_HB = WS_OV;
constexpr size_t WS_FEAT = WS_OV;
constexpr size_t WS_QA = 816 * MiB, WS_KB = 884 * MiB, WS_CFQ = 935 * MiB, WS_CFV = 969 * MiB, WS_KA = 1003 * MiB;
constexpr size_t WS_VA = WS_T, WS_CFG = WS_T + 17 * MiB, WS_CKF = WS_T + 51 * MiB, WS_CKB = WS_T + 85 * MiB;
constexpr size_t WS_BQD = WS_Y, WS_BKVD = WS_Y + 34 * MiB;
constexpr size_t WS_QB = WS_OV, WS_VB = WS_OV + 51 * MiB, WS_OF = WS_OV + 85 * MiB, WS_OB = WS_OV + 153 * MiB;
constexpr size_t WS_END = 1024 * MiB;

constexpr int LDS_BYTES = 131072 + 1024;
constexpr int LDS_MISC = 131072;

__device__ __forceinline__ unsigned pk2(float lo, float hi) { return pg8::cvt_pk_bf16(lo, hi); }
__device__ __forceinline__ float bf_lo(unsigned w) { return __uint_as_float(w << 16); }
__device__ __forceinline__ float bf_hi(unsigned w) { return __uint_as_float(w & 0xffff0000u); }
__device__ __forceinline__ void unpack8(const u32x4 w, float (&f)[8]) { f[0] = bf_lo(w.x); f[1] = bf_hi(w.x); f[2] = bf_lo(w.y); f[3] = bf_hi(w.y); f[4] = bf_lo(w.z); f[5] = bf_hi(w.z); f[6] = bf_lo(w.w); f[7] = bf_hi(w.w); }
__device__ __forceinline__ u32x4 pack8(const float (&f)[8]) { u32x4 w; w.x = pk2(f[0], f[1]); w.y = pk2(f[2], f[3]); w.z = pk2(f[4], f[5]); w.w = pk2(f[6], f[7]); return w; }
__device__ __forceinline__ float wave_sum(float v) {
#pragma unroll
    for (int o = 1; o < 64; o <<= 1) v += __shfl_xor(v, o);
    return v;
}
__device__ __forceinline__ float sigmoidf_(float z) { return 1.0f / (1.0f + __expf(-z)); }
__device__ __forceinline__ float siluf_(float z) { return z / (1.0f + __expf(-z)); }

#define XB_TMO      128
#define XB_XCNT(j)  (256  + 64 * (j))
#define XB_XSUB(j)  (1280 + 64 * (j))
#define XB_XGEN(j)  (2304 + 64 * (j))
#define XB_TOP      3328
#define XB_TOPGEN   3392
#define XCD_BAR_WORDS 3456
#define XB_SPIN_CAP (1u << 18)

__device__ __forceinline__ unsigned xb_ld(unsigned* p)              { return __hip_atomic_load(p, __ATOMIC_RELAXED, __HIP_MEMORY_SCOPE_AGENT); }
__device__ __forceinline__ unsigned xb_add(unsigned* p, unsigned v) { return __hip_atomic_fetch_add(p, v, __ATOMIC_RELAXED, __HIP_MEMORY_SCOPE_AGENT); }
__device__ __forceinline__ unsigned xb_xcc_id() { return (unsigned)__builtin_amdgcn_s_getreg((3 << 11) | 20) & 0xFu; }
#define XB_SPIN(cond, bar) do { unsigned _sp = 0; while (cond) { __builtin_amdgcn_s_sleep(1); \
    if ((++_sp & 255u) == 0u) { if (xb_ld(&(bar)[XB_TMO])) break; if (_sp > XB_SPIN_CAP) { atomicAdd(&(bar)[XB_TMO], 1u); break; } } } } while (0)

struct XcdBarrier {
    unsigned* bar; unsigned x;
    volatile LAS unsigned* st;
};

__device__ __forceinline__ XcdBarrier xcd_barrier_post(unsigned* bar, volatile LAS unsigned* st) {
    XcdBarrier b; b.bar = bar; b.x = xb_xcc_id(); b.st = st;
    if (threadIdx.x == 0) (void)xb_add(&bar[XB_XCNT(b.x)], 1u);
    return b;
}
__device__ __forceinline__ void xcd_barrier_complete(unsigned* bar, unsigned x, unsigned& nloc, unsigned& nx) {
    const unsigned G = gridDim.x * gridDim.y * gridDim.z;
    unsigned sum, cnt, mine, sp = 0u;
    for (;;) {
        sum = 0u; cnt = 0u; mine = 0u;
#pragma unroll
        for (unsigned j = 0; j < 16; ++j) { const unsigned c = xb_ld(&bar[XB_XCNT(j)]); sum += c; cnt += (c > 0u) ? 1u : 0u; mine = (j == x) ? c : mine; }
        if (sum == G) break;
        __builtin_amdgcn_s_sleep(1);
        if ((++sp & 255u) == 0u) { if (xb_ld(&bar[XB_TMO])) break; if (sp > XB_SPIN_CAP) { atomicAdd(&bar[XB_TMO], 1u); break; } }
    }
    nloc = mine > 0u ? mine : 1u; nx = cnt > 0u ? cnt : 1u;
}

__device__ __forceinline__ void xcd_barrier(const XcdBarrier& b) {
    asm volatile("s_waitcnt vmcnt(0)" ::: "memory");
    __syncthreads();
    if (threadIdx.x == 0) {
        unsigned* bar = b.bar;
        __builtin_amdgcn_s_waitcnt(0);
        unsigned nloc = b.st[0], nx = b.st[1];
        if (nloc == 0u) { xcd_barrier_complete(bar, b.x, nloc, nx); b.st[0] = nloc; b.st[1] = nx; }
        const unsigned old = xb_add(&bar[XB_XSUB(b.x)], 1u);
        const unsigned gen = old / nloc;
        if (old + 1u == (gen + 1u) * nloc) {
            __builtin_amdgcn_fence(__ATOMIC_RELEASE, "agent");
            asm volatile("s_waitcnt vmcnt(0)" ::: "memory");
            const unsigned og = xb_add(&bar[XB_TOP], 1u);
            const unsigned tg = og / nx;
            if (og + 1u == (tg + 1u) * nx) xb_add(&bar[XB_TOPGEN], 1u);
            else XB_SPIN(xb_ld(&bar[XB_TOPGEN]) == tg, bar);
            __builtin_amdgcn_fence(__ATOMIC_ACQUIRE, "agent");
            xb_add(&bar[XB_XGEN(b.x)], 1u);
            asm volatile("s_waitcnt vmcnt(0)" ::: "memory");
        } else {
            XB_SPIN(xb_ld(&bar[XB_XGEN(b.x)]) == gen, bar);
            __builtin_amdgcn_fence(__ATOMIC_ACQUIRE, "agent");
            asm volatile("s_waitcnt vmcnt(0)" ::: "memory");
        }
    }
    __syncthreads();
}

struct Args {
    const float* in[22];
    float* out; unsigned char* ws;
    int ph_lo, ph_hi, coop, pad;
};
enum { I_X = 0, I_C, I_CTX, I_CCTX, I_WADA, I_BADA, I_GPREMIX, I_GPOSTMIX, I_GPREFFN, I_GPOSTFFN, I_WIN, I_AQN, I_AKN, I_BQN, I_WQUP, I_BKVN, I_WKVUP, I_CLB, I_CON, I_WOUT, I_WFF1, I_WFF2 };

__device__ __forceinline__ void transpose_item(const float* W, int K, int N, bf16* WT, int Kp, int Np, LAS float* scr, int item, int lane, const float* kscale = nullptr, bool headsplit = false) {
    const int nblk = Np / 32, kb = item / nblk, nb = item % nblk, k0 = 64 * kb, n0 = 32 * nb;
    const int n0o = (headsplit && n0 < 768) ? ((n0 & ~255) + ((n0 >> 5) & 1) * 128 + ((n0 >> 6) & 3) * 32) : n0;
    const int n = n0 + (lane & 31);
#pragma unroll
    for (int i = 0; i < 32; ++i) { const int kk = 2 * i + (lane >> 5); const int k = k0 + kk; scr[kk * 33 + (lane & 31)] = (k < K && n < N) ? W[(size_t)k * N + n] * (kscale ? kscale[k] : 1.0f) : 0.f; }
    asm volatile("s_waitcnt lgkmcnt(0)" ::: "memory");
    const int c = lane & 7;
#pragma unroll
    for (int j = 0; j < 4; ++j) { const int nn = (lane >> 3) + 8 * j; const LAS float* s = scr + (8 * c) * 33 + nn;
        u32x4 o; o.x = pk2(s[0 * 33], s[1 * 33]); o.y = pk2(s[2 * 33], s[3 * 33]); o.z = pk2(s[4 * 33], s[5 * 33]); o.w = pk2(s[6 * 33], s[7 * 33]);
        *(u32x4*)(WT + (size_t)(n0o + nn) * Kp + k0 + 8 * c) = o; }
    asm volatile("s_waitcnt lgkmcnt(0)" ::: "memory");
}
__device__ __forceinline__ void phase0(const Args& a, LAS unsigned char* lds, int gw, int NGW, int wave, int lane, int tid) {
    LAS float* scr = (LAS float*)(lds + wave * 16384);
    constexpr int I_IN = 16 * 80, I_OUT = 16 * 32, I_1 = 16 * 128, I_2 = 64 * 32, I_QU = 4 * 16, I_KVU = 2 * 16, I_L = I_IN + I_OUT + I_1 + I_2 + I_QU + I_KVU;
    for (int it = gw; it < 2 * I_L; it += NGW) {
        const int l = it / I_L; int r = it % I_L; unsigned char* wb = a.ws + WS_W + (size_t)l * W_LAYER;
        if (r < I_IN) { transpose_item(a.in[I_WIN] + (size_t)l * DM * DIN, DM, DIN, (bf16*)(wb + WO_IN), DM, DINP, scr, r, lane, nullptr, true); continue; } r -= I_IN;
        if (r < I_OUT) { transpose_item(a.in[I_WOUT] + (size_t)l * DM * DM, DM, DM, (bf16*)(wb + WO_OUT), DM, DM, scr, r, lane); continue; } r -= I_OUT;
        if (r < I_1) { transpose_item(a.in[I_WFF1] + (size_t)l * DM * DFF, DM, DFF, (bf16*)(wb + WO_1), DM, DFF, scr, r, lane); continue; } r -= I_1;
        if (r < I_2) { transpose_item(a.in[I_WFF2] + (size_t)l * DFF * DM, DFF, DM, (bf16*)(wb + WO_2), DFF, DM, scr, r, lane); continue; } r -= I_2;
        if (r < I_QU) { transpose_item(a.in[I_WQUP] + (size_t)l * 192 * 384, 192, 384, (bf16*)(wb + WO_QU), 256, 512, scr, r, lane, a.in[I_BQN] + l * 192); continue; } r -= I_QU;
        transpose_item(a.in[I_WKVUP] + (size_t)l * 128 * 512, 128, 512, (bf16*)(wb + WO_KVU), 128, 512, scr, r, lane, a.in[I_BKVN] + l * 128);
    }
    float* PART = (float*)(a.ws + WS_PART);
    for (int it = gw; it < 16 * 2 * 96; it += NGW) {
        const int nb = it % 96, l = (it / 96) % 2, ks = it / 192; const int n = nb * 64 + lane;
        float creg[17];
#pragma unroll
        for (int r = 0; r < 17; ++r) { const float cv = (r < 16) ? a.in[I_C][r * DM + ks * 64 + lane] : a.in[I_CCTX][ks * 64 + lane]; creg[r] = siluf_(cv); }
        float acc[17];
#pragma unroll
        for (int r = 0; r < 17; ++r) acc[r] = 0.f;
        const float* wp = a.in[I_WADA] + ((size_t)l * DM + ks * 64) * 6144 + n;
#pragma unroll 32
        for (int kk = 0; kk < 64; ++kk) { const float w = wp[(size_t)kk * 6144];
#pragma unroll
            for (int r = 0; r < 17; ++r) acc[r] += __shfl(creg[r], kk) * w; }
#pragma unroll
        for (int r = 0; r < 17; ++r) PART[(((size_t)ks * 2 + l) * 17 + r) * 6144 + n] = acc[r];
    }
    if (blockIdx.x == 0) {
        float* tab = (float*)(a.ws + WS_TAB);
        for (int e = tid; e < 64 * 16 + 64 * 8; e += NTHR) {
            int pos, f, nf; float* cdst; float* sdst;
            if (e < 1024) { pos = e >> 4; f = e & 15; nf = 16; cdst = tab + e; sdst = tab + 1024 + e; }
            else { const int e2 = e - 1024; pos = e2 >> 3; f = e2 & 7; nf = 8; cdst = tab + 2048 + e2; sdst = tab + 2560 + e2; }
            const float inv = exp2f(-(float)f / (float)nf * 13.287712379549449f);
            const float ang = (float)pos * inv;
            const float kf = rintf(ang * 0.15915494309189535f);
            float rr = fmaf(-kf, 6.28125f, ang); rr = fmaf(-kf, 1.9353071795864769e-3f, rr);
            *cdst = __cosf(rr); *sdst = __sinf(rr);
        }
    }
}
__device__ __forceinline__ void phase_ada_reduce(const Args& a, int tid) {
    const float* PART = (const float*)(a.ws + WS_PART); float* ADA = (float*)(a.ws + WS_ADA);
    for (int e = blockIdx.x * NTHR + tid; e < 2 * 17 * 6144; e += gridDim.x * NTHR) {
        const int n = e % 6144, l = e / (17 * 6144);
        float s = a.in[I_BADA][l * 6144 + n];
#pragma unroll
        for (int ks = 0; ks < 16; ++ks) s += PART[(size_t)ks * (2 * 17 * 6144) + e];
        ADA[e] = s;
    }
}

__device__ __forceinline__ const float* ada_ptr(const Args& a, int l, int R, int chunk) { const int b = R / TPB, j = R % TPB; const int r = (j < SEQ) ? b : 16; return (const float*)(a.ws + WS_ADA) + ((size_t)l * 17 + r) * 6144 + chunk * DM; }
__device__ __forceinline__ size_t xrow_off(int R, bool& lat) { const int b = R / TPB, j = R % TPB; lat = j < SEQ; return lat ? ((size_t)b * SEQ + j) * DM : ((size_t)b * CTX + (j - SEQ)) * DM; }
#define RCOL(q) (8 * lane + 512 * ((q) >> 1) + 4 * ((q) & 1))
struct RowIn { f32x4 x[4]; u32x4 t[2]; u32x4 t2[2]; };
__device__ __forceinline__ void row_load(const Args& a, int R, int lane, bool has_upd, bool xin_from_inputs, RowIn& r, bool has_upd2 = false) {
    bool lat; const size_t xo = xrow_off(R, lat);
    const float* xin = xin_from_inputs ? (lat ? a.in[I_X] : a.in[I_CTX]) : (lat ? (const float*)a.out : (const float*)(a.ws + WS_XC));
#pragma unroll
    for (int q = 0; q < 4; ++q) r.x[q] = *(const f32x4*)(xin + xo + RCOL(q));
    if (has_upd) { const bf16* T = (const bf16*)(a.ws + WS_T) + (size_t)R * DM;
#pragma unroll
        for (int h = 0; h < 2; ++h) r.t[h] = *(const u32x4*)(T + 8 * lane + 512 * h); }
    if (has_upd2) { const bf16* T2 = (const bf16*)(a.ws + WS_T2) + (size_t)R * DM;
#pragma unroll
        for (int h = 0; h < 2; ++h) r.t2[h] = *(const u32x4*)(T2 + 8 * lane + 512 * h); }
}
__device__ __forceinline__ void row_compute(const Args& a, int R, int lane, const RowIn& in, bool has_upd, const float* gpost, int l_gate, int gate_chunk,
                                            bool write_x, bool has_hn, const float* gpre, int l_mod, int sh_chunk, bool has_upd2 = false, const float* gpost2 = nullptr, int gate_chunk2 = 0) {
    bool lat; const size_t xo = xrow_off(R, lat);
    float* xout = lat ? a.out : (float*)(a.ws + WS_XC);
    f32x4 v[4];
#pragma unroll
    for (int q = 0; q < 4; ++q) v[q] = in.x[q];
    if (has_upd) {
        f32x4 t[4]; float ss = 0.f;
#pragma unroll
        for (int q = 0; q < 4; ++q) { const u32x4 w4 = in.t[q >> 1]; const unsigned wx = (q & 1) ? w4.z : w4.x, wy = (q & 1) ? w4.w : w4.y; t[q] = (f32x4){bf_lo(wx), bf_hi(wx), bf_lo(wy), bf_hi(wy)}; ss += t[q].x * t[q].x + t[q].y * t[q].y + t[q].z * t[q].z + t[q].w * t[q].w; }
        const float rinv = rsqrtf(wave_sum(ss) * (1.0f / DM) + EPS);
        const float* gate = ada_ptr(a, l_gate, R, gate_chunk);
#pragma unroll
        for (int q = 0; q < 4; ++q) { const f32x4 g = *(const f32x4*)(gpost + RCOL(q)), gt = *(const f32x4*)(gate + RCOL(q)); v[q] = v[q] + gt * (t[q] * rinv * g); }
    }
    if (has_upd2) {
        f32x4 t[4]; float ss = 0.f;
#pragma unroll
        for (int q = 0; q < 4; ++q) { const u32x4 w4 = in.t2[q >> 1]; const unsigned wx = (q & 1) ? w4.z : w4.x, wy = (q & 1) ? w4.w : w4.y; t[q] = (f32x4){bf_lo(wx), bf_hi(wx), bf_lo(wy), bf_hi(wy)}; ss += t[q].x * t[q].x + t[q].y * t[q].y + t[q].z * t[q].z + t[q].w * t[q].w; }
        const float rinv = rsqrtf(wave_sum(ss) * (1.0f / DM) + EPS);
        const float* gate = ada_ptr(a, l_gate, R, gate_chunk2);
#pragma unroll
        for (int q = 0; q < 4; ++q) { const f32x4 g = *(const f32x4*)(gpost2 + RCOL(q)), gt = *(const f32x4*)(gate + RCOL(q)); v[q] = v[q] + gt * (t[q] * rinv * g); }
    }
    if (has_upd || has_upd2) {
        if (write_x) {
#pragma unroll
            for (int q = 0; q < 4; ++q) *(f32x4*)(xout + xo + RCOL(q)) = v[q];
        }
    }
    if (has_hn) {
        float ss = 0.f;
#pragma unroll
        for (int q = 0; q < 4; ++q) ss += v[q].x * v[q].x + v[q].y * v[q].y + v[q].z * v[q].z + v[q].w * v[q].w;
        const float rinv = rsqrtf(wave_sum(ss) * (1.0f / DM) + EPS);
        const float* sh = ada_ptr(a, l_mod, R, sh_chunk); const float* sc = sh + DM;
        bf16* HN = (bf16*)(a.ws + WS_HN) + (size_t)R * DM; u32x2 hw[4];
#pragma unroll
        for (int q = 0; q < 4; ++q) { const f32x4 g = *(const f32x4*)(gpre + RCOL(q)), s1 = *(const f32x4*)(sc + RCOL(q)), s0 = *(const f32x4*)(sh + RCOL(q));
            const f32x4 h = (v[q] * rinv * g) * (s1 + 1.0f) + s0; hw[q].x = pk2(h.x, h.y); hw[q].y = pk2(h.z, h.w); }
#pragma unroll
        for (int h2 = 0; h2 < 2; ++h2) *(u32x4*)(HN + 8 * lane + 512 * h2) = (u32x4){hw[2 * h2].x, hw[2 * h2].y, hw[2 * h2 + 1].x, hw[2 * h2 + 1].y};
    }
}
__device__ __forceinline__ void rows_update(const Args& a, int gw, int NGW, int lane, bool has_upd, bool xin_from_inputs, const float* gpost, int l_gate, int gate_chunk,
                                            bool write_x, bool has_hn, const float* gpre, int l_mod, int sh_chunk, bool lat_only = false, bool has_upd2 = false, const float* gpost2 = nullptr, int gate_chunk2 = 0) {
    const int NR = lat_only ? NB * SEQ : MROWS;
#define ROWMAP(i) (lat_only ? (((i) >> 12) * TPB + ((i) & 4095)) : (i))
    int Ri = gw; if (Ri >= NR) return;
    int R = ROWMAP(Ri);
    RowIn cur, nxt; row_load(a, R, lane, has_upd, xin_from_inputs, cur, has_upd2);
    nxt = cur; { const int Ri1 = Ri + NGW; if (Ri1 < NR) row_load(a, ROWMAP(Ri1), lane, has_upd, xin_from_inputs, nxt, has_upd2); }
    for (;;) {
        const int Ri2 = Ri + 2 * NGW; RowIn nx2 = nxt;
        if (Ri2 < NR) row_load(a, ROWMAP(Ri2), lane, has_upd, xin_from_inputs, nx2, has_upd2);
        row_compute(a, R, lane, cur, has_upd, gpost, l_gate, gate_chunk, write_x, has_hn, gpre, l_mod, sh_chunk, has_upd2, gpost2, gate_chunk2);
        Ri += NGW; if (Ri >= NR) break;
        R = ROWMAP(Ri); cur = nxt; nxt = nx2;
    }
#undef ROWMAP
}

struct FeatIn { u32x4 w[5]; };
__device__ __forceinline__ void feat_load(const Args& a, int R, int lane, FeatIn& in) {
    const bf16* F = (const bf16*)(a.ws + WS_FEAT) + (size_t)R * DINP; const u32x4 zero4 = (u32x4){0u, 0u, 0u, 0u};
    in.w[0] = *(const u32x4*)(F + C_AQ + 8 * lane);
    in.w[1] = (lane < 32) ? *(const u32x4*)(F + C_AK + 8 * lane) : zero4;
    in.w[2] = (lane < 24) ? *(const u32x4*)(F + C_BQD + 8 * lane) : zero4;
    in.w[3] = (lane < 16) ? *(const u32x4*)(F + C_BKVD + 8 * lane) : zero4;
    in.w[4] = (lane < 4) ? *(const u32x4*)(F + C_BKR + 8 * lane) : zero4;
}
__device__ __forceinline__ void feat_row(const Args& a, int l, int R, int lane, const FeatIn& in) {
    const float* tab = (const float*)(a.ws + WS_TAB); const float* cosA = tab, *sinA = tab + 1024, *cosB = tab + 2048, *sinB = tab + 2560;
    const int j = R % TPB; const bool lat = j < SEQ; const int rowid = j >> 6, colid = j & 63;
    {
        float f[8]; unpack8(in.w[0], f);
        float ss = 0.f;
#pragma unroll
        for (int e = 0; e < 8; ++e) ss += f[e] * f[e];
        ss += __shfl_xor(ss, 1); ss += __shfl_xor(ss, 2); ss += __shfl_xor(ss, 4);
        const float rinv = rsqrtf(ss * (1.0f / 64.0f) + EPS);
        const float* gn = a.in[I_AQN] + l * 64 + 8 * (lane & 7);
#pragma unroll
        for (int e = 0; e < 8; ++e) f[e] = f[e] * rinv * gn[e];
        float pr[8];
#pragma unroll
        for (int e = 0; e < 8; ++e) pr[e] = __shfl_xor(f[e], 4);
        if (lat) {
            const int blk = lane & 3; const int pos = (blk < 2) ? rowid : colid; const float* cp = cosA + pos * 16 + 8 * (blk & 1), *sp = sinA + pos * 16 + 8 * (blk & 1);
            const float sg = ((lane & 7) < 4) ? -1.0f : 1.0f;
#pragma unroll
            for (int e = 0; e < 8; ++e) f[e] = f[e] * cp[e] + sg * pr[e] * sp[e];
        }
#pragma unroll
        for (int e = 0; e < 8; ++e) f[e] *= QSCALE_A;
        *(u32x4*)((bf16*)(a.ws + WS_QA) + (size_t)R * 512 + 8 * lane) = pack8(f);
    }
    {
        float f[8]; const u32x4 w = in.w[1]; unpack8(w, f);
        float ss = 0.f;
#pragma unroll
        for (int e = 0; e < 8; ++e) ss += f[e] * f[e];
        ss += __shfl_xor(ss, 1); ss += __shfl_xor(ss, 2); ss += __shfl_xor(ss, 4);
        const float rinv = rsqrtf(ss * (1.0f / 64.0f) + EPS);
        const float* gn = a.in[I_AKN] + l * 64 + 8 * (lane & 7);
        float g[8];
#pragma unroll
        for (int e = 0; e < 8; ++e) g[e] = f[e] * rinv * gn[e];
        float pr[8];
#pragma unroll
        for (int e = 0; e < 8; ++e) pr[e] = __shfl_xor(g[e], 4);
        if (lat) {
            const int blk = lane & 3; const int pos = (blk < 2) ? rowid : colid; const float* cp = cosA + pos * 16 + 8 * (blk & 1), *sp = sinA + pos * 16 + 8 * (blk & 1);
            const float sg = ((lane & 7) < 4) ? -1.0f : 1.0f;
#pragma unroll
            for (int e = 0; e < 8; ++e) g[e] = g[e] * cp[e] + sg * pr[e] * sp[e];
        }
        if (lane < 16) *(u32x4*)((bf16*)(a.ws + WS_KA) + (size_t)R * 128 + 8 * lane) = pack8(g);
        else if (lane < 32) *(u32x4*)((bf16*)(a.ws + WS_VA) + (size_t)R * 128 + 8 * (lane - 16)) = w;
    }
    {
        float f[8]; unpack8(in.w[2], f);
        float ss = 0.f;
#pragma unroll
        for (int e = 0; e < 8; ++e) ss += f[e] * f[e];
        const float rinv = rsqrtf(wave_sum(ss) * (1.0f / 192.0f) + EPS);
        if (lane < 24) { const float* gn = a.in[I_BQN] + l * 192 + 8 * lane;
#pragma unroll
            for (int e = 0; e < 8; ++e) f[e] = f[e] * rinv * gn[e]; }
        if (lane < 32) *(u32x4*)((bf16*)(a.ws + WS_BQD) + (size_t)R * 256 + 8 * lane) = pack8(f);
    }
    {
        float f[8]; unpack8(in.w[3], f);
        float ss = 0.f;
#pragma unroll
        for (int e = 0; e < 8; ++e) ss += f[e] * f[e];
        const float rinv = rsqrtf(wave_sum(ss) * (1.0f / 128.0f) + EPS);
        if (lane < 16) { const float* gn = a.in[I_BKVN] + l * 128 + 8 * lane;
#pragma unroll
            for (int e = 0; e < 8; ++e) f[e] = f[e] * rinv * gn[e];
            *(u32x4*)((bf16*)(a.ws + WS_BKVD) + (size_t)R * 128 + 8 * lane) = pack8(f); }
    }
    {
        float f[8]; unpack8(in.w[4], f);
        float pr[8];
#pragma unroll
        for (int e = 0; e < 8; ++e) pr[e] = __shfl_xor(f[e], 2);
        if (lat) {
            const int pos = ((lane & 1) == 0) ? rowid : colid; const float* cp = cosB + pos * 8, *sp = sinB + pos * 8;
            const float sg = ((lane & 3) < 2) ? -1.0f : 1.0f;
#pragma unroll
            for (int e = 0; e < 8; ++e) f[e] = f[e] * cp[e] + sg * pr[e] * sp[e];
        }
        if (lane < 4) { const u32x4 o = pack8(f); bf16* kb = (bf16*)(a.ws + WS_KB) + (size_t)R * 384 + 64 + 8 * lane;
#pragma unroll
            for (int h = 0; h < 4; ++h) *(u32x4*)(kb + h * 96) = o; }
    }
}

struct ReadIn { f32x4 of, ob; u32x2 g; };
__device__ __forceinline__ void readout_load(const Args& a, int R, int lane, ReadIn& in) {
    in.of = *(const f32x4*)((const float*)(a.ws + WS_OF) + (size_t)R * 256 + 4 * lane); in.ob = *(const f32x4*)((const float*)(a.ws + WS_OB) + (size_t)R * 256 + 4 * lane);
    in.g = *(const u32x2*)((const bf16*)(a.ws + WS_CFG) + (size_t)R * 256 + 4 * lane);
}
__device__ __forceinline__ void readout_row(const Args& a, int l, int R, int lane, const ReadIn& in) {
    const f32x4 of = in.of, ob = in.ob;
    const f32x4 o = of + ob;
    float ss = o.x * o.x + o.y * o.y + o.z * o.z + o.w * o.w;
    ss += __shfl_xor(ss, 1); ss += __shfl_xor(ss, 2); ss += __shfl_xor(ss, 4); ss += __shfl_xor(ss, 8);
    const float rinv = rsqrtf(ss * (1.0f / 64.0f) + EPS);
    const f32x4 gn = *(const f32x4*)(a.in[I_CON] + l * 64 + 4 * (lane & 15));
    const u32x2 gw = in.g;
    const f32x4 y = o * rinv * gn;
    u32x2 w; w.x = pk2(y.x * siluf_(bf_lo(gw.x)), y.y * siluf_(bf_hi(gw.x))); w.y = pk2(y.z * siluf_(bf_lo(gw.y)), y.w * siluf_(bf_hi(gw.y)));
    *(u32x2*)((bf16*)(a.ws + WS_Y) + (size_t)R * DM + 768 + 4 * lane) = w;
}

typedef float att_f32x2 __attribute__((ext_vector_type(2)));
__device__ __forceinline__ int att_imax(int a, int b) { return a > b ? a : b; }
typedef short att_v4i16 __attribute__((ext_vector_type(4)));
__device__ __forceinline__ s16x4 att_vtr(const LAS unsigned char* p) { return __builtin_bit_cast(s16x4, __builtin_amdgcn_ds_read_tr16_b64_v4i16((LAS att_v4i16*)p)); }
template <int DQ>
__device__ __forceinline__ void attn_unit(LAS unsigned char* lds, const bf16* Q, int qpitch, const bf16* K, int kpitch, const bf16* V, int vpitch, bf16* O, int opitch, int ns) {
    constexpr int KS = DQ * 2 + 16, VS = 144  , NKC = DQ / 8  , NKL = (128 * NKC) / NTHR, KBYTES = 128 * KS, BUF = KBYTES + 128 * VS;
    constexpr float THR = 64.0f;
    int tid_l = threadIdx.x; asm volatile("" : "+v"(tid_l)); const int tid = tid_l, lane = tid & 63, wid = tid >> 6, r32 = lane & 31, hi = lane >> 5;
    bf16x8 qf[DQ / 16];
#pragma unroll
    for (int d0 = 0; d0 < DQ / 16; ++d0) qf[d0] = *(const bf16x8*)(Q + (size_t)(wid * 32 + r32) * qpitch + d0 * 16 + hi * 8);
    f32x16 o0, o1;
#pragma unroll
    for (int r = 0; r < 16; ++r) { o0[r] = 0.f; o1[r] = 0.f; }
    bool mz = true;
    float mrun = 0.f, lrun = 0.f;
    u32x4 kreg[NKL], vreg[2];
#define ATT_LOAD(t) do { _Pragma("unroll") for (int i_ = 0; i_ < NKL; ++i_) { const int c_ = tid + NTHR * i_; kreg[i_] = *(const u32x4*)(K + (size_t)((t) * 128 + c_ / NKC) * kpitch + (c_ % NKC) * 8); } \
        _Pragma("unroll") for (int j_ = 0; j_ < 2; ++j_) { const int c_ = tid + NTHR * j_; vreg[j_] = *(const u32x4*)(V + (size_t)((t) * 128 + (c_ >> 3)) * vpitch + (c_ & 7) * 8); } } while (0)
#define ATT_PUT(buf) do { LAS unsigned char* kb_ = lds + (buf) * BUF; \
        _Pragma("unroll") for (int i_ = 0; i_ < NKL; ++i_) { const int c_ = tid + NTHR * i_; *(LAS u32x4*)(kb_ + (c_ / NKC) * KS + (c_ % NKC) * 16) = kreg[i_]; } \
        _Pragma("unroll") for (int j_ = 0; j_ < 2; ++j_) { const int c_ = tid + NTHR * j_; *(LAS u32x4*)(kb_ + KBYTES + (c_ >> 3) * VS + (c_ & 7) * 16) = vreg[j_]; } } while (0)
    ATT_LOAD(0);
    ATT_PUT(0);
    if (ns > 1) ATT_LOAD(1);
    __syncthreads();
    for (int t = 0; t < ns; ++t) {
        if (t + 1 < ns) { ATT_PUT((t + 1) & 1); if (t + 2 < ns) ATT_LOAD(t + 2); }
        const LAS unsigned char* Ks = lds + (t & 1) * BUF; const LAS unsigned char* Vt = Ks + KBYTES;
        constexpr int ND = DQ / 16;
#define ATT_KRD(SUB, KF) do { _Pragma("unroll") for (int d0 = 0; d0 < ND; ++d0) { KF[2 * d0] = *(const LAS bf16x8*)(Ks + (64 * (SUB) + r32) * KS + d0 * 32 + hi * 16); KF[2 * d0 + 1] = *(const LAS bf16x8*)(Ks + (64 * (SUB) + 32 + r32) * KS + d0 * 32 + hi * 16); } } while (0)
#define ATT_VRD(SUB, VF) do { const LAS unsigned char* vl_ = Vt + ((((lane & 15) >> 2) + 4 * hi) * VS + (16 * ((lane >> 4) & 1) + 4 * (lane & 3)) * 2); \
            _Pragma("unroll") for (int ks = 0; ks < 4; ++ks) { const LAS unsigned char* vr_ = vl_ + (64 * (SUB) + 16 * ks) * VS; \
            VF[4 * ks + 0] = att_vtr(vr_); VF[4 * ks + 1] = att_vtr(vr_ + 8 * VS); VF[4 * ks + 2] = att_vtr(vr_ + 64); VF[4 * ks + 3] = att_vtr(vr_ + 8 * VS + 64); } } while (0)
#define ATT_QK(KF, S0, S1) do { _Pragma("unroll") for (int d0 = 0; d0 < ND; ++d0) { \
            if (d0 == 0) { if (mz) { const f32x16 z_ = {0.f, 0.f, 0.f, 0.f, 0.f, 0.f, 0.f, 0.f, 0.f, 0.f, 0.f, 0.f, 0.f, 0.f, 0.f, 0.f}; \
                    S0 = __builtin_amdgcn_mfma_f32_32x32x16_bf16(KF[0], qf[0], z_, 0, 0, 0); S1 = __builtin_amdgcn_mfma_f32_32x32x16_bf16(KF[1], qf[0], z_, 0, 0, 0); } \
                else { f32x16 nm_; _Pragma("unroll") for (int r = 0; r < 16; ++r) nm_[r] = -mrun; \
                    S0 = __builtin_amdgcn_mfma_f32_32x32x16_bf16(KF[0], qf[0], nm_, 0, 0, 0); S1 = __builtin_amdgcn_mfma_f32_32x32x16_bf16(KF[1], qf[0], nm_, 0, 0, 0); } } \
            else { S0 = __builtin_amdgcn_mfma_f32_32x32x16_bf16(KF[2 * d0], qf[d0], S0, 0, 0, 0); S1 = __builtin_amdgcn_mfma_f32_32x32x16_bf16(KF[2 * d0 + 1], qf[d0], S1, 0, 0, 0); } } } while (0)
#define ATT_MAX(S0, S1, RM) do { float a_ = fmaxf(fmaxf(S0[0], S0[1]), S1[0]), b_ = fmaxf(fmaxf(S0[2], S0[3]), S1[1]); a_ = fmaxf(fmaxf(a_, S1[2]), S1[3]); \
            _Pragma("unroll") for (int r = 4; r < 16; r += 4) { a_ = fmaxf(fmaxf(a_, S0[r]), S0[r + 1]); b_ = fmaxf(fmaxf(b_, S0[r + 2]), S0[r + 3]); a_ = fmaxf(fmaxf(a_, S1[r]), S1[r + 1]); b_ = fmaxf(fmaxf(b_, S1[r + 2]), S1[r + 3]); } \
            RM = fmaxf(a_, b_); auto rr_ = __builtin_amdgcn_permlane32_swap(__float_as_uint(RM), __float_as_uint(RM), false, false); RM = fmaxf(__uint_as_float(rr_[0]), __uint_as_float(rr_[1])); } while (0)
#define ATT_IMAX3(a, b, c) att_imax(att_imax((a), (b)), (c))
#define ATT_SCREEN(S0, S1, HOT) do { int a_ = ATT_IMAX3(__float_as_int(S0[0]), __float_as_int(S0[1]), __float_as_int(S1[0])), b_ = ATT_IMAX3(__float_as_int(S0[2]), __float_as_int(S0[3]), __float_as_int(S1[1])); \
            a_ = ATT_IMAX3(a_, __float_as_int(S1[2]), __float_as_int(S1[3])); \
            _Pragma("unroll") for (int r = 4; r < 16; r += 4) { a_ = ATT_IMAX3(a_, __float_as_int(S0[r]), __float_as_int(S0[r + 1])); b_ = ATT_IMAX3(b_, __float_as_int(S0[r + 2]), __float_as_int(S0[r + 3])); \
                a_ = ATT_IMAX3(a_, __float_as_int(S1[r]), __float_as_int(S1[r + 1])); b_ = ATT_IMAX3(b_, __float_as_int(S1[r + 2]), __float_as_int(S1[r + 3])); } \
            HOT = __any(att_imax(a_, b_) > 0x42800000); } while (0)
#define ATT_RESC(FIRST, S0, S1, RM) do { if ((FIRST) ? __any(fabsf(RM) > THR) : __any(RM > THR)) { const float dl_ = (FIRST) ? RM : fmaxf(RM, 0.f); mrun += dl_; mz = false; \
            _Pragma("unroll") for (int r = 0; r < 16; ++r) { S0[r] -= dl_; S1[r] -= dl_; } \
            if (!(FIRST)) { const float f_ = __builtin_amdgcn_exp2f(-dl_); lrun *= f_; _Pragma("unroll") for (int r = 0; r < 16; ++r) { o0[r] *= f_; o1[r] *= f_; } } } } while (0)
#define ATT_EXP(S0, S1, PB) do { _Pragma("unroll") for (int r = 0; r < 16; ++r) { S0[r] = __builtin_amdgcn_exp2f(S0[r]); S1[r] = __builtin_amdgcn_exp2f(S1[r]); } \
            { att_f32x2 pa_ = (att_f32x2){S0[0], S0[1]} + (att_f32x2){S1[0], S1[1]}, pb_ = (att_f32x2){S0[2], S0[3]} + (att_f32x2){S1[2], S1[3]}; \
              _Pragma("unroll") for (int r = 4; r < 16; r += 4) { pa_ += (att_f32x2){S0[r], S0[r + 1]}; pb_ += (att_f32x2){S0[r + 2], S0[r + 3]}; pa_ += (att_f32x2){S1[r], S1[r + 1]}; pb_ += (att_f32x2){S1[r + 2], S1[r + 3]}; } \
              pa_ += pb_; lrun += pa_.x + pa_.y; } \
            _Pragma("unroll") for (int ks = 0; ks < 4; ++ks) { u32x4 w_; const int b_ = 8 * (ks & 1); \
                if (ks < 2) { w_.x = pk2(S0[b_ + 0], S0[b_ + 1]); w_.y = pk2(S0[b_ + 2], S0[b_ + 3]); w_.z = pk2(S0[b_ + 4], S0[b_ + 5]); w_.w = pk2(S0[b_ + 6], S0[b_ + 7]); } \
                else { w_.x = pk2(S1[b_ + 0], S1[b_ + 1]); w_.y = pk2(S1[b_ + 2], S1[b_ + 3]); w_.z = pk2(S1[b_ + 4], S1[b_ + 5]); w_.w = pk2(S1[b_ + 6], S1[b_ + 7]); } \
                PB[ks] = __builtin_bit_cast(bf16x8, w_); } } while (0)
#define ATT_EXPS(S0, S1, PB, PS) do { _Pragma("unroll") for (int r = 0; r < 16; ++r) { S0[r] = __builtin_amdgcn_exp2f(S0[r]); S1[r] = __builtin_amdgcn_exp2f(S1[r]); } \
            { att_f32x2 pa_ = (att_f32x2){S0[0], S0[1]} + (att_f32x2){S1[0], S1[1]}, pb_ = (att_f32x2){S0[2], S0[3]} + (att_f32x2){S1[2], S1[3]}; \
              _Pragma("unroll") for (int r = 4; r < 16; r += 4) { pa_ += (att_f32x2){S0[r], S0[r + 1]}; pb_ += (att_f32x2){S0[r + 2], S0[r + 3]}; pa_ += (att_f32x2){S1[r], S1[r + 1]}; pb_ += (att_f32x2){S1[r + 2], S1[r + 3]}; } \
              pa_ += pb_; PS = pa_.x + pa_.y; } \
            _Pragma("unroll") for (int ks = 0; ks < 4; ++ks) { u32x4 w_; const int b_ = 8 * (ks & 1); \
                if (ks < 2) { w_.x = pk2(S0[b_ + 0], S0[b_ + 1]); w_.y = pk2(S0[b_ + 2], S0[b_ + 3]); w_.z = pk2(S0[b_ + 4], S0[b_ + 5]); w_.w = pk2(S0[b_ + 6], S0[b_ + 7]); } \
                else { w_.x = pk2(S1[b_ + 0], S1[b_ + 1]); w_.y = pk2(S1[b_ + 2], S1[b_ + 3]); w_.z = pk2(S1[b_ + 4], S1[b_ + 5]); w_.w = pk2(S1[b_ + 6], S1[b_ + 7]); } \
                PB[ks] = __builtin_bit_cast(bf16x8, w_); } } while (0)
#define ATT_FORCE(S0, S1, RM) do { const float dl_ = fmaxf(RM, 0.f); mrun += dl_; mz = false; const float f_ = __builtin_amdgcn_exp2f(-dl_); lrun *= f_; \
            _Pragma("unroll") for (int r = 0; r < 16; ++r) { S0[r] -= dl_; S1[r] -= dl_; o0[r] *= f_; o1[r] *= f_; } } while (0)
#define ATT_PV(VF, PB) do { _Pragma("unroll") for (int ks = 0; ks < 4; ++ks) { \
            const s16x4 a0_ = VF[4 * ks + 0], a1_ = VF[4 * ks + 1], c0_ = VF[4 * ks + 2], c1_ = VF[4 * ks + 3]; \
            const bf16x8 va_ = (bf16x8){a0_[0], a0_[1], a0_[2], a0_[3], a1_[0], a1_[1], a1_[2], a1_[3]}, vc_ = (bf16x8){c0_[0], c0_[1], c0_[2], c0_[3], c1_[0], c1_[1], c1_[2], c1_[3]}; \
            o0 = __builtin_amdgcn_mfma_f32_32x32x16_bf16(va_, PB[ks], o0, 0, 0, 0); o1 = __builtin_amdgcn_mfma_f32_32x32x16_bf16(vc_, PB[ks], o1, 0, 0, 0); } } while (0)
#define ATT_SB() __builtin_amdgcn_sched_barrier(0)
        f32x16 s0, s1; bf16x8 kf[2 * ND], pb[4]; s16x4 vf[16]; float rm;
        ATT_KRD(0, kf); ATT_SB();
        ATT_QK(kf, s0, s1); ATT_SB();
        ATT_VRD(0, vf); ATT_SB();
        if constexpr (DQ != 64) { ATT_MAX(s0, s1, rm); ATT_RESC(t == 0, s0, s1, rm); ATT_EXP(s0, s1, pb); }
        else {
            if (t == 0) { ATT_MAX(s0, s1, rm); ATT_RESC(true, s0, s1, rm); }
            float ps_; ATT_EXPS(s0, s1, pb, ps_);
            if (__any(!(ps_ <= 0x1p64f))) { ATT_KRD(0, kf); ATT_QK(kf, s0, s1); ATT_MAX(s0, s1, rm); ATT_FORCE(s0, s1, rm); ATT_EXPS(s0, s1, pb, ps_); }
            lrun += ps_;
        }
        ATT_PV(vf, pb); ATT_SB();
        ATT_KRD(1, kf); ATT_SB();
        ATT_QK(kf, s0, s1); ATT_SB();
        ATT_VRD(1, vf); ATT_SB();
        if constexpr (DQ != 64) { ATT_MAX(s0, s1, rm); ATT_RESC(false, s0, s1, rm); ATT_EXP(s0, s1, pb); }
        else {
            float ps_; ATT_EXPS(s0, s1, pb, ps_);
            if (__any(!(ps_ <= 0x1p64f))) { ATT_KRD(1, kf); ATT_QK(kf, s0, s1); ATT_MAX(s0, s1, rm); ATT_FORCE(s0, s1, rm); ATT_EXPS(s0, s1, pb, ps_); }
            lrun += ps_;
        }
        ATT_PV(vf, pb);
#undef ATT_KRD
#undef ATT_VRD
#undef ATT_QK
#undef ATT_MAX
#undef ATT_RESC
#undef ATT_SCREEN
#undef ATT_IMAX3
#undef ATT_EXP
#undef ATT_PV
#undef ATT_EXPS
#undef ATT_FORCE
#undef ATT_SB
        __syncthreads();
    }
#undef ATT_LOAD
#undef ATT_PUT
    lrun += __shfl_xor(lrun, 32);
    const float linv = 1.0f / lrun;
    bf16* orow = O + (size_t)(wid * 32 + r32) * opitch;
#pragma unroll
    for (int r4 = 0; r4 < 4; ++r4) {
        u32x2 w0, w1;
        w0.x = pk2(o0[4 * r4 + 0] * linv, o0[4 * r4 + 1] * linv); w0.y = pk2(o0[4 * r4 + 2] * linv, o0[4 * r4 + 3] * linv);
        w1.x = pk2(o1[4 * r4 + 0] * linv, o1[4 * r4 + 1] * linv); w1.y = pk2(o1[4 * r4 + 2] * linv, o1[4 * r4 + 3] * linv);
        *(u32x2*)(orow + 8 * r4 + 4 * hi) = w0; *(u32x2*)(orow + 32 + 8 * r4 + 4 * hi) = w1;
    }
}

typedef float f32x2 __attribute__((ext_vector_type(2)));
__device__ __forceinline__ float dpp_xor1(float v) { return __int_as_float(__builtin_amdgcn_update_dpp(0, __float_as_int(v), 0xB1, 0xF, 0xF, true)); }
__device__ __forceinline__ float dpp_xor2(float v) { return __int_as_float(__builtin_amdgcn_update_dpp(0, __float_as_int(v), 0x4E, 0xF, 0xF, true)); }
__device__ __forceinline__ float dpp_hmir(float v) { return __int_as_float(__builtin_amdgcn_update_dpp(0, __float_as_int(v), 0x141, 0xF, 0xF, true)); }
__device__ __forceinline__ void scan_unit(LAS unsigned char* lds, const Args& a, int l, int b, int h) {
    int tid_l = threadIdx.x; asm volatile("" : "+v"(tid_l)); const int tid = tid_l, lane = tid & 63, wid = tid >> 6, dvl = lane >> 3, dkg = lane & 7;
    const int cw = __builtin_amdgcn_readfirstlane(wid); const int dir = (cw >> 1) & 1, wq = cw & 1;
    LAS float* myq = (LAS float*)(lds + dir * 65536); LAS float* myk = myq + 4096; LAS float* myv = myk + 4096; LAS float* myo = myv + 4096;
    const bf16* CQ = (const bf16*)(a.ws + WS_CFQ); const bf16* CKF = (const bf16*)(a.ws + WS_CKF); const bf16* CKB = (const bf16*)(a.ws + WS_CKB); const bf16* CV = (const bf16*)(a.ws + WS_CFV);
    float* OF = (float*)(a.ws + WS_OF); float* OB = (float*)(a.ws + WS_OB);
    const int rb = b * TPB, col = h * 64;
    f32x2 S[16];
#pragma unroll
    for (int e = 0; e < 16; ++e) S[e] = (f32x2){0.f, 0.f};
    const int li = tid >> 3, lc = tid & 7;
    u32x4 rq0, rk0, rv0, rq1, rk1, rv1;
#define SCAN_FB(c) (((c) < 4) ? (SEQ + 64 * (c)) : 64 * ((c) - 4))
#define SCAN_BB(c) (((c) < 4) ? (TPB - 1 - 64 * (c)) : (SEQ - 1 - 64 * ((c) - 4)))
#define SCAN_LOAD(c) do { const size_t rf_ = (size_t)(rb + SCAN_FB(c) + li) * 256 + col + 8 * lc, rb_ = (size_t)(rb + SCAN_BB(c) - li) * 256 + col + 8 * lc; \
        rq0 = *(const u32x4*)(CQ + rf_); rk0 = *(const u32x4*)(CKF + rf_); rv0 = *(const u32x4*)(CV + rf_); rq1 = *(const u32x4*)(CQ + rb_); rk1 = *(const u32x4*)(CKB + rb_); rv1 = *(const u32x4*)(CV + rb_); } while (0)
#define SCAN_PUT(base, w) do { float f_[8]; unpack8(w, f_); *(LAS f32x4*)((base) + li * 64 + 8 * lc) = (f32x4){f_[0], f_[1], f_[2], f_[3]}; *(LAS f32x4*)((base) + li * 64 + 8 * lc + 4) = (f32x4){f_[4], f_[5], f_[6], f_[7]}; } while (0)
#define SCAN_FLUSH(c) do { LAS float* o0_ = (LAS float*)(lds + 49152) + li * 64 + 8 * lc; LAS float* o1_ = (LAS float*)(lds + 65536 + 49152) + li * 64 + 8 * lc; \
        float* pf_ = OF + (size_t)(rb + SCAN_FB(c) + li) * 256 + col + 8 * lc; float* pb_ = OB + (size_t)(rb + SCAN_BB(c) - li) * 256 + col + 8 * lc; \
        *(f32x4*)pf_ = *(const LAS f32x4*)o0_; *(f32x4*)(pf_ + 4) = *(const LAS f32x4*)(o0_ + 4); *(f32x4*)pb_ = *(const LAS f32x4*)o1_; *(f32x4*)(pb_ + 4) = *(const LAS f32x4*)(o1_ + 4); } while (0)
    SCAN_LOAD(0);
    for (int c = 0; c < 68; ++c) {
        __syncthreads();
        if (c > 0) SCAN_FLUSH(c - 1);
        { LAS float* q0_ = (LAS float*)lds; LAS float* q1_ = (LAS float*)(lds + 65536);
          SCAN_PUT(q0_, rq0); SCAN_PUT(q0_ + 4096, rk0); SCAN_PUT(q0_ + 8192, rv0); SCAN_PUT(q1_, rq1); SCAN_PUT(q1_ + 4096, rk1); SCAN_PUT(q1_ + 8192, rv1); }
        __syncthreads();
        if (c + 1 < 68) SCAN_LOAD(c + 1);
        if (cw < 4) {
        f32x4 q0 = *(const LAS f32x4*)(myq + 8 * dkg), q1 = *(const LAS f32x4*)(myq + 8 * dkg + 4);
        f32x4 k0 = *(const LAS f32x4*)(myk + 8 * dkg), k1 = *(const LAS f32x4*)(myk + 8 * dkg + 4);
        f32x4 vv = *(const LAS f32x4*)(myv + 32 * wq + 4 * dvl);
        const bool lb0 = (lane & 1) != 0, lb1 = (lane & 2) != 0, lb2 = (lane & 4) != 0;
        for (int i0 = 0; i0 < 64; i0 += 4) {
            float val[4][4];
#pragma unroll
            for (int j = 0; j < 4; ++j) {
                const int in_ = (i0 + j + 1) & 63;
                const f32x4 nq0 = *(const LAS f32x4*)(myq + in_ * 64 + 8 * dkg), nq1 = *(const LAS f32x4*)(myq + in_ * 64 + 8 * dkg + 4);
                const f32x4 nk0 = *(const LAS f32x4*)(myk + in_ * 64 + 8 * dkg), nk1 = *(const LAS f32x4*)(myk + in_ * 64 + 8 * dkg + 4);
                const f32x4 nvv = *(const LAS f32x4*)(myv + in_ * 64 + 32 * wq + 4 * dvl);
                const f32x2 va = (f32x2){vv.x, vv.y}, vb = (f32x2){vv.z, vv.w};
                f32x2 a0 = (f32x2){0.f, 0.f}, a1 = a0, b0 = a0, b1 = a0;
#pragma unroll
                for (int e = 0; e < 4; ++e) {
                    const f32x2 kk0 = (f32x2){k0[e], k0[e]}, qq0 = (f32x2){q0[e], q0[e]}, kk1 = (f32x2){k1[e], k1[e]}, qq1 = (f32x2){q1[e], q1[e]};
                    S[e] = kk0 * (va - S[e]) + S[e];             a0 = S[e] * qq0 + a0;
                    S[8 + e] = kk0 * (vb - S[8 + e]) + S[8 + e];   b0 = S[8 + e] * qq0 + b0;
                    S[4 + e] = kk1 * (va - S[4 + e]) + S[4 + e];   a1 = S[4 + e] * qq1 + a1;
                    S[12 + e] = kk1 * (vb - S[12 + e]) + S[12 + e]; b1 = S[12 + e] * qq1 + b1;
                }
                const f32x2 acca = a0 + a1, accb = b0 + b1;
                val[j][0] = acca.x; val[j][1] = acca.y; val[j][2] = accb.x; val[j][3] = accb.y;
                q0 = nq0; q1 = nq1; k0 = nk0; k1 = nk1; vv = nvv;
            }
            float r1[8];
#pragma unroll
            for (int jl = 0; jl < 2; ++jl)
#pragma unroll
                for (int c = 0; c < 4; ++c) { const float lo = val[jl][c], hi = val[2 + jl][c]; const float keep = lb0 ? hi : lo, send = lb0 ? lo : hi; r1[jl * 4 + c] = keep + dpp_xor1(send); }
            float r2[4];
#pragma unroll
            for (int c = 0; c < 4; ++c) { const float lo = r1[c], hi = r1[4 + c]; const float keep = lb1 ? hi : lo, send = lb1 ? lo : hi; r2[c] = keep + dpp_xor2(send); }
            f32x2 r3;
            { const float k0_ = lb2 ? r2[2] : r2[0], s0_ = lb2 ? r2[0] : r2[2], k1_ = lb2 ? r2[3] : r2[1], s1_ = lb2 ? r2[1] : r2[3];
              r3.x = k0_ + __shfl_xor(s0_, 4); r3.y = k1_ + __shfl_xor(s1_, 4); }
            *(LAS f32x2*)(myo + (i0 + 2 * (lane & 1) + ((lane >> 1) & 1)) * 64 + 32 * wq + 4 * dvl + 2 * ((lane >> 2) & 1)) = r3;
        }
        }
    }
    __syncthreads();
    SCAN_FLUSH(67);
    __threadfence();
    __syncthreads();
    {
        const int rl = tid >> 4, c4 = (tid & 15) * 4;
        const f32x4 gn = *(const f32x4*)(a.in[I_CON] + l * 64 + c4);
        const bf16* CG = (const bf16*)(a.ws + WS_CFG); bf16* Y = (bf16*)(a.ws + WS_Y);
        for (int r0 = 0; r0 < TPB; r0 += 128) {
            f32x4 of[4], ob4[4]; u32x2 gw4[4];
#pragma unroll
            for (int p = 0; p < 4; ++p) { const size_t ro = (size_t)(rb + r0 + 32 * p + rl) * 256 + col + c4; of[p] = *(const f32x4*)(OF + ro); ob4[p] = *(const f32x4*)(OB + ro); gw4[p] = *(const u32x2*)(CG + ro); }
#pragma unroll
            for (int p = 0; p < 4; ++p) {
                const f32x4 o = of[p] + ob4[p];
                float ss = o.x * o.x + o.y * o.y + o.z * o.z + o.w * o.w;
                ss += __shfl_xor(ss, 1); ss += __shfl_xor(ss, 2); ss += __shfl_xor(ss, 4); ss += __shfl_xor(ss, 8);
                const float rinv = rsqrtf(ss * (1.0f / 64.0f) + EPS);
                const f32x4 y = o * rinv * gn; const u32x2 g2 = gw4[p];
                u32x2 w; w.x = pk2(y.x * siluf_(bf_lo(g2.x)), y.y * siluf_(bf_hi(g2.x))); w.y = pk2(y.z * siluf_(bf_lo(g2.y)), y.w * siluf_(bf_hi(g2.y)));
                *(u32x2*)(Y + (size_t)(rb + r0 + 32 * p + rl) * DM + 768 + col + c4) = w;
            }
        }
    }
    __syncthreads();
#undef SCAN_FB
#undef SCAN_BB
#undef SCAN_LOAD
#undef SCAN_PUT
#undef SCAN_FLUSH
}

template <class Epi>
__device__ __forceinline__ void run_gemm(LAS unsigned char* lds, const pg8::Gemm& g, const Epi& E, int G, bool lat_only) {
    if (lat_only) { pg8::LatOrder S; S.init(g.N, G, (int)blockIdx.x); pg8::gemm_phase<Epi, pg8::LatOrder, true, true>(lds, g, S, E); }
    else { pg8::StaticOrder S; S.init(g.M, g.N, G, (int)blockIdx.x); pg8::gemm_phase<Epi, pg8::StaticOrder, true, true>(lds, g, S, E); }
}
struct EpiFeat2 {
    static constexpr bool PERM = true, AFTER_DRAIN = false;
    unsigned char* ws; const float* aqn; const float* akn; const float* clb; int layer;
    __device__ __forceinline__ void operator()(const f32x4 (&acc)[2][2][4][2], const pg8::Unit& u, int wr, int wc, int fr, int fq) const {
        const int row0 = u.pm * 256 + wr * 64 + fr, pn = u.pn;
        const float* tab = (const float*)(ws + WS_TAB);
        if (pn <= 2) {
            const bool is_v = (pn == 2 && wc >= 2);
            const float* gain = (pn < 2) ? aqn : akn;
            f32x4 g[2][2];
#pragma unroll
            for (int bj = 0; bj < 2; ++bj)
#pragma unroll
                for (int n = 0; n < 2; ++n) g[bj][n] = *(const f32x4*)(gain + 32 * bj + 8 * fq + 4 * n);
            bf16* dst; int ld;
            if (pn < 2) { dst = (bf16*)(ws + WS_QA) + (4 * pn + wc) * 64; ld = 512; } else if (wc < 2) { dst = (bf16*)(ws + WS_KA) + wc * 64; ld = 128; } else { dst = (bf16*)(ws + WS_VA) + (wc - 2) * 64; ld = 128; }
            const float osc = (pn < 2) ? QSCALE_A : 1.0f;
#pragma unroll
            for (int ai = 0; ai < 2; ++ai)
#pragma unroll
                for (int mm = 0; mm < 4; ++mm) {
                    const int row = row0 + ai * 128 + mm * 16; const int j = row % TPB;
                    f32x4 x[2][2];
#pragma unroll
                    for (int bj = 0; bj < 2; ++bj)
#pragma unroll
                        for (int n = 0; n < 2; ++n) x[bj][n] = acc[ai][bj][mm][n];
                    if (!is_v) {
                        float ss = 0.f;
#pragma unroll
                        for (int bj = 0; bj < 2; ++bj)
#pragma unroll
                            for (int n = 0; n < 2; ++n) ss += x[bj][n].x * x[bj][n].x + x[bj][n].y * x[bj][n].y + x[bj][n].z * x[bj][n].z + x[bj][n].w * x[bj][n].w;
                        ss += __shfl_xor(ss, 16); ss += __shfl_xor(ss, 32);
                        const float rinv = rsqrtf(ss * (1.0f / 64.0f) + EPS);
#pragma unroll
                        for (int bj = 0; bj < 2; ++bj)
#pragma unroll
                            for (int n = 0; n < 2; ++n) x[bj][n] = x[bj][n] * rinv * g[bj][n];
                        if (j < SEQ) {
                            const int pos = (fq < 2) ? (j >> 6) : (j & 63);
#pragma unroll
                            for (int n = 0; n < 2; ++n) { const f32x4 cs = *(const f32x4*)(tab + pos * 16 + 8 * (fq & 1) + 4 * n), sn = *(const f32x4*)(tab + 1024 + pos * 16 + 8 * (fq & 1) + 4 * n);
                                const f32x4 a_ = x[0][n] * cs - x[1][n] * sn, b_ = x[1][n] * cs + x[0][n] * sn; x[0][n] = a_; x[1][n] = b_; }
                        }
#pragma unroll
                        for (int bj = 0; bj < 2; ++bj)
#pragma unroll
                            for (int n = 0; n < 2; ++n) x[bj][n] = x[bj][n] * osc;
                    }
#pragma unroll
                    for (int bj = 0; bj < 2; ++bj) { u32x4 w; w.x = pk2(x[bj][0].x, x[bj][0].y); w.y = pk2(x[bj][0].z, x[bj][0].w); w.z = pk2(x[bj][1].x, x[bj][1].y); w.w = pk2(x[bj][1].z, x[bj][1].w);
                        *(u32x4*)(dst + (size_t)row * ld + 32 * bj + 8 * fq) = w; }
                    asm volatile("" ::: "memory");
                }
            return;
        }
#pragma unroll
        for (int bj = 0; bj < 2; ++bj) {
            const int c0 = pn * 256 + bj * 128 + wc * 32 + 8 * fq;
            if (c0 >= 2400) continue;
            if (c0 < 1088) {
                const bool isq = c0 < 960; const int dd = isq ? (c0 - 768) : (c0 - 960);
                bf16* dst = isq ? ((bf16*)(ws + WS_BQD) + dd) : ((bf16*)(ws + WS_BKVD) + dd); const int ld = isq ? 256 : 128;
                float* ssq = isq ? (float*)(ws + WS_SSQ_Q) : (float*)(ws + WS_SSQ_KV);
                const int grp = dd >> 5;
#pragma unroll
                for (int ai = 0; ai < 2; ++ai)
#pragma unroll
                    for (int mm = 0; mm < 4; ++mm) {
                        const int row = row0 + ai * 128 + mm * 16;
                        const f32x4 v0 = acc[ai][bj][mm][0], v1 = acc[ai][bj][mm][1];
                        float ss = v0.x * v0.x + v0.y * v0.y + v0.z * v0.z + v0.w * v0.w + v1.x * v1.x + v1.y * v1.y + v1.z * v1.z + v1.w * v1.w;
                        ss += __shfl_xor(ss, 16); ss += __shfl_xor(ss, 32);
                        if (fq == 0) ssq[(size_t)row * (isq ? 8 : 4) + grp] = ss;
                        u32x4 w; w.x = pk2(v0.x, v0.y); w.y = pk2(v0.z, v0.w); w.z = pk2(v1.x, v1.y); w.w = pk2(v1.z, v1.w);
                        *(u32x4*)(dst + (size_t)row * ld) = w;
                        if (!isq && grp < 2) *(u32x4*)((bf16*)(ws + WS_BQD) + (size_t)row * 256 + 192 + dd) = (u32x4){0u, 0u, 0u, 0u};
                    }
                continue;
            }
            if (c0 < 1120) {
                const float* cosB = tab + 2048; const float* sinB = tab + 2560;
#pragma unroll
                for (int ai = 0; ai < 2; ++ai)
#pragma unroll
                    for (int mm = 0; mm < 4; ++mm) {
                        const int row = row0 + ai * 128 + mm * 16; const int j = row % TPB;
                        f32x4 v0 = acc[ai][bj][mm][0], v1 = acc[ai][bj][mm][1];
                        f32x4 p0, p1;
#pragma unroll
                        for (int e = 0; e < 4; ++e) { p0[e] = __shfl_xor(v0[e], 32); p1[e] = __shfl_xor(v1[e], 32); }
                        if (j < SEQ) {
                            const int pos = ((fq & 1) == 0) ? (j >> 6) : (j & 63);
                            const f32x4 c0v = *(const f32x4*)(cosB + pos * 8), c1v = *(const f32x4*)(cosB + pos * 8 + 4), s0v = *(const f32x4*)(sinB + pos * 8), s1v = *(const f32x4*)(sinB + pos * 8 + 4);
                            const float sg = (fq < 2) ? -1.0f : 1.0f;
                            v0 = v0 * c0v + p0 * s0v * sg; v1 = v1 * c1v + p1 * s1v * sg;
                        }
                        u32x4 w; w.x = pk2(v0.x, v0.y); w.y = pk2(v0.z, v0.w); w.z = pk2(v1.x, v1.y); w.w = pk2(v1.z, v1.w);
                        bf16* kb = (bf16*)(ws + WS_KB) + (size_t)row * 384 + 64 + 8 * fq;
#pragma unroll
                        for (int h = 0; h < 4; ++h) *(u32x4*)(kb + h * 96) = w;
                    }
                continue;
            }
            const int seg = (c0 - 1120) >> 8; const int ch = (c0 - 1120) & 255;
            float om[8];
#pragma unroll
            for (int e = 0; e < 8; ++e) om[e] = 1.0f;
            if (layer > 0 && (seg == 1 || seg == 2)) {
                const float* c1 = clb + 512 + (seg - 1) * 256 + ch; const float* c0p = clb + (seg - 1) * 256 + ch;
#pragma unroll
                for (int e = 0; e < 8; ++e) om[e] = 1.0f - 1.0f / (1.0f + __expf(-(c1[e] - c0p[e])));
            }
            bf16* dst = (bf16*)(ws + (seg == 0 ? WS_CFQ : seg == 1 ? WS_CKF : seg == 2 ? WS_CKB : seg == 3 ? WS_CFV : WS_CFG)) + ch;
#pragma unroll
            for (int ai = 0; ai < 2; ++ai)
#pragma unroll
                for (int mm = 0; mm < 4; ++mm) {
                    const int row = row0 + ai * 128 + mm * 16;
                    f32x4 v0 = acc[ai][bj][mm][0], v1 = acc[ai][bj][mm][1];
                    if (seg == 0) {
#pragma unroll
                        for (int e = 0; e < 4; ++e) { v0[e] = v0[e] / (1.0f + __expf(-v0[e])); v1[e] = v1[e] / (1.0f + __expf(-v1[e])); }
                    } else if (seg == 1 || seg == 2) {
#pragma unroll
                        for (int e = 0; e < 4; ++e) { v0[e] = om[e] / (1.0f + __expf(v0[e])); v1[e] = om[4 + e] / (1.0f + __expf(v1[e])); }
                    }
                    u32x4 w; w.x = pk2(v0.x, v0.y); w.y = pk2(v0.z, v0.w); w.z = pk2(v1.x, v1.y); w.w = pk2(v1.z, v1.w);
                    *(u32x4*)(dst + (size_t)row * 256) = w;
                }
        }
    }
};
struct EpiQup2 {
    static constexpr bool PERM = false, AFTER_DRAIN = false;
    unsigned char* ws;
    __device__ __forceinline__ void operator()(const f32x4 (&acc)[2][2][4][2], const pg8::Unit& u, int wr, int wc, int fr, int fq) const {
        const int row0 = u.pm * 256 + wr * 64 + fr; const float* tab = (const float*)(ws + WS_TAB); const float* cosB = tab + 2048; const float* sinB = tab + 2560;
        const float* ssq = (const float*)(ws + WS_SSQ_Q); bf16* O = (bf16*)(ws + WS_QB);
#pragma unroll
        for (int bj = 0; bj < 2; ++bj) {
            const int cg_ = u.pn * 256 + bj * 128 + wc * 32;
            if (cg_ >= 384) continue;
            const bool pe = ((cg_ >> 5) % 3) == 2;
#pragma unroll
            for (int ai = 0; ai < 2; ++ai)
#pragma unroll
                for (int mm = 0; mm < 4; ++mm) {
                    const int row = row0 + ai * 128 + mm * 16; const int j = row % TPB;
                    const f32x4 sa = *(const f32x4*)(ssq + (size_t)row * 8), sb = *(const f32x4*)(ssq + (size_t)row * 8 + 4);
                    const float sc = QSCALE_B * rsqrtf((sa.x + sa.y + sa.z + sa.w + sb.x + sb.y) * (1.0f / 192.0f) + EPS);
                    f32x4 v0 = acc[ai][bj][mm][0], v1 = acc[ai][bj][mm][1];
                    if (pe && j < SEQ) {
                        const int pos = (fq < 2) ? (j >> 6) : (j & 63);
                        const f32x4 cs = *(const f32x4*)(cosB + pos * 8 + 4 * (fq & 1)), sn = *(const f32x4*)(sinB + pos * 8 + 4 * (fq & 1));
                        const f32x4 a_ = v0 * cs - v1 * sn, b_ = v1 * cs + v0 * sn; v0 = a_; v1 = b_;
                    }
                    v0 = v0 * sc; v1 = v1 * sc;
                    bf16* p = O + (size_t)row * 384 + cg_ + 4 * fq;
                    u32x2 w0, w1; w0.x = pk2(v0.x, v0.y); w0.y = pk2(v0.z, v0.w); w1.x = pk2(v1.x, v1.y); w1.y = pk2(v1.z, v1.w);
                    *(u32x2*)p = w0; *(u32x2*)(p + 16) = w1;
                    asm volatile("" ::: "memory");
                }
        }
    }
};
struct EpiKVup2 {
    static constexpr bool PERM = true, AFTER_DRAIN = false;
    unsigned char* ws;
    __device__ __forceinline__ void operator()(const f32x4 (&acc)[2][2][4][2], const pg8::Unit& u, int wr, int wc, int fr, int fq) const {
        const int row0 = u.pm * 256 + wr * 64 + fr; const float* ssq = (const float*)(ws + WS_SSQ_KV);
        bf16* KB = (bf16*)(ws + WS_KB); bf16* VB = (bf16*)(ws + WS_VB);
#pragma unroll
        for (int bj = 0; bj < 2; ++bj) {
            const int head = u.pn * 2 + bj; const int within = wc * 32 + 8 * fq;
#pragma unroll
            for (int ai = 0; ai < 2; ++ai)
#pragma unroll
                for (int mm = 0; mm < 4; ++mm) {
                    const int row = row0 + ai * 128 + mm * 16;
                    const f32x4 sa = *(const f32x4*)(ssq + (size_t)row * 4);
                    const float sc = rsqrtf((sa.x + sa.y + sa.z + sa.w) * (1.0f / 128.0f) + EPS);
                    const f32x4 v0 = acc[ai][bj][mm][0] * sc, v1 = acc[ai][bj][mm][1] * sc;
                    u32x4 w; w.x = pk2(v0.x, v0.y); w.y = pk2(v0.z, v0.w); w.z = pk2(v1.x, v1.y); w.w = pk2(v1.z, v1.w);
                    bf16* p = (within < 64) ? (KB + (size_t)row * 384 + head * 96 + within) : (VB + (size_t)row * 256 + head * 64 + (within - 64));
                    *(u32x4*)p = w;
                    asm volatile("" ::: "memory");
                }
        }
    }
};
__device__ __forceinline__ void mixer_phase(const Args& a, LAS unsigned char* lds, int l, unsigned char* wb, int G, int cidx = 0, int ustart = 0) {
    volatile LAS unsigned* misc = (volatile LAS unsigned*)(lds + LDS_MISC);
    unsigned* ctr = (unsigned*)(a.ws + WS_CTL) + 8 * l + cidx;
    const int n_units = 64 + 1024 + 2048 + ((l + 1 < DEPTH) ? 192 : 0);
    const bf16* QA = (const bf16*)(a.ws + WS_QA); const bf16* KA = (const bf16*)(a.ws + WS_KA); const bf16* VA = (const bf16*)(a.ws + WS_VA);
    const bf16* QB = (const bf16*)(a.ws + WS_QB); const bf16* KB = (const bf16*)(a.ws + WS_KB); const bf16* VB = (const bf16*)(a.ws + WS_VB);
    bf16* Y = (bf16*)(a.ws + WS_Y);
    unsigned* gdone = (unsigned*)(a.ws + WS_CTL) + 8 * l + 2;
    { int kq = 256; asm volatile("" : "+s"(kq)); pg8::Gemm g{(const bf16*)(a.ws + WS_BQD), (const bf16*)(wb + WO_QU), MROWS, 512, kq}; pg8::StaticOrder S; S.init(MROWS, 512, G, (int)blockIdx.x);
      EpiQup2 E{a.ws};
      pg8::gemm_phase<EpiQup2, pg8::StaticOrder, true, true>(lds, g, S, E); }
    { int kq = 128; asm volatile("" : "+s"(kq)); pg8::Gemm g{(const bf16*)(a.ws + WS_BKVD), (const bf16*)(wb + WO_KVU), MROWS, 512, kq}; pg8::StaticOrder S; S.init(MROWS, 512, G, (int)blockIdx.x);
      EpiKVup2 E{a.ws};
      pg8::gemm_phase<EpiKVup2, pg8::StaticOrder, true, true>(lds, g, S, E); }
    asm volatile("s_waitcnt vmcnt(0)" ::: "memory");
    __syncthreads();
    if (threadIdx.x == 0) { __builtin_amdgcn_fence(__ATOMIC_RELEASE, "agent"); asm volatile("s_waitcnt vmcnt(0)" ::: "memory"); __hip_atomic_fetch_add(gdone, 1u, __ATOMIC_RELAXED, __HIP_MEMORY_SCOPE_AGENT); }
    bool b_ready = false;
    for (;;) {
        __syncthreads();
        if (threadIdx.x == 0) misc[0] = atomicAdd(ctr, 1u);
        __syncthreads();
        int u = (int)misc[0] + ustart;
        if (u >= n_units) break;
        if (u < 64) { scan_unit(lds, a, l, u >> 2, u & 3); continue; }
        u -= 64;
        int ua = -1;
        if (u < 1024) ua = u; else if (u >= 2048 && u < 3072) ua = u - 1024;
        if (ua >= 0) { const int b = ua >> 7, kvh = (ua >> 6) & 1, qb = (ua >> 2) & 15, g = ua & 3, h = kvh * 4 + g; const size_t r0 = (size_t)b * TPB;
            attn_unit<64>(lds, QA + (r0 + qb * 256) * 512 + h * 64, 512, KA + r0 * 128 + kvh * 64, 128, VA + r0 * 128 + kvh * 64, 128, Y + (r0 + qb * 256) * DM + h * 64, DM, 34); continue; }
        const int n_actx = (l + 1 < DEPTH) ? 128 : 0;
        if (u >= 3072 && u < 3072 + n_actx) { const int uc = u - 3072; const int b = uc >> 3, h = uc & 7, kvh = h >> 2; const size_t r0 = (size_t)b * TPB + SEQ;
            attn_unit<64>(lds, QA + r0 * 512 + h * 64, 512, KA + r0 * 128 + kvh * 64, 128, VA + r0 * 128 + kvh * 64, 128, Y + r0 * DM + h * 64, DM, 2); continue; }
        if (!b_ready) {
            if (threadIdx.x == 0) { unsigned sp = 0; while (__hip_atomic_load(gdone, __ATOMIC_RELAXED, __HIP_MEMORY_SCOPE_AGENT) < (unsigned)G) { __builtin_amdgcn_s_sleep(2); if (++sp > (1u << 22)) break; }
                __builtin_amdgcn_fence(__ATOMIC_ACQUIRE, "agent"); asm volatile("s_waitcnt vmcnt(0)" ::: "memory"); }
            __syncthreads(); b_ready = true;
        }
        if (u < 2048) { const int ub = u - 1024; const int b = ub >> 6, h = (ub >> 4) & 3, qb = ub & 15; const size_t r0 = (size_t)b * TPB;
            attn_unit<96>(lds, QB + (r0 + qb * 256) * 384 + h * 96, 384, KB + r0 * 384 + h * 96, 384, VB + r0 * 256 + h * 64, 256, Y + (r0 + qb * 256) * DM + 512 + h * 64, DM, 34); continue; }
        u -= 3072 + n_actx;
        { const int b = u >> 2, h = u & 3; const size_t r0 = (size_t)b * TPB + SEQ;
            attn_unit<96>(lds, QB + r0 * 384 + h * 96, 384, KB + r0 * 384 + h * 96, 384, VB + r0 * 256 + h * 64, 256, Y + r0 * DM + 512 + h * 64, DM, 2); }
    }
}

constexpr int N_PHASES = 3 + 7 * DEPTH;
#ifndef ONLY
#define ONLY -1
#endif
#ifndef SKIP
#define SKIP -2
#endif
#define EN(id) ((ONLY < 0 || ONLY == (id)) && SKIP != (id))
__global__ void __launch_bounds__(NTHR, 2) fwd_kernel(Args a_in) {
    extern __shared__ __attribute__((aligned(16))) unsigned char lds_raw[];
    LAS unsigned char* lds = (LAS unsigned char*)lds_raw;
    const int G = gridDim.x, NGW = G * NWAVES;
    { volatile LAS unsigned* mz = (volatile LAS unsigned*)(lds + LDS_MISC); if (threadIdx.x < 64) mz[threadIdx.x] = 0u; }
    __syncthreads();
    const XcdBarrier xbar = xcd_barrier_post((unsigned*)(a_in.ws + WS_CTL) + 1024, (volatile LAS unsigned*)(lds + LDS_MISC) + 8);
    bool rep_done = false;
    if (a_in.coop) cg::this_grid().sync();
    for (int ph = a_in.ph_lo; ph < a_in.ph_hi; ++ph) {
        Args a = a_in; { unsigned long long w_ = (unsigned long long)a_in.ws; asm volatile("" : "+s"(w_)); a.ws = (unsigned char*)(__attribute__((address_space(1))) unsigned char*)w_; }
        int tid_l = threadIdx.x; asm volatile("" : "+v"(tid_l));
        const int tid = tid_l, lane = tid & 63, wave = __builtin_amdgcn_readfirstlane(tid >> 6), gw = blockIdx.x * NWAVES + wave;
        if (ph > a.ph_lo) { if (a.coop) xcd_barrier(xbar); }
#if defined(PROBE_SYNCS)
        if (ph == 3) { for (int i_ = 0; i_ < PROBE_SYNCS; ++i_) cg::this_grid().sync(); }
#endif
#if defined(PROBE_PRO)
        if (ph < 3 && !rep_done) { rep_done = true; --ph; } else if (ph < 3) rep_done = false;
#endif
        if (ph == 0) { if constexpr (EN(100)) phase0(a, lds, gw, NGW, wave, lane, tid); continue; }
        if (ph == 1) { if constexpr (EN(101)) phase_ada_reduce(a, tid); continue; }
        if (ph == 2) { if constexpr (EN(102)) rows_update(a, gw, NGW, lane, false, true, nullptr, 0, 0, false, true, a.in[I_GPREMIX], 0, 0); continue; }
        const int l = (ph - 3) / 7, s = (ph - 3) % 7;
#if defined(PROBE_REP)
        if (l == 0 && ((PROBE_REP >> s) & 1) && !rep_done) { rep_done = true; --ph; } else rep_done = false;
#endif
        unsigned char* wb = a.ws + WS_W + (size_t)l * W_LAYER;
        if (s == 0) { if constexpr (EN(0)) {
            pg8::Gemm g{(const bf16*)(a.ws + WS_HN), (const bf16*)(wb + WO_IN), MROWS, DINP, DM}; pg8::StaticOrder S; S.init(MROWS, DINP, G, (int)blockIdx.x);
            EpiFeat2 E{a.ws, a.in[I_AQN] + l * 64, a.in[I_AKN] + l * 64, a.in[I_CLB], l};
            pg8::gemm_phase<EpiFeat2, pg8::StaticOrder, true, true>(lds, g, S, E);
        } } else if (s == 1) { if constexpr (EN(1)) {
            mixer_phase(a, lds, l, wb, G);
#if defined(PROBE_MIXER2)
            if (l == 0) { cg::this_grid().sync(); mixer_phase(a, lds, l, wb, G, 4, PROBE_MIXER2); }
#endif
        } } else if (s == 2) { if constexpr (EN(2)) {
            pg8::Gemm g{(const bf16*)(a.ws + WS_Y), (const bf16*)(wb + WO_OUT), MROWS, DM, DM};
            pg8::EpiStore<0> E{(bf16*)(a.ws + WS_T), DM};
            run_gemm(lds, g, E, G, l + 1 == DEPTH);
        } } else if (s == 3) { if constexpr (EN(3)) {
            rows_update(a, gw, NGW, lane, true, l == 0, a.in[I_GPOSTMIX] + l * DM, l, 2, false, true, a.in[I_GPREFFN] + l * DM, l, 3, l + 1 == DEPTH);
        } } else if (s == 4) { if constexpr (EN(4)) {
            pg8::Gemm g{(const bf16*)(a.ws + WS_HN), (const bf16*)(wb + WO_1), MROWS, DFF, DM};
            pg8::EpiStore<1> E{(bf16*)(a.ws + WS_HB), DFF};
            if (l + 1 < DEPTH && G == 256) {
                const int c = (int)blockIdx.x;
                unsigned* pcnt = (unsigned*)(a.ws + WS_CTL) + 8192 + 1024 * l;
                { pg8::OneUnit S1{(c >> 4) * 17 + 16, c & 15}; pg8::gemm_phase<pg8::EpiStore<1>, pg8::OneUnit, true, true>(lds, g, S1, E); }
                asm volatile("s_waitcnt vmcnt(0)" ::: "memory");
                __syncthreads();
                if (tid == 0) { __builtin_amdgcn_fence(__ATOMIC_RELEASE, "agent"); asm volatile("s_waitcnt vmcnt(0)" ::: "memory"); __hip_atomic_fetch_add(pcnt + 64 * (c >> 4), 1u, __ATOMIC_RELAXED, __HIP_MEMORY_SCOPE_AGENT); }
                if (c < 64) {
                    if (tid == 0) { unsigned sp = 0; while (__hip_atomic_load(pcnt + 64 * (c >> 2), __ATOMIC_RELAXED, __HIP_MEMORY_SCOPE_AGENT) < 16u) { __builtin_amdgcn_s_sleep(2); if (++sp > (1u << 22)) break; }
                        __builtin_amdgcn_fence(__ATOMIC_ACQUIRE, "agent"); asm volatile("s_waitcnt vmcnt(0)" ::: "memory"); }
                    __syncthreads();
                    { pg8::Gemm g2{(const bf16*)(a.ws + WS_HB), (const bf16*)(wb + WO_2), MROWS, DM, DFF}; pg8::EpiStore<0> E2{(bf16*)(a.ws + WS_T2), DM};
                      pg8::OneUnit S2{(c >> 2) * 17 + 16, c & 3}; pg8::gemm_phase<pg8::EpiStore<0>, pg8::OneUnit, true, true>(lds, g2, S2, E2); }
                    { pg8::LatRange S3; S3.init(52, DFF, 64, c, 204); pg8::gemm_phase<pg8::EpiStore<1>, pg8::LatRange, true, true>(lds, g, S3, E); }
                } else {
                    pg8::LatRange S3; S3.init(204, DFF, 192, c - 64, 0); pg8::gemm_phase<pg8::EpiStore<1>, pg8::LatRange, true, true>(lds, g, S3, E);
                }
            } else run_gemm(lds, g, E, G, l + 1 == DEPTH);
        } } else if (s == 5) { if constexpr (EN(5)) {
            pg8::Gemm g{(const bf16*)(a.ws + WS_HB), (const bf16*)(wb + WO_2), MROWS, DM, DFF};
            pg8::EpiStore<0> E{(bf16*)(a.ws + WS_T2), DM};
            run_gemm(lds, g, E, G, (l + 1 == DEPTH) || G == 256);
        } } else { if constexpr (EN(6)) {
            const bool more = (l + 1 < DEPTH);
            rows_update(a, gw, NGW, lane, true, l == 0, a.in[I_GPOSTMIX] + l * DM, l, 2, true, more, a.in[I_GPREMIX] + (more ? (l + 1) : l) * DM, more ? (l + 1) : l, 0, !more, true, a.in[I_GPOSTFFN] + l * DM, 5);
        } }
    }
}

#ifndef ONE_LAUNCH
#define ONE_LAUNCH 1
#endif
extern "C" void kernel_launch(void* const* d_in, const int* in_sizes, int n_in, void* d_out, int out_size, void* d_ws, size_t ws_size, hipStream_t stream) {
    static int grid = 0;
    if (grid == 0) {
        if (n_in != 22 || ws_size < WS_END) { fprintf(stderr, "kernel_launch: expected 22 inputs and >= %zu bytes of workspace (got %d, %zu)\n", (size_t)WS_END, n_in, ws_size); grid = -1; return; }
        int dev = 0, cus = 0, per_cu = 0;
        hipGetDevice(&dev); hipDeviceGetAttribute(&cus, hipDeviceAttributeMultiprocessorCount, dev);
        hipFuncSetAttribute((const void*)fwd_kernel, hipFuncAttributeMaxDynamicSharedMemorySize, LDS_BYTES);
        hipOccupancyMaxActiveBlocksPerMultiprocessor(&per_cu, (const void*)fwd_kernel, NTHR, LDS_BYTES);
        if (per_cu < 1) per_cu = 1;
        grid = cus * 1;
        (void)hipGetLastError();
    }
    if (grid < 0) return;
    (void)hipMemsetAsync((char*)d_ws + WS_CTL, 0, 65536, stream);
    Args a{};
    for (int i = 0; i < 22; ++i) a.in[i] = (const float*)d_in[i];
    a.out = (float*)d_out; a.ws = (unsigned char*)d_ws; a.pad = 0;
#if ONE_LAUNCH
    a.ph_lo = 0; a.ph_hi = N_PHASES; a.coop = 1;
    void* args[] = {&a};
    hipError_t e = hipLaunchCooperativeKernel((const void*)fwd_kernel, dim3(grid), dim3(NTHR), args, LDS_BYTES, stream);
    if (e != hipSuccess) fprintf(stderr, "cooperative launch failed: %s (grid %d)\n", hipGetErrorString(e), grid);
#else
    for (int ph = 0; ph < N_PHASES; ++ph) { a.ph_lo = ph; a.ph_hi = ph + 1; a.coop = 0; hipLaunchKernelGGL(fwd_kernel, dim3(grid), dim3(NTHR), LDS_BYTES, stream, a); }
#endif
}
```

```cpp
#include <hip/hip_runtime.h>
#include <cstdio>
#include <cstdint>
namespace pg8 {
#define PG8_LAS __attribute__((address_space(3)))
typedef unsigned short bf16_t;
typedef short bf16x8 __attribute__((ext_vector_type(8)));
typedef float f32x4 __attribute__((ext_vector_type(4)));
typedef unsigned u32x4 __attribute__((ext_vector_type(4)));
constexpr int BM = 256, BK = 64, HALF = 128, HTB = HALF * BK * 2  , STAGE_BYTES = 8 * HTB, NXCD = 8, WGM = 8;

__host__ __device__ __forceinline__ int lds_byte(int r, int c) { const int st = (r >> 4) * 2 + (c >> 5), rr = r & 15, cc = c & 31, ob = rr * 64 + cc * 2; return st * 1024 + (ob ^ (((ob >> 9) & 1) << 5)); }
__host__ __device__ __forceinline__ void stage_rc(int b, int& R, int& C) { const int st = b / 1024, sb = b % 1024, swz = sb ^ (((sb >> 9) & 1) << 5); R = (st >> 1) * 16 + swz / 64; C = (st & 1) * 32 + (swz % 64) / 2; }
__host__ __device__ __forceinline__ int perm32(int rho) { const int n = rho >> 4, i = rho & 15; return 8 * (i >> 2) + 4 * n + (i & 3); }

struct Unit { int pm, pn; };
struct Gemm { const bf16_t* A; const bf16_t* Bt; int M, N, K; };

struct StaticOrder {
    int nM, nN, nwg, G, c;
    __host__ __device__ void init(int M, int N, int G_, int c_) { nM = M / BM; nN = N / BM; nwg = nM * nN; G = G_; c = c_; }
    __host__ __device__ bool next(int i, Unit& u) const {
        const long L = (long)i * G + c; if (L >= nwg) return false;
        int wgid = (int)L; { const int q = nwg / NXCD, r = nwg % NXCD, xcd = wgid % NXCD, off = wgid / NXCD; wgid = (xcd < r ? xcd * (q + 1) : r * (q + 1) + (xcd - r) * q) + off; }
        const int nig = WGM * nN, gid = wgid / nig, fm = gid * WGM, gsz = (nM - fm) < WGM ? (nM - fm) : WGM;
        u.pm = fm + ((wgid % nig) % gsz); u.pn = (wgid % nig) / gsz; return true;
    }
    __device__ __forceinline__ void a_ready(const Unit&) const {}
    __device__ __forceinline__ void done(const Unit&) const {}
};

struct LatOrder {
    StaticOrder s;
    __host__ __device__ void init(int N, int G_, int c_) { s.init(65536, N, G_, c_); }
    __host__ __device__ bool next(int i, Unit& u) const { if (!s.next(i, u)) return false; u.pm = (u.pm >> 4) * 17 + (u.pm & 15); return true; }
    __device__ __forceinline__ void a_ready(const Unit&) const {}
    __device__ __forceinline__ void done(const Unit&) const {}
};
struct OneUnit {
    int pm, pn;
    __host__ __device__ bool next(int i, Unit& u) const { if (i > 0) return false; u.pm = pm; u.pn = pn; return true; }
    __device__ __forceinline__ void a_ready(const Unit&) const {}
    __device__ __forceinline__ void done(const Unit&) const {}
};
struct LatRange {
    StaticOrder s; int p0;
    __host__ __device__ void init(int np, int N, int G_, int c_, int p0_) { s.init(np * BM, N, G_, c_); p0 = p0_; }
    __host__ __device__ bool next(int i, Unit& u) const { if (!s.next(i, u)) return false; const int p = u.pm + p0; u.pm = (p >> 4) * 17 + (p & 15); return true; }
    __device__ __forceinline__ void a_ready(const Unit&) const {}
    __device__ __forceinline__ void done(const Unit&) const {}
};
typedef float f32x2c_t __attribute__((ext_vector_type(2))); typedef __bf16 bf16x2c_t __attribute__((ext_vector_type(2)));
__device__ __forceinline__ unsigned cvt_pk_bf16(float lo, float hi) { f32x2c_t v = {lo, hi}; bf16x2c_t b = __builtin_convertvector(v, bf16x2c_t); return __builtin_bit_cast(unsigned, b); }
typedef float f32x2 __attribute__((ext_vector_type(2)));

constexpr int TPB_ = 4352;
template <int ACT  > struct EpiStore {
    static constexpr bool PERM = true, AFTER_DRAIN = false;
    bf16_t* O; int ldc;
    __device__ __forceinline__ void operator()(const f32x4 (&acc)[2][2][4][2], const Unit& u, int wr, int wc, int fr, int fq) const {
        const int row0 = u.pm * BM + wr * 64 + fr, col0 = u.pn * BM + wc * 32 + 8 * fq;
#pragma unroll
        for (int ai = 0; ai < 2; ++ai)
#pragma unroll
            for (int m = 0; m < 4; ++m) { bf16_t* rowp = O + (size_t)(row0 + ai * HALF + m * 16) * ldc + col0;
#pragma unroll
                for (int bj = 0; bj < 2; ++bj) { f32x4 v0 = acc[ai][bj][m][0], v1 = acc[ai][bj][m][1];
                    if (ACT == 1) {
#pragma unroll
                        for (int e = 0; e < 4; ++e) { float a = v0[e] > 0.f ? v0[e] : 0.f, b = v1[e] > 0.f ? v1[e] : 0.f; v0[e] = a * a; v1[e] = b * b; } }
                    u32x4 w; w.x = cvt_pk_bf16(v0[0], v0[1]); w.y = cvt_pk_bf16(v0[2], v0[3]); w.z = cvt_pk_bf16(v1[0], v1[1]); w.w = cvt_pk_bf16(v1[2], v1[3]);
                    *(u32x4*)(rowp + bj * HALF) = w; } }
    }
};
struct EpiQup {
    static constexpr bool PERM = false, AFTER_DRAIN = false;
    bf16_t* O; const float* cosB; const float* sinB; float scale;
    __device__ __forceinline__ void operator()(const f32x4 (&acc)[2][2][4][2], const Unit& u, int wr, int wc, int fr, int fq) const {
        typedef unsigned u32x2v __attribute__((ext_vector_type(2)));
        const int row0 = u.pm * BM + wr * 64 + fr;
#pragma unroll
        for (int bj = 0; bj < 2; ++bj) {
            const int cg = u.pn * BM + bj * HALF + wc * 32;
            if (cg >= 384) continue;
            const bool pe = ((cg >> 5) % 3) == 2;
#pragma unroll
            for (int ai = 0; ai < 2; ++ai)
#pragma unroll
                for (int m = 0; m < 4; ++m) {
                    const int row = row0 + ai * HALF + m * 16; const int j = row % TPB_;
                    f32x4 v0 = acc[ai][bj][m][0], v1 = acc[ai][bj][m][1];
                    if (pe && j < 4096) {
                        const int pos = (fq < 2) ? (j >> 6) : (j & 63);
                        const f32x4 cs = *(const f32x4*)(cosB + pos * 8 + 4 * (fq & 1)), sn = *(const f32x4*)(sinB + pos * 8 + 4 * (fq & 1));
                        const f32x4 a = v0 * cs - v1 * sn, b = v1 * cs + v0 * sn; v0 = a; v1 = b;
                    }
                    v0 = v0 * scale; v1 = v1 * scale;
                    bf16_t* p = O + (size_t)row * 384 + cg + 4 * fq;
                    u32x2v w0, w1; w0.x = cvt_pk_bf16(v0[0], v0[1]); w0.y = cvt_pk_bf16(v0[2], v0[3]); w1.x = cvt_pk_bf16(v1[0], v1[1]); w1.y = cvt_pk_bf16(v1[2], v1[3]);
                    *(u32x2v*)p = w0; *(u32x2v*)(p + 16) = w1;
                    asm volatile("" ::: "memory");
                }
        }
    }
};
struct EpiKVup {
    static constexpr bool PERM = true, AFTER_DRAIN = false;
    bf16_t* KB; bf16_t* VB;
    __device__ __forceinline__ void operator()(const f32x4 (&acc)[2][2][4][2], const Unit& u, int wr, int wc, int fr, int fq) const {
        const int row0 = u.pm * BM + wr * 64 + fr;
#pragma unroll
        for (int bj = 0; bj < 2; ++bj) {
            const int head = u.pn * 2 + bj; const int within = wc * 32 + 8 * fq;
#pragma unroll
            for (int ai = 0; ai < 2; ++ai)
#pragma unroll
                for (int m = 0; m < 4; ++m) {
                    const int row = row0 + ai * HALF + m * 16;
                    const f32x4 v0 = acc[ai][bj][m][0], v1 = acc[ai][bj][m][1];
                    u32x4 w; w.x = cvt_pk_bf16(v0[0], v0[1]); w.y = cvt_pk_bf16(v0[2], v0[3]); w.z = cvt_pk_bf16(v1[0], v1[1]); w.w = cvt_pk_bf16(v1[2], v1[3]);
                    bf16_t* p = (within < 64) ? (KB + (size_t)row * 384 + head * 96 + within) : (VB + (size_t)row * 256 + head * 64 + (within - 64));
                    *(u32x4*)p = w;
                }
        }
    }
};

struct EpiFeat {
    static constexpr bool PERM = true, AFTER_DRAIN = false;
    bf16_t* FEAT; int ldf; bf16_t* CFQ; bf16_t* CKF; bf16_t* CKB; bf16_t* CFV; bf16_t* CFG; const float* clb; int layer;
    __device__ __forceinline__ void operator()(const f32x4 (&acc)[2][2][4][2], const Unit& u, int wr, int wc, int fr, int fq) const {
        const int row0 = u.pm * BM + wr * 64 + fr;
#pragma unroll
        for (int bj = 0; bj < 2; ++bj) {
            const int c0 = u.pn * BM + bj * HALF + wc * 32 + 8 * fq;
            if (c0 >= 2400) continue;
            const int seg = (c0 < 1120) ? -1 : ((c0 - 1120) >> 8); const int ch = (c0 - 1120) & 255;
            float om[8];
#pragma unroll
            for (int e = 0; e < 8; ++e) om[e] = 1.0f;
            if (layer > 0 && (seg == 1 || seg == 2)) {
                const float* c1 = clb + 512 + (seg - 1) * 256 + ch; const float* c0p = clb + (seg - 1) * 256 + ch;
#pragma unroll
                for (int e = 0; e < 8; ++e) om[e] = 1.0f - 1.0f / (1.0f + __expf(-(c1[e] - c0p[e])));
            }
            bf16_t* dst; int ld;
            if (seg < 0) { dst = FEAT + c0; ld = ldf; } else { dst = (seg == 0 ? CFQ : seg == 1 ? CKF : seg == 2 ? CKB : seg == 3 ? CFV : CFG) + ch; ld = 256; }
#pragma unroll
            for (int ai = 0; ai < 2; ++ai)
#pragma unroll
                for (int m = 0; m < 4; ++m) {
                    const int row = row0 + ai * HALF + m * 16;
                    f32x4 v0 = acc[ai][bj][m][0], v1 = acc[ai][bj][m][1];
                    if (seg == 0) {
#pragma unroll
                        for (int e = 0; e < 4; ++e) { v0[e] = v0[e] / (1.0f + __expf(-v0[e])); v1[e] = v1[e] / (1.0f + __expf(-v1[e])); }
                    } else if (seg == 1 || seg == 2) {
#pragma unroll
                        for (int e = 0; e < 4; ++e) { v0[e] = om[e] / (1.0f + __expf(v0[e])); v1[e] = om[4 + e] / (1.0f + __expf(v1[e])); }
                    }
                    u32x4 w; w.x = cvt_pk_bf16(v0[0], v0[1]); w.y = cvt_pk_bf16(v0[2], v0[3]); w.z = cvt_pk_bf16(v1[0], v1[1]); w.w = cvt_pk_bf16(v1[2], v1[3]);
                    *(u32x4*)(dst + (size_t)row * ld) = w;
                }
        }
    }
};
template <class Epi, class Sched, bool ALIGN_EPI = false, bool SP2 = false>
__device__ __forceinline__ void gemm_phase(PG8_LAS unsigned char* lds, const Gemm g, const Sched& S, const Epi& E) {
    int tid_l = threadIdx.x; asm volatile("" : "+v"(tid_l)); const int tid = tid_l, wid = __builtin_amdgcn_readfirstlane(tid >> 6), lane = tid & 63, wr = wid >> 2, wc = wid & 3, fr = lane & 15, fq = lane >> 4;
    const int K = g.K, nt = K / BK;
    unsigned voffA[2], voffB[2];
#pragma unroll
    for (int i = 0; i < 2; ++i) { int R, C; stage_rc(tid * 16 + i * 8192, R, C); const int Rb = Epi::PERM ? ((R & ~31) + perm32(R & 31)) : R;
        voffA[i] = (unsigned)(R * K + C) * 2u; voffB[i] = (unsigned)(Rb * K + C) * 2u; }
    const size_t kstep = (size_t)(BK * 2);
    const size_t hstep = (size_t)HALF * K * 2;
    const size_t tstep = 2 * hstep;
    const unsigned ldsw = (unsigned)wid * 1024u;
    const int aoff = lds_byte(wr * 64 + fr, fq * 8), boff = lds_byte(wc * 32 + fr, fq * 8);
#define PG8_SA(b, h) (((b) * 2 + (h)) * HTB)
#define PG8_SB(b, h) ((4 + (b) * 2 + (h)) * HTB)
#define PG8_STAGE(bufoff, gbase, voff) do { _Pragma("unroll") for (int _i = 0; _i < 2; ++_i) \
        __builtin_amdgcn_global_load_lds((const unsigned*)((const char*)(gbase) + (voff)[_i]), (PG8_LAS unsigned*)(lds + (bufoff) + ldsw + _i * 8192), 16, 0, 0); } while (0)
#define PG8_LDA(dst, b, h) do { _Pragma("unroll") for (int m = 0; m < 4; ++m) _Pragma("unroll") for (int k = 0; k < 2; ++k) dst[m][k] = *(const PG8_LAS bf16x8*)(lds + PG8_SA(b, h) + aoff + m * 2048 + k * 1024); } while (0)
#define PG8_LDB(dst, b, h) do { _Pragma("unroll") for (int n = 0; n < 2; ++n) _Pragma("unroll") for (int k = 0; k < 2; ++k) dst[n][k] = *(const PG8_LAS bf16x8*)(lds + PG8_SB(b, h) + boff + n * 2048 + k * 1024); } while (0)
#define PG8_MMA(ai, bj, At, Bt) do { __builtin_amdgcn_s_setprio(1); _Pragma("unroll") for (int m = 0; m < 4; ++m) _Pragma("unroll") for (int n = 0; n < 2; ++n) _Pragma("unroll") for (int k = 0; k < 2; ++k) \
        acc[ai][bj][m][n] = __builtin_amdgcn_mfma_f32_16x16x32_bf16(Bt[n][k], At[m][k], acc[ai][bj][m][n], 0, 0, 0); __builtin_amdgcn_s_setprio(0); } while (0)
#define PG8_WAIT_V(n) asm volatile("s_waitcnt vmcnt(" #n ")" ::: "memory")
#define PG8_WAIT_L(n) asm volatile("s_waitcnt lgkmcnt(" #n ")" ::: "memory")
#define PG8_BAR __builtin_amdgcn_s_barrier()
#define PG8_SCHED __builtin_amdgcn_sched_barrier(0)
    Unit cur, nxt; int ui = 0;
    if (!S.next(0, cur)) return;
    f32x4 acc[2][2][4][2];
#pragma unroll
    for (int a = 0; a < 2; ++a)
#pragma unroll
        for (int b = 0; b < 2; ++b)
#pragma unroll
            for (int m = 0; m < 4; ++m)
#pragma unroll
                for (int n = 0; n < 2; ++n) acc[a][b][m][n] = (f32x4){0.f, 0.f, 0.f, 0.f};
    bf16x8 At[4][2], B0[2][2], B1[2][2];
    const char* cA = (const char*)g.A + (size_t)cur.pm * tstep; const char* cB = (const char*)g.Bt + (size_t)cur.pn * tstep;
    S.a_ready(cur);
    if constexpr (SP2) {
        PG8_STAGE(PG8_SB(0, 0), cB, voffB); PG8_STAGE(PG8_SB(0, 1), cB + hstep, voffB); PG8_STAGE(PG8_SA(0, 0), cA, voffA); PG8_STAGE(PG8_SA(0, 1), cA + hstep, voffA);
        if (wr == 1) PG8_BAR;
        PG8_WAIT_V(2); PG8_BAR;
        PG8_STAGE(PG8_SB(1, 0), cB + kstep, voffB); PG8_STAGE(PG8_SA(1, 0), cA + kstep, voffA); PG8_STAGE(PG8_SB(1, 1), cB + hstep + kstep, voffB);
        PG8_WAIT_V(6); PG8_BAR;
    } else {
        PG8_STAGE(PG8_SB(0, 0), cB, voffB); PG8_STAGE(PG8_SA(0, 0), cA, voffA); PG8_STAGE(PG8_SB(0, 1), cB + hstep, voffB); PG8_STAGE(PG8_SA(0, 1), cA + hstep, voffA);
        if (wr == 1) PG8_BAR;
        PG8_WAIT_V(4); PG8_BAR;
        PG8_STAGE(PG8_SB(1, 0), cB + kstep, voffB); PG8_STAGE(PG8_SA(1, 0), cA + kstep, voffA); PG8_STAGE(PG8_SB(1, 1), cB + hstep + kstep, voffB);
        PG8_WAIT_V(6); PG8_BAR;
    }
    for (;;) {
        const bool has_next = S.next(ui + 1, nxt);
        const char* nA = has_next ? (const char*)g.A + (size_t)nxt.pm * tstep : cA; const char* nB = has_next ? (const char*)g.Bt + (size_t)nxt.pn * tstep : cB;
        for (int t = 0; t < nt; t += 2) {
            const bool last = (t == nt - 2);
            const char* a1 = cA + (size_t)(t + 1) * kstep;
            const char* a2 = last ? nA : cA + (size_t)(t + 2) * kstep; const char* b2 = last ? nB : cB + (size_t)(t + 2) * kstep;
            const char* a3 = a2 + kstep; const char* b3 = b2 + kstep;
            if (last && has_next) S.a_ready(nxt);
            if constexpr (SP2) {
            PG8_LDB(B0, 0, 0); PG8_LDB(B1, 0, 1); PG8_SCHED; PG8_LDA(At, 0, 0); PG8_STAGE(PG8_SA(1, 1), a1 + hstep, voffA);
            PG8_WAIT_V(8); PG8_WAIT_L(0); PG8_BAR; PG8_MMA(0, 0, At, B0); PG8_MMA(0, 1, At, B1); PG8_BAR; PG8_SCHED;
            PG8_LDA(At, 0, 1); PG8_STAGE(PG8_SB(0, 0), b2, voffB); PG8_STAGE(PG8_SB(0, 1), b2 + hstep, voffB); PG8_STAGE(PG8_SA(0, 0), a2, voffA);
            PG8_WAIT_V(8); PG8_WAIT_L(0); PG8_BAR; PG8_MMA(1, 0, At, B0); PG8_MMA(1, 1, At, B1); PG8_BAR; PG8_SCHED;
            PG8_LDB(B0, 1, 0); PG8_LDB(B1, 1, 1); PG8_SCHED; PG8_LDA(At, 1, 0); PG8_STAGE(PG8_SA(0, 1), a2 + hstep, voffA);
            PG8_WAIT_V(8); PG8_WAIT_L(0); PG8_BAR; PG8_MMA(0, 0, At, B0); PG8_MMA(0, 1, At, B1); PG8_BAR; PG8_SCHED;
            PG8_LDA(At, 1, 1); PG8_STAGE(PG8_SB(1, 0), b3, voffB); PG8_STAGE(PG8_SB(1, 1), b3 + hstep, voffB); PG8_STAGE(PG8_SA(1, 0), a3, voffA);
            PG8_WAIT_V(8); PG8_WAIT_L(0); PG8_BAR; PG8_MMA(1, 0, At, B0); PG8_MMA(1, 1, At, B1); PG8_BAR; PG8_SCHED;
            } else {
            PG8_LDB(B0, 0, 0); PG8_SCHED; PG8_LDA(At, 0, 0); PG8_STAGE(PG8_SA(1, 1), a1 + hstep, voffA);
            PG8_WAIT_L(8); PG8_BAR; PG8_WAIT_L(0); PG8_MMA(0, 0, At, B0); PG8_BAR; PG8_SCHED;
            PG8_LDB(B1, 0, 1); PG8_STAGE(PG8_SB(0, 0), b2, voffB);
            PG8_BAR; PG8_WAIT_L(0); PG8_MMA(0, 1, At, B1); PG8_BAR;
            PG8_LDA(At, 0, 1); PG8_STAGE(PG8_SA(0, 0), a2, voffA);
            PG8_BAR; PG8_WAIT_L(0); PG8_MMA(1, 0, At, B0); PG8_BAR; PG8_SCHED;
            PG8_STAGE(PG8_SB(0, 1), b2 + hstep, voffB);
            PG8_WAIT_V(6); PG8_BAR; PG8_MMA(1, 1, At, B1); PG8_BAR;
            PG8_LDB(B0, 1, 0); PG8_SCHED; PG8_LDA(At, 1, 0); PG8_STAGE(PG8_SA(0, 1), a2 + hstep, voffA);
            PG8_WAIT_L(8); PG8_BAR; PG8_WAIT_L(0); PG8_MMA(0, 0, At, B0); PG8_BAR; PG8_SCHED;
            PG8_LDB(B1, 1, 1); PG8_STAGE(PG8_SB(1, 0), b3, voffB);
            PG8_BAR; PG8_WAIT_L(0); PG8_MMA(0, 1, At, B1); PG8_BAR;
            PG8_LDA(At, 1, 1); PG8_STAGE(PG8_SA(1, 0), a3, voffA);
            PG8_BAR; PG8_WAIT_L(0); PG8_MMA(1, 0, At, B0); PG8_BAR; PG8_SCHED;
            PG8_STAGE(PG8_SB(1, 1), b3 + hstep, voffB);
            PG8_WAIT_V(6); PG8_BAR; PG8_MMA(1, 1, At, B1); PG8_BAR;
            }
        }
        if constexpr (ALIGN_EPI) { if (wr == 0) PG8_BAR; }
        if constexpr (!Epi::AFTER_DRAIN) { E(acc, cur, wr, wc, fr, fq); S.done(cur); }
        if (!has_next) break;
#pragma unroll
        for (int a = 0; a < 2; ++a)
#pragma unroll
            for (int b = 0; b < 2; ++b)
#pragma unroll
                for (int m = 0; m < 4; ++m)
#pragma unroll
                    for (int n = 0; n < 2; ++n) acc[a][b][m][n] = (f32x4){0.f, 0.f, 0.f, 0.f};
        cur = nxt; cA = nA; cB = nB; ++ui;
        if constexpr (ALIGN_EPI) { if (wr == 1) PG8_BAR; }
    }
    PG8_WAIT_V(0);
    if constexpr (!ALIGN_EPI) { if (wr == 0) PG8_BAR; }
    PG8_BAR;
    if constexpr (Epi::AFTER_DRAIN) { E.fused(acc, cur, wr, wc, fr, fq, lds, wid, lane); S.done(cur); }
#undef PG8_SA
#undef PG8_SB
#undef PG8_STAGE
#undef PG8_LDA
#undef PG8_LDB
#undef PG8_MMA
#undef PG8_WAIT_V
#undef PG8_WAIT_L
#undef PG8_BAR
#undef PG8_SCHED
}
}

#include <hip/hip_cooperative_groups.h>
namespace cg = cooperative_groups;
#define LAS __attribute__((address_space(3)))
typedef unsigned short bf16;
typedef short bf16x8 __attribute__((ext_vector_type(8)));
typedef float f32x4 __attribute__((ext_vector_type(4)));
typedef float f32x16 __attribute__((ext_vector_type(16)));
typedef unsigned u32x4 __attribute__((ext_vector_type(4)));
typedef unsigned u32x2 __attribute__((ext_vector_type(2)));
typedef short s16x4 __attribute__((ext_vector_type(4)));

constexpr int NB = 16, SEQ = 4096, CTX = 256, TPB = 4352, MROWS = NB * TPB, DM = 1024, DIN = 2400, DINP = 2560, DFF = 4096, DEPTH = 2;
constexpr int NTHR = 512, NWAVES = 8;
constexpr float EPS = 1e-6f;
constexpr float LOG2E = 1.4426950408889634f;
constexpr float QSCALE_A = 0.125f * LOG2E;
constexpr float QSCALE_B = 0.10206207261596577f * LOG2E;
constexpr int C_AQ = 0, C_AK = 512, C_AV = 640, C_BQD = 768, C_BKVD = 960, C_BKR = 1088, C_CQ = 1120, C_CFF = 1376, C_CFB = 1632, C_CI = 1888, C_CG = 2144;

constexpr size_t MiB = 1u << 20;
constexpr size_t WS_CTL = 0;
constexpr size_t WS_ADA = 1 * MiB;
constexpr size_t WS_TAB = 2 * MiB;
constexpr size_t WS_SSQ_Q = 1020 * MiB, WS_SSQ_KV = 1022 * MiB + 262144;
constexpr size_t WS_PART = 1004 * MiB;
constexpr size_t WS_W = 4 * MiB, W_LAYER = 24 * MiB;
constexpr size_t WO_IN = 0, WO_OUT = 5 * MiB, WO_1 = 7 * MiB, WO_2 = 15 * MiB, WO_QU = 23 * MiB, WO_KVU = 23 * MiB + 512 * 1024;
constexpr size_t WS_XC = 52 * MiB;
constexpr size_t WS_HN = 68 * MiB;
constexpr size_t WS_T = 204 * MiB;
constexpr size_t WS_Y = 340 * MiB;
constexpr size_t WS_T2 = WS_Y;
constexpr size_t WS_OV = 476 * MiB;
constexpr size_t WS_HB = WS_OV;
constexpr size_t WS_FEAT = WS_OV;
constexpr size_t WS_QA = 816 * MiB, WS_KB = 884 * MiB, WS_CFQ = 935 * MiB, WS_CFV = 969 * MiB, WS_KA = 1003 * MiB;
constexpr size_t WS_VA = WS_T, WS_CFG = WS_T + 17 * MiB, WS_CKF = WS_T + 51 * MiB, WS_CKB = WS_T + 85 * MiB;
constexpr size_t WS_BQD = WS_Y, WS_BKVD = WS_Y + 34 * MiB;
constexpr size_t WS_QB = WS_OV, WS_VB = WS_OV + 51 * MiB, WS_OF = WS_OV + 85 * MiB, WS_OB = WS_OV + 153 * MiB;
constexpr size_t WS_END = 1024 * MiB;

constexpr int LDS_BYTES = 131072 + 1024;
constexpr int LDS_MISC = 131072;

__device__ __forceinline__ unsigned pk2(float lo, float hi) { return pg8::cvt_pk_bf16(lo, hi); }
__device__ __forceinline__ float bf_lo(unsigned w) { return __uint_as_float(w << 16); }
__device__ __forceinline__ float bf_hi(unsigned w) { return __uint_as_float(w & 0xffff0000u); }
__device__ __forceinline__ void unpack8(const u32x4 w, float (&f)[8]) { f[0] = bf_lo(w.x); f[1] = bf_hi(w.x); f[2] = bf_lo(w.y); f[3] = bf_hi(w.y); f[4] = bf_lo(w.z); f[5] = bf_hi(w.z); f[6] = bf_lo(w.w); f[7] = bf_hi(w.w); }
__device__ __forceinline__ u32x4 pack8(const float (&f)[8]) { u32x4 w; w.x = pk2(f[0], f[1]); w.y = pk2(f[2], f[3]); w.z = pk2(f[4], f[5]); w.w = pk2(f[6], f[7]); return w; }
__device__ __forceinline__ float wave_sum(float v) {
#pragma unroll
    for (int o = 1; o < 64; o <<= 1) v += __shfl_xor(v, o);
    return v;
}
__device__ __forceinline__ float sigmoidf_(float z) { return 1.0f / (1.0f + __expf(-z)); }
__device__ __forceinline__ float siluf_(float z) { return z / (1.0f + __expf(-z)); }

#define XB_TMO      128
#define XB_XCNT(j)  (256  + 64 * (j))
#define XB_XSUB(j)  (1280 + 64 * (j))
#define XB_XGEN(j)  (2304 + 64 * (j))
#define XB_TOP      3328
#define XB_TOPGEN   3392
#define XCD_BAR_WORDS 3456
#define XB_SPIN_CAP (1u << 18)

__device__ __forceinline__ unsigned xb_ld(unsigned* p)              { return __hip_atomic_load(p, __ATOMIC_RELAXED, __HIP_MEMORY_SCOPE_AGENT); }
__device__ __forceinline__ unsigned xb_add(unsigned* p, unsigned v) { return __hip_atomic_fetch_add(p, v, __ATOMIC_RELAXED, __HIP_MEMORY_SCOPE_AGENT); }
__device__ __forceinline__ unsigned xb_xcc_id() { return (unsigned)__builtin_amdgcn_s_getreg((3 << 11) | 20) & 0xFu; }
#define XB_SPIN(cond, bar) do { unsigned _sp = 0; while (cond) { __builtin_amdgcn_s_sleep(1); \
    if ((++_sp & 255u) == 0u) { if (xb_ld(&(bar)[XB_TMO])) break; if (_sp > XB_SPIN_CAP) { atomicAdd(&(bar)[XB_TMO], 1u); break; } } } } while (0)

struct XcdBarrier {
    unsigned* bar; unsigned x;
    volatile LAS unsigned* st;
};

__device__ __forceinline__ XcdBarrier xcd_barrier_post(unsigned* bar, volatile LAS unsigned* st) {
    XcdBarrier b; b.bar = bar; b.x = xb_xcc_id(); b.st = st;
    if (threadIdx.x == 0) (void)xb_add(&bar[XB_XCNT(b.x)], 1u);
    return b;
}
__device__ __forceinline__ void xcd_barrier_complete(unsigned* bar, unsigned x, unsigned& nloc, unsigned& nx) {
    const unsigned G = gridDim.x * gridDim.y * gridDim.z;
    unsigned sum, cnt, mine, sp = 0u;
    for (;;) {
        sum = 0u; cnt = 0u; mine = 0u;
#pragma unroll
        for (unsigned j = 0; j < 16; ++j) { const unsigned c = xb_ld(&bar[XB_XCNT(j)]); sum += c; cnt += (c > 0u) ? 1u : 0u; mine = (j == x) ? c : mine; }
        if (sum == G) break;
        __builtin_amdgcn_s_sleep(1);
        if ((++sp & 255u) == 0u) { if (xb_ld(&bar[XB_TMO])) break; if (sp > XB_SPIN_CAP) { atomicAdd(&bar[XB_TMO], 1u); break; } }
    }
    nloc = mine > 0u ? mine : 1u; nx = cnt > 0u ? cnt : 1u;
}

__device__ __forceinline__ void xcd_barrier(const XcdBarrier& b) {
    asm volatile("s_waitcnt vmcnt(0)" ::: "memory");
    __syncthreads();
    if (threadIdx.x == 0) {
        unsigned* bar = b.bar;
        __builtin_amdgcn_s_waitcnt(0);
        unsigned nloc = b.st[0], nx = b.st[1];
        if (nloc == 0u) { xcd_barrier_complete(bar, b.x, nloc, nx); b.st[0] = nloc; b.st[1] = nx; }
        const unsigned old = xb_add(&bar[XB_XSUB(b.x)], 1u);
        const unsigned gen = old / nloc;
        if (old + 1u == (gen + 1u) * nloc) {
            __builtin_amdgcn_fence(__ATOMIC_RELEASE, "agent");
            asm volatile("s_waitcnt vmcnt(0)" ::: "memory");
            const unsigned og = xb_add(&bar[XB_TOP], 1u);
            const unsigned tg = og / nx;
            if (og + 1u == (tg + 1u) * nx) xb_add(&bar[XB_TOPGEN], 1u);
            else XB_SPIN(xb_ld(&bar[XB_TOPGEN]) == tg, bar);
            __builtin_amdgcn_fence(__ATOMIC_ACQUIRE, "agent");
            xb_add(&bar[XB_XGEN(b.x)], 1u);
            asm volatile("s_waitcnt vmcnt(0)" ::: "memory");
        } else {
            XB_SPIN(xb_ld(&bar[XB_XGEN(b.x)]) == gen, bar);
            __builtin_amdgcn_fence(__ATOMIC_ACQUIRE, "agent");
            asm volatile("s_waitcnt vmcnt(0)" ::: "memory");
        }
    }
    __syncthreads();
}

struct Args {
    const float* in[22];
    float* out; unsigned char* ws;
    int ph_lo, ph_hi, coop, pad;
};
enum { I_X = 0, I_C, I_CTX, I_CCTX, I_WADA, I_BADA, I_GPREMIX, I_GPOSTMIX, I_GPREFFN, I_GPOSTFFN, I_WIN, I_AQN, I_AKN, I_BQN, I_WQUP, I_BKVN, I_WKVUP, I_CLB, I_CON, I_WOUT, I_WFF1, I_WFF2 };

__device__ __forceinline__ void transpose_item(const float* W, int K, int N, bf16* WT, int Kp, int Np, LAS float* scr, int item, int lane, const float* kscale = nullptr, bool headsplit = false) {
    const int nblk = Np / 32, kb = item / nblk, nb = item % nblk, k0 = 64 * kb, n0 = 32 * nb;
    const int n0o = (headsplit && n0 < 768) ? ((n0 & ~255) + ((n0 >> 5) & 1) * 128 + ((n0 >> 6) & 3) * 32) : n0;
    const int n = n0 + (lane & 31);
#pragma unroll
    for (int i = 0; i < 32; ++i) { const int kk = 2 * i + (lane >> 5); const int k = k0 + kk; scr[kk * 33 + (lane & 31)] = (k < K && n < N) ? W[(size_t)k * N + n] * (kscale ? kscale[k] : 1.0f) : 0.f; }
    asm volatile("s_waitcnt lgkmcnt(0)" ::: "memory");
    const int c = lane & 7;
#pragma unroll
    for (int j = 0; j < 4; ++j) { const int nn = (lane >> 3) + 8 * j; const LAS float* s = scr + (8 * c) * 33 + nn;
        u32x4 o; o.x = pk2(s[0 * 33], s[1 * 33]); o.y = pk2(s[2 * 33], s[3 * 33]); o.z = pk2(s[4 * 33], s[5 * 33]); o.w = pk2(s[6 * 33], s[7 * 33]);
        *(u32x4*)(WT + (size_t)(n0o + nn) * Kp + k0 + 8 * c) = o; }
    asm volatile("s_waitcnt lgkmcnt(0)" ::: "memory");
}
__device__ __forceinline__ void phase0(const Args& a, LAS unsigned char* lds, int gw, int NGW, int wave, int lane, int tid) {
    LAS float* scr = (LAS float*)(lds + wave * 16384);
    constexpr int I_IN = 16 * 80, I_OUT = 16 * 32, I_1 = 16 * 128, I_2 = 64 * 32, I_QU = 4 * 16, I_KVU = 2 * 16, I_L = I_IN + I_OUT + I_1 + I_2 + I_QU + I_KVU;
    for (int it = gw; it < 2 * I_L; it += NGW) {
        const int l = it / I_L; int r = it % I_L; unsigned char* wb = a.ws + WS_W + (size_t)l * W_LAYER;
        if (r < I_IN) { transpose_item(a.in[I_WIN] + (size_t)l * DM * DIN, DM, DIN, (bf16*)(wb + WO_IN), DM, DINP, scr, r, lane, nullptr, true); continue; } r -= I_IN;
        if (r < I_OUT) { transpose_item(a.in[I_WOUT] + (size_t)l * DM * DM, DM, DM, (bf16*)(wb + WO_OUT), DM, DM, scr, r, lane); continue; } r -= I_OUT;
        if (r < I_1) { transpose_item(a.in[I_WFF1] + (size_t)l * DM * DFF, DM, DFF, (bf16*)(wb + WO_1), DM, DFF, scr, r, lane); continue; } r -= I_1;
        if (r < I_2) { transpose_item(a.in[I_WFF2] + (size_t)l * DFF * DM, DFF, DM, (bf16*)(wb + WO_2), DFF, DM, scr, r, lane); continue; } r -= I_2;
        if (r < I_QU) { transpose_item(a.in[I_WQUP] + (size_t)l * 192 * 384, 192, 384, (bf16*)(wb + WO_QU), 256, 512, scr, r, lane, a.in[I_BQN] + l * 192); continue; } r -= I_QU;
        transpose_item(a.in[I_WKVUP] + (size_t)l * 128 * 512, 128, 512, (bf16*)(wb + WO_KVU), 128, 512, scr, r, lane, a.in[I_BKVN] + l * 128);
    }
    float* PART = (float*)(a.ws + WS_PART);
    for (int it = gw; it < 16 * 2 * 96; it += NGW) {
        const int nb = it % 96, l = (it / 96) % 2, ks = it / 192; const int n = nb * 64 + lane;
        float creg[17];
#pragma unroll
        for (int r = 0; r < 17; ++r) { const float cv = (r < 16) ? a.in[I_C][r * DM + ks * 64 + lane] : a.in[I_CCTX][ks * 64 + lane]; creg[r] = siluf_(cv); }
        float acc[17];
#pragma unroll
        for (int r = 0; r < 17; ++r) acc[r] = 0.f;
        const float* wp = a.in[I_WADA] + ((size_t)l * DM + ks * 64) * 6144 + n;
#pragma unroll 32
        for (int kk = 0; kk < 64; ++kk) { const float w = wp[(size_t)kk * 6144];
#pragma unroll
            for (int r = 0; r < 17; ++r) acc[r] += __shfl(creg[r], kk) * w; }
#pragma unroll
        for (int r = 0; r < 17; ++r) PART[(((size_t)ks * 2 + l) * 17 + r) * 6144 + n] = acc[r];
    }
    if (blockIdx.x == 0) {
        float* tab = (float*)(a.ws + WS_TAB);
        for (int e = tid; e < 64 * 16 + 64 * 8; e += NTHR) {
            int pos, f, nf; float* cdst; float* sdst;
            if (e < 1024) { pos = e >> 4; f = e & 15; nf = 16; cdst = tab + e; sdst = tab + 1024 + e; }
            else { const int e2 = e - 1024; pos = e2 >> 3; f = e2 & 7; nf = 8; cdst = tab + 2048 + e2; sdst = tab + 2560 + e2; }
            const float inv = exp2f(-(float)f / (float)nf * 13.287712379549449f);
            const float ang = (float)pos * inv;
            const float kf = rintf(ang * 0.15915494309189535f);
            float rr = fmaf(-kf, 6.28125f, ang); rr = fmaf(-kf, 1.9353071795864769e-3f, rr);
            *cdst = __cosf(rr); *sdst = __sinf(rr);
        }
    }
}
__device__ __forceinline__ void phase_ada_reduce(const Args& a, int tid) {
    const float* PART = (const float*)(a.ws + WS_PART); float* ADA = (float*)(a.ws + WS_ADA);
    for (int e = blockIdx.x * NTHR + tid; e < 2 * 17 * 6144; e += gridDim.x * NTHR) {
        const int n = e % 6144, l = e / (17 * 6144);
        float s = a.in[I_BADA][l * 6144 + n];
#pragma unroll
        for (int ks = 0; ks < 16; ++ks) s += PART[(size_t)ks * (2 * 17 * 6144) + e];
        ADA[e] = s;
    }
}

__device__ __forceinline__ const float* ada_ptr(const Args& a, int l, int R, int chunk) { const int b = R / TPB, j = R % TPB; const int r = (j < SEQ) ? b : 16; return (const float*)(a.ws + WS_ADA) + ((size_t)l * 17 + r) * 6144 + chunk * DM; }
__device__ __forceinline__ size_t xrow_off(int R, bool& lat) { const int b = R / TPB, j = R % TPB; lat = j < SEQ; return lat ? ((size_t)b * SEQ + j) * DM : ((size_t)b * CTX + (j - SEQ)) * DM; }
#define RCOL(q) (8 * lane + 512 * ((q) >> 1) + 4 * ((q) & 1))
struct RowIn { f32x4 x[4]; u32x4 t[2]; u32x4 t2[2]; };
__device__ __forceinline__ void row_load(const Args& a, int R, int lane, bool has_upd, bool xin_from_inputs, RowIn& r, bool has_upd2 = false) {
    bool lat; const size_t xo = xrow_off(R, lat);
    const float* xin = xin_from_inputs ? (lat ? a.in[I_X] : a.in[I_CTX]) : (lat ? (const float*)a.out : (const float*)(a.ws + WS_XC));
#pragma unroll
    for (int q = 0; q < 4; ++q) r.x[q] = *(const f32x4*)(xin + xo + RCOL(q));
    if (has_upd) { const bf16* T = (const bf16*)(a.ws + WS_T) + (size_t)R * DM;
#pragma unroll
        for (int h = 0; h < 2; ++h) r.t[h] = *(const u32x4*)(T + 8 * lane + 512 * h); }
    if (has_upd2) { const bf16* T2 = (const bf16*)(a.ws + WS_T2) + (size_t)R * DM;
#pragma unroll
        for (int h = 0; h < 2; ++h) r.t2[h] = *(const u32x4*)(T2 + 8 * lane + 512 * h); }
}
__device__ __forceinline__ void row_compute(const Args& a, int R, int lane, const RowIn& in, bool has_upd, const float* gpost, int l_gate, int gate_chunk,
                                            bool write_x, bool has_hn, const float* gpre, int l_mod, int sh_chunk, bool has_upd2 = false, const float* gpost2 = nullptr, int gate_chunk2 = 0) {
    bool lat; const size_t xo = xrow_off(R, lat);
    float* xout = lat ? a.out : (float*)(a.ws + WS_XC);
    f32x4 v[4];
#pragma unroll
    for (int q = 0; q < 4; ++q) v[q] = in.x[q];
    if (has_upd) {
        f32x4 t[4]; float ss = 0.f;
#pragma unroll
        for (int q = 0; q < 4; ++q) { const u32x4 w4 = in.t[q >> 1]; const unsigned wx = (q & 1) ? w4.z : w4.x, wy = (q & 1) ? w4.w : w4.y; t[q] = (f32x4){bf_lo(wx), bf_hi(wx), bf_lo(wy), bf_hi(wy)}; ss += t[q].x * t[q].x + t[q].y * t[q].y + t[q].z * t[q].z + t[q].w * t[q].w; }
        const float rinv = rsqrtf(wave_sum(ss) * (1.0f / DM) + EPS);
        const float* gate = ada_ptr(a, l_gate, R, gate_chunk);
#pragma unroll
        for (int q = 0; q < 4; ++q) { const f32x4 g = *(const f32x4*)(gpost + RCOL(q)), gt = *(const f32x4*)(gate + RCOL(q)); v[q] = v[q] + gt * (t[q] * rinv * g); }
    }
    if (has_upd2) {
        f32x4 t[4]; float ss = 0.f;
#pragma unroll
        for (int q = 0; q < 4; ++q) { const u32x4 w4 = in.t2[q >> 1]; const unsigned wx = (q & 1) ? w4.z : w4.x, wy = (q & 1) ? w4.w : w4.y; t[q] = (f32x4){bf_lo(wx), bf_hi(wx), bf_lo(wy), bf_hi(wy)}; ss += t[q].x * t[q].x + t[q].y * t[q].y + t[q].z * t[q].z + t[q].w * t[q].w; }
        const float rinv = rsqrtf(wave_sum(ss) * (1.0f / DM) + EPS);
        const float* gate = ada_ptr(a, l_gate, R, gate_chunk2);
#pragma unroll
        for (int q = 0; q < 4; ++q) { const f32x4 g = *(const f32x4*)(gpost2 + RCOL(q)), gt = *(const f32x4*)(gate + RCOL(q)); v[q] = v[q] + gt * (t[q] * rinv * g); }
    }
    if (has_upd || has_upd2) {
        if (write_x) {
#pragma unroll
            for (int q = 0; q < 4; ++q) *(f32x4*)(xout + xo + RCOL(q)) = v[q];
        }
    }
    if (has_hn) {
        float ss = 0.f;
#pragma unroll
        for (int q = 0; q < 4; ++q) ss += v[q].x * v[q].x + v[q].y * v[q].y + v[q].z * v[q].z + v[q].w * v[q].w;
        const float rinv = rsqrtf(wave_sum(ss) * (1.0f / DM) + EPS);
        const float* sh = ada_ptr(a, l_mod, R, sh_chunk); const float* sc = sh + DM;
        bf16* HN = (bf16*)(a.ws + WS_HN) + (size_t)R * DM; u32x2 hw[4];
#pragma unroll
        for (int q = 0; q < 4; ++q) { const f32x4 g = *(const f32x4*)(gpre + RCOL(q)), s1 = *(const f32x4*)(sc + RCOL(q)), s0 = *(const f32x4*)(sh + RCOL(q));
            const f32x4 h = (v[q] * rinv * g) * (s1 + 1.0f) + s0; hw[q].x = pk2(h.x, h.y); hw[q].y = pk2(h.z, h.w); }
#pragma unroll
        for (int h2 = 0; h2 < 2; ++h2) *(u32x4*)(HN + 8 * lane + 512 * h2) = (u32x4){hw[2 * h2].x, hw[2 * h2].y, hw[2 * h2 + 1].x, hw[2 * h2 + 1].y};
    }
}
__device__ __forceinline__ void rows_update(const Args& a, int gw, int NGW, int lane, bool has_upd, bool xin_from_inputs, const float* gpost, int l_gate, int gate_chunk,
                                            bool write_x, bool has_hn, const float* gpre, int l_mod, int sh_chunk, bool lat_only = false, bool has_upd2 = false, const float* gpost2 = nullptr, int gate_chunk2 = 0) {
    const int NR = lat_only ? NB * SEQ : MROWS;
#define ROWMAP(i) (lat_only ? (((i) >> 12) * TPB + ((i) & 4095)) : (i))
    int Ri = gw; if (Ri >= NR) return;
    int R = ROWMAP(Ri);
    RowIn cur, nxt; row_load(a, R, lane, has_upd, xin_from_inputs, cur, has_upd2);
    nxt = cur; { const int Ri1 = Ri + NGW; if (Ri1 < NR) row_load(a, ROWMAP(Ri1), lane, has_upd, xin_from_inputs, nxt, has_upd2); }
    for (;;) {
        const int Ri2 = Ri + 2 * NGW; RowIn nx2 = nxt;
        if (Ri2 < NR) row_load(a, ROWMAP(Ri2), lane, has_upd, xin_from_inputs, nx2, has_upd2);
        row_compute(a, R, lane, cur, has_upd, gpost, l_gate, gate_chunk, write_x, has_hn, gpre, l_mod, sh_chunk, has_upd2, gpost2, gate_chunk2);
        Ri += NGW; if (Ri >= NR) break;
        R = ROWMAP(Ri); cur = nxt; nxt = nx2;
    }
#undef ROWMAP
}

struct FeatIn { u32x4 w[5]; };
__device__ __forceinline__ void feat_load(const Args& a, int R, int lane, FeatIn& in) {
    const bf16* F = (const bf16*)(a.ws + WS_FEAT) + (size_t)R * DINP; const u32x4 zero4 = (u32x4){0u, 0u, 0u, 0u};
    in.w[0] = *(const u32x4*)(F + C_AQ + 8 * lane);
    in.w[1] = (lane < 32) ? *(const u32x4*)(F + C_AK + 8 * lane) : zero4;
    in.w[2] = (lane < 24) ? *(const u32x4*)(F + C_BQD + 8 * lane) : zero4;
    in.w[3] = (lane < 16) ? *(const u32x4*)(F + C_BKVD + 8 * lane) : zero4;
    in.w[4] = (lane < 4) ? *(const u32x4*)(F + C_BKR + 8 * lane) : zero4;
}
__device__ __forceinline__ void feat_row(const Args& a, int l, int R, int lane, const FeatIn& in) {
    const float* tab = (const float*)(a.ws + WS_TAB); const float* cosA = tab, *sinA = tab + 1024, *cosB = tab + 2048, *sinB = tab + 2560;
    const int j = R % TPB; const bool lat = j < SEQ; const int rowid = j >> 6, colid = j & 63;
    {
        float f[8]; unpack8(in.w[0], f);
        float ss = 0.f;
#pragma unroll
        for (int e = 0; e < 8; ++e) ss += f[e] * f[e];
        ss += __shfl_xor(ss, 1); ss += __shfl_xor(ss, 2); ss += __shfl_xor(ss, 4);
        const float rinv = rsqrtf(ss * (1.0f / 64.0f) + EPS);
        const float* gn = a.in[I_AQN] + l * 64 + 8 * (lane & 7);
#pragma unroll
        for (int e = 0; e < 8; ++e) f[e] = f[e] * rinv * gn[e];
        float pr[8];
#pragma unroll
        for (int e = 0; e < 8; ++e) pr[e] = __shfl_xor(f[e], 4);
        if (lat) {
            const int blk = lane & 3; const int pos = (blk < 2) ? rowid : colid; const float* cp = cosA + pos * 16 + 8 * (blk & 1), *sp = sinA + pos * 16 + 8 * (blk & 1);
            const float sg = ((lane & 7) < 4) ? -1.0f : 1.0f;
#pragma unroll
            for (int e = 0; e < 8; ++e) f[e] = f[e] * cp[e] + sg * pr[e] * sp[e];
        }
#pragma unroll
        for (int e = 0; e < 8; ++e) f[e] *= QSCALE_A;
        *(u32x4*)((bf16*)(a.ws + WS_QA) + (size_t)R * 512 + 8 * lane) = pack8(f);
    }
    {
        float f[8]; const u32x4 w = in.w[1]; unpack8(w, f);
        float ss = 0.f;
#pragma unroll
        for (int e = 0; e < 8; ++e) ss += f[e] * f[e];
        ss += __shfl_xor(ss, 1); ss += __shfl_xor(ss, 2); ss += __shfl_xor(ss, 4);
        const float rinv = rsqrtf(ss * (1.0f / 64.0f) + EPS);
        const float* gn = a.in[I_AKN] + l * 64 + 8 * (lane & 7);
        float g[8];
#pragma unroll
        for (int e = 0; e < 8; ++e) g[e] = f[e] * rinv * gn[e];
        float pr[8];
#pragma unroll
        for (int e = 0; e < 8; ++e) pr[e] = __shfl_xor(g[e], 4);
        if (lat) {
            const int blk = lane & 3; const int pos = (blk < 2) ? rowid : colid; const float* cp = cosA + pos * 16 + 8 * (blk & 1), *sp = sinA + pos * 16 + 8 * (blk & 1);
            const float sg = ((lane & 7) < 4) ? -1.0f : 1.0f;
#pragma unroll
            for (int e = 0; e < 8; ++e) g[e] = g[e] * cp[e] + sg * pr[e] * sp[e];
        }
        if (lane < 16) *(u32x4*)((bf16*)(a.ws + WS_KA) + (size_t)R * 128 + 8 * lane) = pack8(g);
        else if (lane < 32) *(u32x4*)((bf16*)(a.ws + WS_VA) + (size_t)R * 128 + 8 * (lane - 16)) = w;
    }
    {
        float f[8]; unpack8(in.w[2], f);
        float ss = 0.f;
#pragma unroll
        for (int e = 0; e < 8; ++e) ss += f[e] * f[e];
        const float rinv = rsqrtf(wave_sum(ss) * (1.0f / 192.0f) + EPS);
        if (lane < 24) { const float* gn = a.in[I_BQN] + l * 192 + 8 * lane;
#pragma unroll
            for (int e = 0; e < 8; ++e) f[e] = f[e] * rinv * gn[e]; }
        if (lane < 32) *(u32x4*)((bf16*)(a.ws + WS_BQD) + (size_t)R * 256 + 8 * lane) = pack8(f);
    }
    {
        float f[8]; unpack8(in.w[3], f);
        float ss = 0.f;
#pragma unroll
        for (int e = 0; e < 8; ++e) ss += f[e] * f[e];
        const float rinv = rsqrtf(wave_sum(ss) * (1.0f / 128.0f) + EPS);
        if (lane < 16) { const float* gn = a.in[I_BKVN] + l * 128 + 8 * lane;
#pragma unroll
            for (int e = 0; e < 8; ++e) f[e] = f[e] * rinv * gn[e];
            *(u32x4*)((bf16*)(a.ws + WS_BKVD) + (size_t)R * 128 + 8 * lane) = pack8(f); }
    }
    {
        float f[8]; unpack8(in.w[4], f);
        float pr[8];
#pragma unroll
        for (int e = 0; e < 8; ++e) pr[e] = __shfl_xor(f[e], 2);
        if (lat) {
            const int pos = ((lane & 1) == 0) ? rowid : colid; const float* cp = cosB + pos * 8, *sp = sinB + pos * 8;
            const float sg = ((lane & 3) < 2) ? -1.0f : 1.0f;
#pragma unroll
            for (int e = 0; e < 8; ++e) f[e] = f[e] * cp[e] + sg * pr[e] * sp[e];
        }
        if (lane < 4) { const u32x4 o = pack8(f); bf16* kb = (bf16*)(a.ws + WS_KB) + (size_t)R * 384 + 64 + 8 * lane;
#pragma unroll
            for (int h = 0; h < 4; ++h) *(u32x4*)(kb + h * 96) = o; }
    }
}

struct ReadIn { f32x4 of, ob; u32x2 g; };
__device__ __forceinline__ void readout_load(const Args& a, int R, int lane, ReadIn& in) {
    in.of = *(const f32x4*)((const float*)(a.ws + WS_OF) + (size_t)R * 256 + 4 * lane); in.ob = *(const f32x4*)((const float*)(a.ws + WS_OB) + (size_t)R * 256 + 4 * lane);
    in.g = *(const u32x2*)((const bf16*)(a.ws + WS_CFG) + (size_t)R * 256 + 4 * lane);
}
__device__ __forceinline__ void readout_row(const Args& a, int l, int R, int lane, const ReadIn& in) {
    const f32x4 of = in.of, ob = in.ob;
    const f32x4 o = of + ob;
    float ss = o.x * o.x + o.y * o.y + o.z * o.z + o.w * o.w;
    ss += __shfl_xor(ss, 1); ss += __shfl_xor(ss, 2); ss += __shfl_xor(ss, 4); ss += __shfl_xor(ss, 8);
    const float rinv = rsqrtf(ss * (1.0f / 64.0f) + EPS);
    const f32x4 gn = *(const f32x4*)(a.in[I_CON] + l * 64 + 4 * (lane & 15));
    const u32x2 gw = in.g;
    const f32x4 y = o * rinv * gn;
    u32x2 w; w.x = pk2(y.x * siluf_(bf_lo(gw.x)), y.y * siluf_(bf_hi(gw.x))); w.y = pk2(y.z * siluf_(bf_lo(gw.y)), y.w * siluf_(bf_hi(gw.y)));
    *(u32x2*)((bf16*)(a.ws + WS_Y) + (size_t)R * DM + 768 + 4 * lane) = w;
}

typedef float att_f32x2 __attribute__((ext_vector_type(2)));
__device__ __forceinline__ int att_imax(int a, int b) { return a > b ? a : b; }
typedef short att_v4i16 __attribute__((ext_vector_type(4)));
__device__ __forceinline__ s16x4 att_vtr(const LAS unsigned char* p) { return __builtin_bit_cast(s16x4, __builtin_amdgcn_ds_read_tr16_b64_v4i16((LAS att_v4i16*)p)); }
template <int DQ>
__device__ __forceinline__ void attn_unit(LAS unsigned char* lds, const bf16* Q, int qpitch, const bf16* K, int kpitch, const bf16* V, int vpitch, bf16* O, int opitch, int ns, float kmax2 = 0.f) {
    constexpr int KS = DQ * 2 + 16, VS = 144  , NKC = DQ / 8  , NKL = (128 * NKC) / NTHR, KBYTES = 128 * KS, BUF = KBYTES + 128 * VS;
    constexpr float THR = 64.0f;
    int tid_l = threadIdx.x; asm volatile("" : "+v"(tid_l)); const int tid = tid_l, lane = tid & 63, wid = tid >> 6, r32 = lane & 31, hi = lane >> 5;
    bf16x8 qf[DQ / 16];
#pragma unroll
    for (int d0 = 0; d0 < DQ / 16; ++d0) qf[d0] = *(const bf16x8*)(Q + (size_t)(wid * 32 + r32) * qpitch + d0 * 16 + hi * 8);
    f32x16 o0, o1;
#pragma unroll
    for (int r = 0; r < 16; ++r) { o0[r] = 0.f; o1[r] = 0.f; }
    bool mz = true;
    bool safe = false;
    if (DQ == 64 && kmax2 > 0.f) {
        float q2 = 0.f;
#pragma unroll
        for (int d0 = 0; d0 < DQ / 16; ++d0) { const u32x4 w_ = __builtin_bit_cast(u32x4, qf[d0]); float f_[8]; unpack8(w_, f_);
#pragma unroll
            for (int e = 0; e < 8; ++e) q2 += f_[e] * f_[e]; }
        q2 += __shfl_xor(q2, 32);
        safe = __all(q2 * kmax2 <= 3600.0f);
    }
    float mrun = 0.f, lrun = 0.f;
    u32x4 kreg[NKL], vreg[2];
#define ATT_LOAD(t) do { _Pragma("unroll") for (int i_ = 0; i_ < NKL; ++i_) { const int c_ = tid + NTHR * i_; kreg[i_] = *(const u32x4*)(K + (size_t)((t) * 128 + c_ / NKC) * kpitch + (c_ % NKC) * 8); } \
        _Pragma("unroll") for (int j_ = 0; j_ < 2; ++j_) { const int c_ = tid + NTHR * j_; vreg[j_] = *(const u32x4*)(V + (size_t)((t) * 128 + (c_ >> 3)) * vpitch + (c_ & 7) * 8); } } while (0)
#define ATT_PUT(buf) do { LAS unsigned char* kb_ = lds + (buf) * BUF; \
        _Pragma("unroll") for (int i_ = 0; i_ < NKL; ++i_) { const int c_ = tid + NTHR * i_; *(LAS u32x4*)(kb_ + (c_ / NKC) * KS + (c_ % NKC) * 16) = kreg[i_]; } \
        _Pragma("unroll") for (int j_ = 0; j_ < 2; ++j_) { const int c_ = tid + NTHR * j_; *(LAS u32x4*)(kb_ + KBYTES + (c_ >> 3) * VS + (c_ & 7) * 16) = vreg[j_]; } } while (0)
    ATT_LOAD(0);
    ATT_PUT(0);
    if (ns > 1) ATT_LOAD(1);
    __syncthreads();
    for (int t = 0; t < ns; ++t) {
        if (t + 1 < ns) { ATT_PUT((t + 1) & 1); if (t + 2 < ns) ATT_LOAD(t + 2); }
        const LAS unsigned char* Ks = lds + (t & 1) * BUF; const LAS unsigned char* Vt = Ks + KBYTES;
        constexpr int ND = DQ / 16;
#define ATT_KRD(SUB, KF) do { _Pragma("unroll") for (int d0 = 0; d0 < ND; ++d0) { KF[2 * d0] = *(const LAS bf16x8*)(Ks + (64 * (SUB) + r32) * KS + d0 * 32 + hi * 16); KF[2 * d0 + 1] = *(const LAS bf16x8*)(Ks + (64 * (SUB) + 32 + r32) * KS + d0 * 32 + hi * 16); } } while (0)
#define ATT_VRD(SUB, VF) do { const LAS unsigned char* vl_ = Vt + ((((lane & 15) >> 2) + 4 * hi) * VS + (16 * ((lane >> 4) & 1) + 4 * (lane & 3)) * 2); \
            _Pragma("unroll") for (int ks = 0; ks < 4; ++ks) { const LAS unsigned char* vr_ = vl_ + (64 * (SUB) + 16 * ks) * VS; \
            VF[4 * ks + 0] = att_vtr(vr_); VF[4 * ks + 1] = att_vtr(vr_ + 8 * VS); VF[4 * ks + 2] = att_vtr(vr_ + 64); VF[4 * ks + 3] = att_vtr(vr_ + 8 * VS + 64); } } while (0)
#define ATT_QK(KF, S0, S1) do { _Pragma("unroll") for (int d0 = 0; d0 < ND; ++d0) { \
            if (d0 == 0) { if (mz) { const f32x16 z_ = {0.f, 0.f, 0.f, 0.f, 0.f, 0.f, 0.f, 0.f, 0.f, 0.f, 0.f, 0.f, 0.f, 0.f, 0.f, 0.f}; \
                    S0 = __builtin_amdgcn_mfma_f32_32x32x16_bf16(KF[0], qf[0], z_, 0, 0, 0); S1 = __builtin_amdgcn_mfma_f32_32x32x16_bf16(KF[1], qf[0], z_, 0, 0, 0); } \
                else { f32x16 nm_; _Pragma("unroll") for (int r = 0; r < 16; ++r) nm_[r] = -mrun; \
                    S0 = __builtin_amdgcn_mfma_f32_32x32x16_bf16(KF[0], qf[0], nm_, 0, 0, 0); S1 = __builtin_amdgcn_mfma_f32_32x32x16_bf16(KF[1], qf[0], nm_, 0, 0, 0); } } \
            else { S0 = __builtin_amdgcn_mfma_f32_32x32x16_bf16(KF[2 * d0], qf[d0], S0, 0, 0, 0); S1 = __builtin_amdgcn_mfma_f32_32x32x16_bf16(KF[2 * d0 + 1], qf[d0], S1, 0, 0, 0); } } } while (0)
#define ATT_MAX(S0, S1, RM) do { float a_ = fmaxf(fmaxf(S0[0], S0[1]), S1[0]), b_ = fmaxf(fmaxf(S0[2], S0[3]), S1[1]); a_ = fmaxf(fmaxf(a_, S1[2]), S1[3]); \
            _Pragma("unroll") for (int r = 4; r < 16; r += 4) { a_ = fmaxf(fmaxf(a_, S0[r]), S0[r + 1]); b_ = fmaxf(fmaxf(b_, S0[r + 2]), S0[r + 3]); a_ = fmaxf(fmaxf(a_, S1[r]), S1[r + 1]); b_ = fmaxf(fmaxf(b_, S1[r + 2]), S1[r + 3]); } \
            RM = fmaxf(a_, b_); auto rr_ = __builtin_amdgcn_permlane32_swap(__float_as_uint(RM), __float_as_uint(RM), false, false); RM = fmaxf(__uint_as_float(rr_[0]), __uint_as_float(rr_[1])); } while (0)
#define ATT_IMAX3(a, b, c) att_imax(att_imax((a), (b)), (c))
#define ATT_SCREEN(S0, S1, HOT) do { int a_ = ATT_IMAX3(__float_as_int(S0[0]), __float_as_int(S0[1]), __float_as_int(S1[0])), b_ = ATT_IMAX3(__float_as_int(S0[2]), __float_as_int(S0[3]), __float_as_int(S1[1])); \
            a_ = ATT_IMAX3(a_, __float_as_int(S1[2]), __float_as_int(S1[3])); \
            _Pragma("unroll") for (int r = 4; r < 16; r += 4) { a_ = ATT_IMAX3(a_, __float_as_int(S0[r]), __float_as_int(S0[r + 1])); b_ = ATT_IMAX3(b_, __float_as_int(S0[r + 2]), __float_as_int(S0[r + 3])); \
                a_ = ATT_IMAX3(a_, __float_as_int(S1[r]), __float_as_int(S1[r + 1])); b_ = ATT_IMAX3(b_, __float_as_int(S1[r + 2]), __float_as_int(S1[r + 3])); } \
            HOT = __any(att_imax(a_, b_) > 0x42800000); } while (0)
#define ATT_RESC(FIRST, S0, S1, RM) do { if ((FIRST) ? __any(fabsf(RM) > THR) : __any(RM > THR)) { const float dl_ = (FIRST) ? RM : fmaxf(RM, 0.f); mrun += dl_; mz = false; \
            _Pragma("unroll") for (int r = 0; r < 16; ++r) { S0[r] -= dl_; S1[r] -= dl_; } \
            if (!(FIRST)) { const float f_ = __builtin_amdgcn_exp2f(-dl_); lrun *= f_; _Pragma("unroll") for (int r = 0; r < 16; ++r) { o0[r] *= f_; o1[r] *= f_; } } } } while (0)
#define ATT_EXP(S0, S1, PB) do { _Pragma("unroll") for (int r = 0; r < 16; ++r) { S0[r] = __builtin_amdgcn_exp2f(S0[r]); S1[r] = __builtin_amdgcn_exp2f(S1[r]); } \
            { att_f32x2 pa_ = (att_f32x2){S0[0], S0[1]} + (att_f32x2){S1[0], S1[1]}, pb_ = (att_f32x2){S0[2], S0[3]} + (att_f32x2){S1[2], S1[3]}; \
              _Pragma("unroll") for (int r = 4; r < 16; r += 4) { pa_ += (att_f32x2){S0[r], S0[r + 1]}; pb_ += (att_f32x2){S0[r + 2], S0[r + 3]}; pa_ += (att_f32x2){S1[r], S1[r + 1]}; pb_ += (att_f32x2){S1[r + 2], S1[r + 3]}; } \
              pa_ += pb_; lrun += pa_.x + pa_.y; } \
            _Pragma("unroll") for (int ks = 0; ks < 4; ++ks) { u32x4 w_; const int b_ = 8 * (ks & 1); \
                if (ks < 2) { w_.x = pk2(S0[b_ + 0], S0[b_ + 1]); w_.y = pk2(S0[b_ + 2], S0[b_ + 3]); w_.z = pk2(S0[b_ + 4], S0[b_ + 5]); w_.w = pk2(S0[b_ + 6], S0[b_ + 7]); } \
                else { w_.x = pk2(S1[b_ + 0], S1[b_ + 1]); w_.y = pk2(S1[b_ + 2], S1[b_ + 3]); w_.z = pk2(S1[b_ + 4], S1[b_ + 5]); w_.w = pk2(S1[b_ + 6], S1[b_ + 7]); } \
                PB[ks] = __builtin_bit_cast(bf16x8, w_); } } while (0)
#define ATT_PV(VF, PB) do { _Pragma("unroll") for (int ks = 0; ks < 4; ++ks) { \
            const s16x4 a0_ = VF[4 * ks + 0], a1_ = VF[4 * ks + 1], c0_ = VF[4 * ks + 2], c1_ = VF[4 * ks + 3]; \
            const bf16x8 va_ = (bf16x8){a0_[0], a0_[1], a0_[2], a0_[3], a1_[0], a1_[1], a1_[2], a1_[3]}, vc_ = (bf16x8){c0_[0], c0_[1], c0_[2], c0_[3], c1_[0], c1_[1], c1_[2], c1_[3]}; \
            o0 = __builtin_amdgcn_mfma_f32_32x32x16_bf16(va_, PB[ks], o0, 0, 0, 0); o1 = __builtin_amdgcn_mfma_f32_32x32x16_bf16(vc_, PB[ks], o1, 0, 0, 0); } } while (0)
#define ATT_SB() __builtin_amdgcn_sched_barrier(0)
        f32x16 s0, s1; bf16x8 kf[2 * ND], pb[4]; s16x4 vf[16]; float rm;
        ATT_KRD(0, kf); ATT_SB();
        ATT_QK(kf, s0, s1); ATT_SB();
        ATT_VRD(0, vf); ATT_SB();
        if (DQ != 64 || t == 0) { ATT_MAX(s0, s1, rm); ATT_RESC(t == 0, s0, s1, rm); }
        else if (!safe) { bool hot_; ATT_SCREEN(s0, s1, hot_); if (hot_) { ATT_MAX(s0, s1, rm); ATT_RESC(false, s0, s1, rm); } }
        ATT_EXP(s0, s1, pb);
        ATT_PV(vf, pb); ATT_SB();
        ATT_KRD(1, kf); ATT_SB();
        ATT_QK(kf, s0, s1); ATT_SB();
        ATT_VRD(1, vf); ATT_SB();
        if (DQ != 64) { ATT_MAX(s0, s1, rm); ATT_RESC(false, s0, s1, rm); }
        else if (!safe) { bool hot_; ATT_SCREEN(s0, s1, hot_); if (hot_) { ATT_MAX(s0, s1, rm); ATT_RESC(false, s0, s1, rm); } }
        ATT_EXP(s0, s1, pb);
        ATT_PV(vf, pb);
#undef ATT_KRD
#undef ATT_VRD
#undef ATT_QK
#undef ATT_MAX
#undef ATT_RESC
#undef ATT_SCREEN
#undef ATT_IMAX3
#undef ATT_EXP
#undef ATT_PV
#undef ATT_SB
        __syncthreads();
    }
#undef ATT_LOAD
#undef ATT_PUT
    lrun += __shfl_xor(lrun, 32);
    const float linv = 1.0f / lrun;
    bf16* orow = O + (size_t)(wid * 32 + r32) * opitch;
#pragma unroll
    for (int r4 = 0; r4 < 4; ++r4) {
        u32x2 w0, w1;
        w0.x = pk2(o0[4 * r4 + 0] * linv, o0[4 * r4 + 1] * linv); w0.y = pk2(o0[4 * r4 + 2] * linv, o0[4 * r4 + 3] * linv);
        w1.x = pk2(o1[4 * r4 + 0] * linv, o1[4 * r4 + 1] * linv); w1.y = pk2(o1[4 * r4 + 2] * linv, o1[4 * r4 + 3] * linv);
        *(u32x2*)(orow + 8 * r4 + 4 * hi) = w0; *(u32x2*)(orow + 32 + 8 * r4 + 4 * hi) = w1;
    }
}

typedef float f32x2 __attribute__((ext_vector_type(2)));
__device__ __forceinline__ float dpp_xor1(float v) { return __int_as_float(__builtin_amdgcn_update_dpp(0, __float_as_int(v), 0xB1, 0xF, 0xF, true)); }
__device__ __forceinline__ float dpp_xor2(float v) { return __int_as_float(__builtin_amdgcn_update_dpp(0, __float_as_int(v), 0x4E, 0xF, 0xF, true)); }
__device__ __forceinline__ float dpp_hmir(float v) { return __int_as_float(__builtin_amdgcn_update_dpp(0, __float_as_int(v), 0x141, 0xF, 0xF, true)); }
__device__ __forceinline__ void scan_unit(LAS unsigned char* lds, const Args& a, int l, int b, int h) {
    int tid_l = threadIdx.x; asm volatile("" : "+v"(tid_l)); const int tid = tid_l, lane = tid & 63, wid = tid >> 6, dvl = lane >> 3, dkg = lane & 7;
    const int cw = __builtin_amdgcn_readfirstlane(wid); const int dir = (cw >> 1) & 1, wq = cw & 1;
    LAS float* myq = (LAS float*)(lds + dir * 65536); LAS float* myk = myq + 4096; LAS float* myv = myk + 4096; LAS float* myo = myv + 4096;
    const bf16* CQ = (const bf16*)(a.ws + WS_CFQ); const bf16* CKF = (const bf16*)(a.ws + WS_CKF); const bf16* CKB = (const bf16*)(a.ws + WS_CKB); const bf16* CV = (const bf16*)(a.ws + WS_CFV);
    float* OF = (float*)(a.ws + WS_OF); float* OB = (float*)(a.ws + WS_OB);
    const int rb = b * TPB, col = h * 64;
    f32x2 S[16];
#pragma unroll
    for (int e = 0; e < 16; ++e) S[e] = (f32x2){0.f, 0.f};
    const int li = tid >> 3, lc = tid & 7;
    u32x4 rq0, rk0, rv0, rq1, rk1, rv1;
#define SCAN_FB(c) (((c) < 4) ? (SEQ + 64 * (c)) : 64 * ((c) - 4))
#define SCAN_BB(c) (((c) < 4) ? (TPB - 1 - 64 * (c)) : (SEQ - 1 - 64 * ((c) - 4)))
#define SCAN_LOAD(c) do { const size_t rf_ = (size_t)(rb + SCAN_FB(c) + li) * 256 + col + 8 * lc, rb_ = (size_t)(rb + SCAN_BB(c) - li) * 256 + col + 8 * lc; \
        rq0 = *(const u32x4*)(CQ + rf_); rk0 = *(const u32x4*)(CKF + rf_); rv0 = *(const u32x4*)(CV + rf_); rq1 = *(const u32x4*)(CQ + rb_); rk1 = *(const u32x4*)(CKB + rb_); rv1 = *(const u32x4*)(CV + rb_); } while (0)
#define SCAN_PUT(base, w) do { float f_[8]; unpack8(w, f_); *(LAS f32x4*)((base) + li * 64 + 8 * lc) = (f32x4){f_[0], f_[1], f_[2], f_[3]}; *(LAS f32x4*)((base) + li * 64 + 8 * lc + 4) = (f32x4){f_[4], f_[5], f_[6], f_[7]}; } while (0)
#define SCAN_FLUSH(c) do { LAS float* o0_ = (LAS float*)(lds + 49152) + li * 64 + 8 * lc; LAS float* o1_ = (LAS float*)(lds + 65536 + 49152) + li * 64 + 8 * lc; \
        float* pf_ = OF + (size_t)(rb + SCAN_FB(c) + li) * 256 + col + 8 * lc; float* pb_ = OB + (size_t)(rb + SCAN_BB(c) - li) * 256 + col + 8 * lc; \
        *(f32x4*)pf_ = *(const LAS f32x4*)o0_; *(f32x4*)(pf_ + 4) = *(const LAS f32x4*)(o0_ + 4); *(f32x4*)pb_ = *(const LAS f32x4*)o1_; *(f32x4*)(pb_ + 4) = *(const LAS f32x4*)(o1_ + 4); } while (0)
    SCAN_LOAD(0);
    for (int c = 0; c < 68; ++c) {
        __syncthreads();
        if (c > 0) SCAN_FLUSH(c - 1);
        { LAS float* q0_ = (LAS float*)lds; LAS float* q1_ = (LAS float*)(lds + 65536);
          SCAN_PUT(q0_, rq0); SCAN_PUT(q0_ + 4096, rk0); SCAN_PUT(q0_ + 8192, rv0); SCAN_PUT(q1_, rq1); SCAN_PUT(q1_ + 4096, rk1); SCAN_PUT(q1_ + 8192, rv1); }
        __syncthreads();
        if (c + 1 < 68) SCAN_LOAD(c + 1);
        if (cw < 4) {
        f32x4 q0 = *(const LAS f32x4*)(myq + 8 * dkg), q1 = *(const LAS f32x4*)(myq + 8 * dkg + 4);
        f32x4 k0 = *(const LAS f32x4*)(myk + 8 * dkg), k1 = *(const LAS f32x4*)(myk + 8 * dkg + 4);
        f32x4 vv = *(const LAS f32x4*)(myv + 32 * wq + 4 * dvl);
        const bool lb0 = (lane & 1) != 0, lb1 = (lane & 2) != 0, lb2 = (lane & 4) != 0;
        for (int i0 = 0; i0 < 64; i0 += 4) {
            float val[4][4];
#pragma unroll
            for (int j = 0; j < 4; ++j) {
                const int in_ = (i0 + j + 1) & 63;
                const f32x4 nq0 = *(const LAS f32x4*)(myq + in_ * 64 + 8 * dkg), nq1 = *(const LAS f32x4*)(myq + in_ * 64 + 8 * dkg + 4);
                const f32x4 nk0 = *(const LAS f32x4*)(myk + in_ * 64 + 8 * dkg), nk1 = *(const LAS f32x4*)(myk + in_ * 64 + 8 * dkg + 4);
                const f32x4 nvv = *(const LAS f32x4*)(myv + in_ * 64 + 32 * wq + 4 * dvl);
                const f32x2 va = (f32x2){vv.x, vv.y}, vb = (f32x2){vv.z, vv.w};
                f32x2 a0 = (f32x2){0.f, 0.f}, a1 = a0, b0 = a0, b1 = a0;
#pragma unroll
                for (int e = 0; e < 4; ++e) {
                    const f32x2 kk0 = (f32x2){k0[e], k0[e]}, qq0 = (f32x2){q0[e], q0[e]}, kk1 = (f32x2){k1[e], k1[e]}, qq1 = (f32x2){q1[e], q1[e]};
                    S[e] = kk0 * (va - S[e]) + S[e];             a0 = S[e] * qq0 + a0;
                    S[8 + e] = kk0 * (vb - S[8 + e]) + S[8 + e];   b0 = S[8 + e] * qq0 + b0;
                    S[4 + e] = kk1 * (va - S[4 + e]) + S[4 + e];   a1 = S[4 + e] * qq1 + a1;
                    S[12 + e] = kk1 * (vb - S[12 + e]) + S[12 + e]; b1 = S[12 + e] * qq1 + b1;
                }
                const f32x2 acca = a0 + a1, accb = b0 + b1;
                val[j][0] = acca.x; val[j][1] = acca.y; val[j][2] = accb.x; val[j][3] = accb.y;
                q0 = nq0; q1 = nq1; k0 = nk0; k1 = nk1; vv = nvv;
            }
            float r1[8];
#pragma unroll
            for (int jl = 0; jl < 2; ++jl)
#pragma unroll
                for (int c = 0; c < 4; ++c) { const float lo = val[jl][c], hi = val[2 + jl][c]; const float keep = lb0 ? hi : lo, send = lb0 ? lo : hi; r1[jl * 4 + c] = keep + dpp_xor1(send); }
            float r2[4];
#pragma unroll
            for (int c = 0; c < 4; ++c) { const float lo = r1[c], hi = r1[4 + c]; const float keep = lb1 ? hi : lo, send = lb1 ? lo : hi; r2[c] = keep + dpp_xor2(send); }
            f32x2 r3;
            { const float k0_ = lb2 ? r2[2] : r2[0], s0_ = lb2 ? r2[0] : r2[2], k1_ = lb2 ? r2[3] : r2[1], s1_ = lb2 ? r2[1] : r2[3];
              r3.x = k0_ + __shfl_xor(s0_, 4); r3.y = k1_ + __shfl_xor(s1_, 4); }
            *(LAS f32x2*)(myo + (i0 + 2 * (lane & 1) + ((lane >> 1) & 1)) * 64 + 32 * wq + 4 * dvl + 2 * ((lane >> 2) & 1)) = r3;
        }
        }
    }
    __syncthreads();
    SCAN_FLUSH(67);
    __threadfence();
    __syncthreads();
    {
        const int rl = tid >> 4, c4 = (tid & 15) * 4;
        const f32x4 gn = *(const f32x4*)(a.in[I_CON] + l * 64 + c4);
        const bf16* CG = (const bf16*)(a.ws + WS_CFG); bf16* Y = (bf16*)(a.ws + WS_Y);
        for (int r0 = 0; r0 < TPB; r0 += 128) {
            f32x4 of[4], ob4[4]; u32x2 gw4[4];
#pragma unroll
            for (int p = 0; p < 4; ++p) { const size_t ro = (size_t)(rb + r0 + 32 * p + rl) * 256 + col + c4; of[p] = *(const f32x4*)(OF + ro); ob4[p] = *(const f32x4*)(OB + ro); gw4[p] = *(const u32x2*)(CG + ro); }
#pragma unroll
            for (int p = 0; p < 4; ++p) {
                const f32x4 o = of[p] + ob4[p];
                float ss = o.x * o.x + o.y * o.y + o.z * o.z + o.w * o.w;
                ss += __shfl_xor(ss, 1); ss += __shfl_xor(ss, 2); ss += __shfl_xor(ss, 4); ss += __shfl_xor(ss, 8);
                const float rinv = rsqrtf(ss * (1.0f / 64.0f) + EPS);
                const f32x4 y = o * rinv * gn; const u32x2 g2 = gw4[p];
                u32x2 w; w.x = pk2(y.x * siluf_(bf_lo(g2.x)), y.y * siluf_(bf_hi(g2.x))); w.y = pk2(y.z * siluf_(bf_lo(g2.y)), y.w * siluf_(bf_hi(g2.y)));
                *(u32x2*)(Y + (size_t)(rb + r0 + 32 * p + rl) * DM + 768 + col + c4) = w;
            }
        }
    }
    __syncthreads();
#undef SCAN_FB
#undef SCAN_BB
#undef SCAN_LOAD
#undef SCAN_PUT
#undef SCAN_FLUSH
}

template <class Epi>
__device__ __forceinline__ void run_gemm(LAS unsigned char* lds, const pg8::Gemm& g, const Epi& E, int G, bool lat_only) {
    if (lat_only) { pg8::LatOrder S; S.init(g.N, G, (int)blockIdx.x); pg8::gemm_phase<Epi, pg8::LatOrder, true, true>(lds, g, S, E); }
    else { pg8::StaticOrder S; S.init(g.M, g.N, G, (int)blockIdx.x); pg8::gemm_phase<Epi, pg8::StaticOrder, true, true>(lds, g, S, E); }
}
struct EpiFeat2 {
    static constexpr bool PERM = true, AFTER_DRAIN = false;
    unsigned char* ws; const float* aqn; const float* akn; const float* clb; int layer;
    __device__ __forceinline__ void operator()(const f32x4 (&acc)[2][2][4][2], const pg8::Unit& u, int wr, int wc, int fr, int fq) const {
        const int row0 = u.pm * 256 + wr * 64 + fr, pn = u.pn;
        const float* tab = (const float*)(ws + WS_TAB);
        if (pn <= 2) {
            const bool is_v = (pn == 2 && wc >= 2);
            const float* gain = (pn < 2) ? aqn : akn;
            f32x4 g[2][2];
#pragma unroll
            for (int bj = 0; bj < 2; ++bj)
#pragma unroll
                for (int n = 0; n < 2; ++n) g[bj][n] = *(const f32x4*)(gain + 32 * bj + 8 * fq + 4 * n);
            bf16* dst; int ld;
            if (pn < 2) { dst = (bf16*)(ws + WS_QA) + (4 * pn + wc) * 64; ld = 512; } else if (wc < 2) { dst = (bf16*)(ws + WS_KA) + wc * 64; ld = 128; } else { dst = (bf16*)(ws + WS_VA) + (wc - 2) * 64; ld = 128; }
            const float osc = (pn < 2) ? QSCALE_A : 1.0f;
#pragma unroll
            for (int ai = 0; ai < 2; ++ai)
#pragma unroll
                for (int mm = 0; mm < 4; ++mm) {
                    const int row = row0 + ai * 128 + mm * 16; const int j = row % TPB;
                    f32x4 x[2][2];
#pragma unroll
                    for (int bj = 0; bj < 2; ++bj)
#pragma unroll
                        for (int n = 0; n < 2; ++n) x[bj][n] = acc[ai][bj][mm][n];
                    if (!is_v) {
                        float ss = 0.f;
#pragma unroll
                        for (int bj = 0; bj < 2; ++bj)
#pragma unroll
                            for (int n = 0; n < 2; ++n) ss += x[bj][n].x * x[bj][n].x + x[bj][n].y * x[bj][n].y + x[bj][n].z * x[bj][n].z + x[bj][n].w * x[bj][n].w;
                        ss += __shfl_xor(ss, 16); ss += __shfl_xor(ss, 32);
                        const float rinv = rsqrtf(ss * (1.0f / 64.0f) + EPS);
#pragma unroll
                        for (int bj = 0; bj < 2; ++bj)
#pragma unroll
                            for (int n = 0; n < 2; ++n) x[bj][n] = x[bj][n] * rinv * g[bj][n];
                        if (j < SEQ) {
                            const int pos = (fq < 2) ? (j >> 6) : (j & 63);
#pragma unroll
                            for (int n = 0; n < 2; ++n) { const f32x4 cs = *(const f32x4*)(tab + pos * 16 + 8 * (fq & 1) + 4 * n), sn = *(const f32x4*)(tab + 1024 + pos * 16 + 8 * (fq & 1) + 4 * n);
                                const f32x4 a_ = x[0][n] * cs - x[1][n] * sn, b_ = x[1][n] * cs + x[0][n] * sn; x[0][n] = a_; x[1][n] = b_; }
                        }
#pragma unroll
                        for (int bj = 0; bj < 2; ++bj)
#pragma unroll
                            for (int n = 0; n < 2; ++n) x[bj][n] = x[bj][n] * osc;
                    }
#pragma unroll
                    for (int bj = 0; bj < 2; ++bj) { u32x4 w; w.x = pk2(x[bj][0].x, x[bj][0].y); w.y = pk2(x[bj][0].z, x[bj][0].w); w.z = pk2(x[bj][1].x, x[bj][1].y); w.w = pk2(x[bj][1].z, x[bj][1].w);
                        *(u32x4*)(dst + (size_t)row * ld + 32 * bj + 8 * fq) = w; }
                    asm volatile("" ::: "memory");
                }
            return;
        }
#pragma unroll
        for (int bj = 0; bj < 2; ++bj) {
            const int c0 = pn * 256 + bj * 128 + wc * 32 + 8 * fq;
            if (c0 >= 2400) continue;
            if (c0 < 1088) {
                const bool isq = c0 < 960; const int dd = isq ? (c0 - 768) : (c0 - 960);
                bf16* dst = isq ? ((bf16*)(ws + WS_BQD) + dd) : ((bf16*)(ws + WS_BKVD) + dd); const int ld = isq ? 256 : 128;
                float* ssq = isq ? (float*)(ws + WS_SSQ_Q) : (float*)(ws + WS_SSQ_KV);
                const int grp = dd >> 5;
#pragma unroll
                for (int ai = 0; ai < 2; ++ai)
#pragma unroll
                    for (int mm = 0; mm < 4; ++mm) {
                        const int row = row0 + ai * 128 + mm * 16;
                        const f32x4 v0 = acc[ai][bj][mm][0], v1 = acc[ai][bj][mm][1];
                        float ss = v0.x * v0.x + v0.y * v0.y + v0.z * v0.z + v0.w * v0.w + v1.x * v1.x + v1.y * v1.y + v1.z * v1.z + v1.w * v1.w;
                        ss += __shfl_xor(ss, 16); ss += __shfl_xor(ss, 32);
                        if (fq == 0) ssq[(size_t)row * (isq ? 8 : 4) + grp] = ss;
                        u32x4 w; w.x = pk2(v0.x, v0.y); w.y = pk2(v0.z, v0.w); w.z = pk2(v1.x, v1.y); w.w = pk2(v1.z, v1.w);
                        *(u32x4*)(dst + (size_t)row * ld) = w;
                        if (!isq && grp < 2) *(u32x4*)((bf16*)(ws + WS_BQD) + (size_t)row * 256 + 192 + dd) = (u32x4){0u, 0u, 0u, 0u};
                    }
                continue;
            }
            if (c0 < 1120) {
                const float* cosB = tab + 2048; const float* sinB = tab + 2560;
#pragma unroll
                for (int ai = 0; ai < 2; ++ai)
#pragma unroll
                    for (int mm = 0; mm < 4; ++mm) {
                        const int row = row0 + ai * 128 + mm * 16; const int j = row % TPB;
                        f32x4 v0 = acc[ai][bj][mm][0], v1 = acc[ai][bj][mm][1];
                        f32x4 p0, p1;
#pragma unroll
                        for (int e = 0; e < 4; ++e) { p0[e] = __shfl_xor(v0[e], 32); p1[e] = __shfl_xor(v1[e], 32); }
                        if (j < SEQ) {
                            const int pos = ((fq & 1) == 0) ? (j >> 6) : (j & 63);
                            const f32x4 c0v = *(const f32x4*)(cosB + pos * 8), c1v = *(const f32x4*)(cosB + pos * 8 + 4), s0v = *(const f32x4*)(sinB + pos * 8), s1v = *(const f32x4*)(sinB + pos * 8 + 4);
                            const float sg = (fq < 2) ? -1.0f : 1.0f;
                            v0 = v0 * c0v + p0 * s0v * sg; v1 = v1 * c1v + p1 * s1v * sg;
                        }
                        u32x4 w; w.x = pk2(v0.x, v0.y); w.y = pk2(v0.z, v0.w); w.z = pk2(v1.x, v1.y); w.w = pk2(v1.z, v1.w);
                        bf16* kb = (bf16*)(ws + WS_KB) + (size_t)row * 384 + 64 + 8 * fq;
#pragma unroll
                        for (int h = 0; h < 4; ++h) *(u32x4*)(kb + h * 96) = w;
                    }
                continue;
            }
            const int seg = (c0 - 1120) >> 8; const int ch = (c0 - 1120) & 255;
            float om[8];
#pragma unroll
            for (int e = 0; e < 8; ++e) om[e] = 1.0f;
            if (layer > 0 && (seg == 1 || seg == 2)) {
                const float* c1 = clb + 512 + (seg - 1) * 256 + ch; const float* c0p = clb + (seg - 1) * 256 + ch;
#pragma unroll
                for (int e = 0; e < 8; ++e) om[e] = 1.0f - 1.0f / (1.0f + __expf(-(c1[e] - c0p[e])));
            }
            bf16* dst = (bf16*)(ws + (seg == 0 ? WS_CFQ : seg == 1 ? WS_CKF : seg == 2 ? WS_CKB : seg == 3 ? WS_CFV : WS_CFG)) + ch;
#pragma unroll
            for (int ai = 0; ai < 2; ++ai)
#pragma unroll
                for (int mm = 0; mm < 4; ++mm) {
                    const int row = row0 + ai * 128 + mm * 16;
                    f32x4 v0 = acc[ai][bj][mm][0], v1 = acc[ai][bj][mm][1];
                    if (seg == 0) {
#pragma unroll
                        for (int e = 0; e < 4; ++e) { v0[e] = v0[e] / (1.0f + __expf(-v0[e])); v1[e] = v1[e] / (1.0f + __expf(-v1[e])); }
                    } else if (seg == 1 || seg == 2) {
#pragma unroll
                        for (int e = 0; e < 4; ++e) { v0[e] = om[e] / (1.0f + __expf(v0[e])); v1[e] = om[4 + e] / (1.0f + __expf(v1[e])); }
                    }
                    u32x4 w; w.x = pk2(v0.x, v0.y); w.y = pk2(v0.z, v0.w); w.z = pk2(v1.x, v1.y); w.w = pk2(v1.z, v1.w);
                    *(u32x4*)(dst + (size_t)row * 256) = w;
                }
        }
    }
};
struct EpiQup2 {
    static constexpr bool PERM = false, AFTER_DRAIN = false;
    unsigned char* ws;
    __device__ __forceinline__ void operator()(const f32x4 (&acc)[2][2][4][2], const pg8::Unit& u, int wr, int wc, int fr, int fq) const {
        const int row0 = u.pm * 256 + wr * 64 + fr; const float* tab = (const float*)(ws + WS_TAB); const float* cosB = tab + 2048; const float* sinB = tab + 2560;
        const float* ssq = (const float*)(ws + WS_SSQ_Q); bf16* O = (bf16*)(ws + WS_QB);
#pragma unroll
        for (int bj = 0; bj < 2; ++bj) {
            const int cg_ = u.pn * 256 + bj * 128 + wc * 32;
            if (cg_ >= 384) continue;
            const bool pe = ((cg_ >> 5) % 3) == 2;
#pragma unroll
            for (int ai = 0; ai < 2; ++ai)
#pragma unroll
                for (int mm = 0; mm < 4; ++mm) {
                    const int row = row0 + ai * 128 + mm * 16; const int j = row % TPB;
                    const f32x4 sa = *(const f32x4*)(ssq + (size_t)row * 8), sb = *(const f32x4*)(ssq + (size_t)row * 8 + 4);
                    const float sc = QSCALE_B * rsqrtf((sa.x + sa.y + sa.z + sa.w + sb.x + sb.y) * (1.0f / 192.0f) + EPS);
                    f32x4 v0 = acc[ai][bj][mm][0], v1 = acc[ai][bj][mm][1];
                    if (pe && j < SEQ) {
                        const int pos = (fq < 2) ? (j >> 6) : (j & 63);
                        const f32x4 cs = *(const f32x4*)(cosB + pos * 8 + 4 * (fq & 1)), sn = *(const f32x4*)(sinB + pos * 8 + 4 * (fq & 1));
                        const f32x4 a_ = v0 * cs - v1 * sn, b_ = v1 * cs + v0 * sn; v0 = a_; v1 = b_;
                    }
                    v0 = v0 * sc; v1 = v1 * sc;
                    bf16* p = O + (size_t)row * 384 + cg_ + 4 * fq;
                    u32x2 w0, w1; w0.x = pk2(v0.x, v0.y); w0.y = pk2(v0.z, v0.w); w1.x = pk2(v1.x, v1.y); w1.y = pk2(v1.z, v1.w);
                    *(u32x2*)p = w0; *(u32x2*)(p + 16) = w1;
                    asm volatile("" ::: "memory");
                }
        }
    }
};
struct EpiKVup2 {
    static constexpr bool PERM = true, AFTER_DRAIN = false;
    unsigned char* ws;
    __device__ __forceinline__ void operator()(const f32x4 (&acc)[2][2][4][2], const pg8::Unit& u, int wr, int wc, int fr, int fq) const {
        const int row0 = u.pm * 256 + wr * 64 + fr; const float* ssq = (const float*)(ws + WS_SSQ_KV);
        bf16* KB = (bf16*)(ws + WS_KB); bf16* VB = (bf16*)(ws + WS_VB);
#pragma unroll
        for (int bj = 0; bj < 2; ++bj) {
            const int head = u.pn * 2 + bj; const int within = wc * 32 + 8 * fq;
#pragma unroll
            for (int ai = 0; ai < 2; ++ai)
#pragma unroll
                for (int mm = 0; mm < 4; ++mm) {
                    const int row = row0 + ai * 128 + mm * 16;
                    const f32x4 sa = *(const f32x4*)(ssq + (size_t)row * 4);
                    const float sc = rsqrtf((sa.x + sa.y + sa.z + sa.w) * (1.0f / 128.0f) + EPS);
                    const f32x4 v0 = acc[ai][bj][mm][0] * sc, v1 = acc[ai][bj][mm][1] * sc;
                    u32x4 w; w.x = pk2(v0.x, v0.y); w.y = pk2(v0.z, v0.w); w.z = pk2(v1.x, v1.y); w.w = pk2(v1.z, v1.w);
                    bf16* p = (within < 64) ? (KB + (size_t)row * 384 + head * 96 + within) : (VB + (size_t)row * 256 + head * 64 + (within - 64));
                    *(u32x4*)p = w;
                    asm volatile("" ::: "memory");
                }
        }
    }
};
__device__ __forceinline__ void mixer_phase(const Args& a, LAS unsigned char* lds, int l, unsigned char* wb, int G, int cidx = 0, int ustart = 0) {
    volatile LAS unsigned* misc = (volatile LAS unsigned*)(lds + LDS_MISC);
    unsigned* ctr = (unsigned*)(a.ws + WS_CTL) + 8 * l + cidx;
    const int n_units = 64 + 1024 + 2048 + ((l + 1 < DEPTH) ? 192 : 0);
    const bf16* QA = (const bf16*)(a.ws + WS_QA); const bf16* KA = (const bf16*)(a.ws + WS_KA); const bf16* VA = (const bf16*)(a.ws + WS_VA);
    const bf16* QB = (const bf16*)(a.ws + WS_QB); const bf16* KB = (const bf16*)(a.ws + WS_KB); const bf16* VB = (const bf16*)(a.ws + WS_VB);
    bf16* Y = (bf16*)(a.ws + WS_Y);
    unsigned* gdone = (unsigned*)(a.ws + WS_CTL) + 8 * l + 2;
    { int kq = 256; asm volatile("" : "+s"(kq)); pg8::Gemm g{(const bf16*)(a.ws + WS_BQD), (const bf16*)(wb + WO_QU), MROWS, 512, kq}; pg8::StaticOrder S; S.init(MROWS, 512, G, (int)blockIdx.x);
      EpiQup2 E{a.ws};
      pg8::gemm_phase<EpiQup2, pg8::StaticOrder, true, true>(lds, g, S, E); }
    { int kq = 128; asm volatile("" : "+s"(kq)); pg8::Gemm g{(const bf16*)(a.ws + WS_BKVD), (const bf16*)(wb + WO_KVU), MROWS, 512, kq}; pg8::StaticOrder S; S.init(MROWS, 512, G, (int)blockIdx.x);
      EpiKVup2 E{a.ws};
      pg8::gemm_phase<EpiKVup2, pg8::StaticOrder, true, true>(lds, g, S, E); }
    asm volatile("s_waitcnt vmcnt(0)" ::: "memory");
    __syncthreads();
    if (threadIdx.x == 0) { __builtin_amdgcn_fence(__ATOMIC_RELEASE, "agent"); asm volatile("s_waitcnt vmcnt(0)" ::: "memory"); __hip_atomic_fetch_add(gdone, 1u, __ATOMIC_RELAXED, __HIP_MEMORY_SCOPE_AGENT); }
    float kmax2A; { const float g_ = a.in[I_AKN][l * 64 + (threadIdx.x & 63)]; float mx_ = g_ * g_;
#pragma unroll
        for (int o_ = 1; o_ < 64; o_ <<= 1) mx_ = fmaxf(mx_, __shfl_xor(mx_, o_));
        kmax2A = 64.0f * mx_; }
    bool b_ready = false;
    for (;;) {
        __syncthreads();
        if (threadIdx.x == 0) misc[0] = atomicAdd(ctr, 1u);
        __syncthreads();
        int u = (int)misc[0] + ustart;
        if (u >= n_units) break;
        if (u < 64) { scan_unit(lds, a, l, u >> 2, u & 3); continue; }
        u -= 64;
        int ua = -1;
        if (u < 1024) ua = u; else if (u >= 2048 && u < 3072) ua = u - 1024;
        if (ua >= 0) { const int b = ua >> 7, kvh = (ua >> 6) & 1, qb = (ua >> 2) & 15, g = ua & 3, h = kvh * 4 + g; const size_t r0 = (size_t)b * TPB;
            attn_unit<64>(lds, QA + (r0 + qb * 256) * 512 + h * 64, 512, KA + r0 * 128 + kvh * 64, 128, VA + r0 * 128 + kvh * 64, 128, Y + (r0 + qb * 256) * DM + h * 64, DM, 34, kmax2A); continue; }
        const int n_actx = (l + 1 < DEPTH) ? 128 : 0;
        if (u >= 3072 && u < 3072 + n_actx) { const int uc = u - 3072; const int b = uc >> 3, h = uc & 7, kvh = h >> 2; const size_t r0 = (size_t)b * TPB + SEQ;
            attn_unit<64>(lds, QA + r0 * 512 + h * 64, 512, KA + r0 * 128 + kvh * 64, 128, VA + r0 * 128 + kvh * 64, 128, Y + r0 * DM + h * 64, DM, 2, kmax2A); continue; }
        if (!b_ready) {
            if (threadIdx.x == 0) { unsigned sp = 0; while (__hip_atomic_load(gdone, __ATOMIC_RELAXED, __HIP_MEMORY_SCOPE_AGENT) < (unsigned)G) { __builtin_amdgcn_s_sleep(2); if (++sp > (1u << 22)) break; }
                __builtin_amdgcn_fence(__ATOMIC_ACQUIRE, "agent"); asm volatile("s_waitcnt vmcnt(0)" ::: "memory"); }
            __syncthreads(); b_ready = true;
        }
        if (u < 2048) { const int ub = u - 1024; const int b = ub >> 6, h = (ub >> 4) & 3, qb = ub & 15; const size_t r0 = (size_t)b * TPB;
            attn_unit<96>(lds, QB + (r0 + qb * 256) * 384 + h * 96, 384, KB + r0 * 384 + h * 96, 384, VB + r0 * 256 + h * 64, 256, Y + (r0 + qb * 256) * DM + 512 + h * 64, DM, 34); continue; }
        u -= 3072 + n_actx;
        { const int b = u >> 2, h = u & 3; const size_t r0 = (size_t)b * TPB + SEQ;
            attn_unit<96>(lds, QB + r0 * 384 + h * 96, 384, KB + r0 * 384 + h * 96, 384, VB + r0 * 256 + h * 64, 256, Y + r0 * DM + 512 + h * 64, DM, 2); }
    }
}

constexpr int N_PHASES = 3 + 7 * DEPTH;
#ifndef ONLY
#define ONLY -1
#endif
#ifndef SKIP
#define SKIP -2
#endif
#define EN(id) ((ONLY < 0 || ONLY == (id)) && SKIP != (id))
__global__ void __launch_bounds__(NTHR, 2) fwd_kernel(Args a_in) {
    extern __shared__ __attribute__((aligned(16))) unsigned char lds_raw[];
    LAS unsigned char* lds = (LAS unsigned char*)lds_raw;
    const int G = gridDim.x, NGW = G * NWAVES;
    { volatile LAS unsigned* mz = (volatile LAS unsigned*)(lds + LDS_MISC); if (threadIdx.x < 64) mz[threadIdx.x] = 0u; }
    __syncthreads();
    const XcdBarrier xbar = xcd_barrier_post((unsigned*)(a_in.ws + WS_CTL) + 1024, (volatile LAS unsigned*)(lds + LDS_MISC) + 8);
    bool rep_done = false;
    if (a_in.coop) cg::this_grid().sync();
    for (int ph = a_in.ph_lo; ph < a_in.ph_hi; ++ph) {
        Args a = a_in; { unsigned long long w_ = (unsigned long long)a_in.ws; asm volatile("" : "+s"(w_)); a.ws = (unsigned char*)(__attribute__((address_space(1))) unsigned char*)w_; }
        int tid_l = threadIdx.x; asm volatile("" : "+v"(tid_l));
        const int tid = tid_l, lane = tid & 63, wave = __builtin_amdgcn_readfirstlane(tid >> 6), gw = blockIdx.x * NWAVES + wave;
        if (ph > a.ph_lo) { if (a.coop) xcd_barrier(xbar); }
#if defined(PROBE_SYNCS)
        if (ph == 3) { for (int i_ = 0; i_ < PROBE_SYNCS; ++i_) cg::this_grid().sync(); }
#endif
#if defined(PROBE_PRO)
        if (ph < 3 && !rep_done) { rep_done = true; --ph; } else if (ph < 3) rep_done = false;
#endif
        if (ph == 0) { if constexpr (EN(100)) phase0(a, lds, gw, NGW, wave, lane, tid); continue; }
        if (ph == 1) { if constexpr (EN(101)) phase_ada_reduce(a, tid); continue; }
        if (ph == 2) { if constexpr (EN(102)) rows_update(a, gw, NGW, lane, false, true, nullptr, 0, 0, false, true, a.in[I_GPREMIX], 0, 0); continue; }
        const int l = (ph - 3) / 7, s = (ph - 3) % 7;
#if defined(PROBE_REP)
        if (l == 0 && ((PROBE_REP >> s) & 1) && !rep_done) { rep_done = true; --ph; } else rep_done = false;
#endif
        unsigned char* wb = a.ws + WS_W + (size_t)l * W_LAYER;
        if (s == 0) { if constexpr (EN(0)) {
            pg8::Gemm g{(const bf16*)(a.ws + WS_HN), (const bf16*)(wb + WO_IN), MROWS, DINP, DM}; pg8::StaticOrder S; S.init(MROWS, DINP, G, (int)blockIdx.x);
            EpiFeat2 E{a.ws, a.in[I_AQN] + l * 64, a.in[I_AKN] + l * 64, a.in[I_CLB], l};
            pg8::gemm_phase<EpiFeat2, pg8::StaticOrder, true, true>(lds, g, S, E);
        } } else if (s == 1) { if constexpr (EN(1)) {
            mixer_phase(a, lds, l, wb, G);
#if defined(PROBE_MIXER2)
            if (l == 0) { cg::this_grid().sync(); mixer_phase(a, lds, l, wb, G, 4, PROBE_MIXER2); }
#endif
        } } else if (s == 2) { if constexpr (EN(2)) {
            pg8::Gemm g{(const bf16*)(a.ws + WS_Y), (const bf16*)(wb + WO_OUT), MROWS, DM, DM};
            pg8::EpiStore<0> E{(bf16*)(a.ws + WS_T), DM};
            run_gemm(lds, g, E, G, l + 1 == DEPTH);
        } } else if (s == 3) { if constexpr (EN(3)) {
            rows_update(a, gw, NGW, lane, true, l == 0, a.in[I_GPOSTMIX] + l * DM, l, 2, false, true, a.in[I_GPREFFN] + l * DM, l, 3, l + 1 == DEPTH);
        } } else if (s == 4) { if constexpr (EN(4)) {
            pg8::Gemm g{(const bf16*)(a.ws + WS_HN), (const bf16*)(wb + WO_1), MROWS, DFF, DM};
            pg8::EpiStore<1> E{(bf16*)(a.ws + WS_HB), DFF};
            if (l + 1 < DEPTH && G == 256) {
                const int c = (int)blockIdx.x;
                unsigned* pcnt = (unsigned*)(a.ws + WS_CTL) + 8192 + 1024 * l;
                { pg8::OneUnit S1{(c >> 4) * 17 + 16, c & 15}; pg8::gemm_phase<pg8::EpiStore<1>, pg8::OneUnit, true, true>(lds, g, S1, E); }
                asm volatile("s_waitcnt vmcnt(0)" ::: "memory");
                __syncthreads();
                if (tid == 0) { __builtin_amdgcn_fence(__ATOMIC_RELEASE, "agent"); asm volatile("s_waitcnt vmcnt(0)" ::: "memory"); __hip_atomic_fetch_add(pcnt + 64 * (c >> 4), 1u, __ATOMIC_RELAXED, __HIP_MEMORY_SCOPE_AGENT); }
                if (c < 64) {
                    if (tid == 0) { unsigned sp = 0; while (__hip_atomic_load(pcnt + 64 * (c >> 2), __ATOMIC_RELAXED, __HIP_MEMORY_SCOPE_AGENT) < 16u) { __builtin_amdgcn_s_sleep(2); if (++sp > (1u << 22)) break; }
                        __builtin_amdgcn_fence(__ATOMIC_ACQUIRE, "agent"); asm volatile("s_waitcnt vmcnt(0)" ::: "memory"); }
                    __syncthreads();
                    { pg8::Gemm g2{(const bf16*)(a.ws + WS_HB), (const bf16*)(wb + WO_2), MROWS, DM, DFF}; pg8::EpiStore<0> E2{(bf16*)(a.ws + WS_T2), DM};
                      pg8::OneUnit S2{(c >> 2) * 17 + 16, c & 3}; pg8::gemm_phase<pg8::EpiStore<0>, pg8::OneUnit, true, true>(lds, g2, S2, E2); }
                    { pg8::LatRange S3; S3.init(52, DFF, 64, c, 204); pg8::gemm_phase<pg8::EpiStore<1>, pg8::LatRange, true, true>(lds, g, S3, E); }
                } else {
                    pg8::LatRange S3; S3.init(204, DFF, 192, c - 64, 0); pg8::gemm_phase<pg8::EpiStore<1>, pg8::LatRange, true, true>(lds, g, S3, E);
                }
            } else run_gemm(lds, g, E, G, l + 1 == DEPTH);
        } } else if (s == 5) { if constexpr (EN(5)) {
            pg8::Gemm g{(const bf16*)(a.ws + WS_HB), (const bf16*)(wb + WO_2), MROWS, DM, DFF};
            pg8::EpiStore<0> E{(bf16*)(a.ws + WS_T2), DM};
            run_gemm(lds, g, E, G, (l + 1 == DEPTH) || G == 256);
        } } else { if constexpr (EN(6)) {
            const bool more = (l + 1 < DEPTH);
            rows_update(a, gw, NGW, lane, true, l == 0, a.in[I_GPOSTMIX] + l * DM, l, 2, true, more, a.in[I_GPREMIX] + (more ? (l + 1) : l) * DM, more ? (l + 1) : l, 0, !more, true, a.in[I_GPOSTFFN] + l * DM, 5);
        } }
    }
}

#ifndef ONE_LAUNCH
#define ONE_LAUNCH 1
#endif
extern "C" void kernel_launch(void* const* d_in, const int* in_sizes, int n_in, void* d_out, int out_size, void* d_ws, size_t ws_size, hipStream_t stream) {
    static int grid = 0;
    if (grid == 0) {
        if (n_in != 22 || ws_size < WS_END) { fprintf(stderr, "kernel_launch: expected 22 inputs and >= %zu bytes of workspace (got %d, %zu)\n", (size_t)WS_END, n_in, ws_size); grid = -1; return; }
        int dev = 0, cus = 0, per_cu = 0;
        hipGetDevice(&dev); hipDeviceGetAttribute(&cus, hipDeviceAttributeMultiprocessorCount, dev);
        hipFuncSetAttribute((const void*)fwd_kernel, hipFuncAttributeMaxDynamicSharedMemorySize, LDS_BYTES);
        hipOccupancyMaxActiveBlocksPerMultiprocessor(&per_cu, (const void*)fwd_kernel, NTHR, LDS_BYTES);
        if (per_cu < 1) per_cu = 1;
        grid = cus * 1;
        (void)hipGetLastError();
    }
    if (grid < 0) return;
    (void)hipMemsetAsync((char*)d_ws + WS_CTL, 0, 65536, stream);
    Args a{};
    for (int i = 0; i < 22; ++i) a.in[i] = (const float*)d_in[i];
    a.out = (float*)d_out; a.ws = (unsigned char*)d_ws; a.pad = 0;
#if ONE_LAUNCH
    a.ph_lo = 0; a.ph_hi = N_PHASES; a.coop = 1;
    void* args[] = {&a};
    hipError_t e = hipLaunchCooperativeKernel((const void*)fwd_kernel, dim3(grid), dim3(NTHR), args, LDS_BYTES, stream);
    if (e != hipSuccess) fprintf(stderr, "cooperative launch failed: %s (grid %d)\n", hipGetErrorString(e), grid);
#else
    for (int ph = 0; ph < N_PHASES; ++ph) { a.ph_lo = ph; a.ph_hi = ph + 1; a.coop = 0; hipLaunchKernelGGL(fwd_kernel, dim3(grid), dim3(NTHR), LDS_BYTES, stream, a); }
#endif
}
```

```cpp
#include <hip/hip_runtime.h>
#include <cstdio>
#include <cstdint>
namespace pg8 {
#define PG8_LAS __attribute__((address_space(3)))
typedef unsigned short bf16_t;
typedef short bf16x8 __attribute__((ext_vector_type(8)));
typedef float f32x4 __attribute__((ext_vector_type(4)));
typedef unsigned u32x4 __attribute__((ext_vector_type(4)));
constexpr int BM = 256, BK = 64, HALF = 128, HTB = HALF * BK * 2  , STAGE_BYTES = 8 * HTB, NXCD = 8, WGM = 8;

__host__ __device__ __forceinline__ int lds_byte(int r, int c) { const int st = (r >> 4) * 2 + (c >> 5), rr = r & 15, cc = c & 31, ob = rr * 64 + cc * 2; return st * 1024 + (ob ^ (((ob >> 9) & 1) << 5)); }
__host__ __device__ __forceinline__ void stage_rc(int b, int& R, int& C) { const int st = b / 1024, sb = b % 1024, swz = sb ^ (((sb >> 9) & 1) << 5); R = (st >> 1) * 16 + swz / 64; C = (st & 1) * 32 + (swz % 64) / 2; }
__host__ __device__ __forceinline__ int perm32(int rho) { const int n = rho >> 4, i = rho & 15; return 8 * (i >> 2) + 4 * n + (i & 3); }

struct Unit { int pm, pn; };
struct Gemm { const bf16_t* A; const bf16_t* Bt; int M, N, K; };

struct StaticOrder {
    int nM, nN, nwg, G, c;
    __host__ __device__ void init(int M, int N, int G_, int c_) { nM = M / BM; nN = N / BM; nwg = nM * nN; G = G_; c = c_; }
    __host__ __device__ bool next(int i, Unit& u) const {
        const long L = (long)i * G + c; if (L >= nwg) return false;
        int wgid = (int)L; { const int q = nwg / NXCD, r = nwg % NXCD, xcd = wgid % NXCD, off = wgid / NXCD; wgid = (xcd < r ? xcd * (q + 1) : r * (q + 1) + (xcd - r) * q) + off; }
        const int nig = WGM * nN, gid = wgid / nig, fm = gid * WGM, gsz = (nM - fm) < WGM ? (nM - fm) : WGM;
        u.pm = fm + ((wgid % nig) % gsz); u.pn = (wgid % nig) / gsz; return true;
    }
    __device__ __forceinline__ void a_ready(const Unit&) const {}
    __device__ __forceinline__ void done(const Unit&) const {}
};

struct LatOrder {
    StaticOrder s;
    __host__ __device__ void init(int N, int G_, int c_) { s.init(65536, N, G_, c_); }
    __host__ __device__ bool next(int i, Unit& u) const { if (!s.next(i, u)) return false; u.pm = (u.pm >> 4) * 17 + (u.pm & 15); return true; }
    __device__ __forceinline__ void a_ready(const Unit&) const {}
    __device__ __forceinline__ void done(const Unit&) const {}
};
struct OneUnit {
    int pm, pn;
    __host__ __device__ bool next(int i, Unit& u) const { if (i > 0) return false; u.pm = pm; u.pn = pn; return true; }
    __device__ __forceinline__ void a_ready(const Unit&) const {}
    __device__ __forceinline__ void done(const Unit&) const {}
};
struct LatRange {
    StaticOrder s; int p0;
    __host__ __device__ void init(int np, int N, int G_, int c_, int p0_) { s.init(np * BM, N, G_, c_); p0 = p0_; }
    __host__ __device__ bool next(int i, Unit& u) const { if (!s.next(i, u)) return false; const int p = u.pm + p0; u.pm = (p >> 4) * 17 + (p & 15); return true; }
    __device__ __forceinline__ void a_ready(const Unit&) const {}
    __device__ __forceinline__ void done(const Unit&) const {}
};
typedef float f32x2c_t __attribute__((ext_vector_type(2))); typedef __bf16 bf16x2c_t __attribute__((ext_vector_type(2)));
__device__ __forceinline__ unsigned cvt_pk_bf16(float lo, float hi) { f32x2c_t v = {lo, hi}; bf16x2c_t b = __builtin_convertvector(v, bf16x2c_t); return __builtin_bit_cast(unsigned, b); }
typedef float f32x2 __attribute__((ext_vector_type(2)));

constexpr int TPB_ = 4352;
template <int ACT  > struct EpiStore {
    static constexpr bool PERM = true, AFTER_DRAIN = false;
    bf16_t* O; int ldc;
    __device__ __forceinline__ void operator()(const f32x4 (&acc)[2][2][4][2], const Unit& u, int wr, int wc, int fr, int fq) const {
        const int row0 = u.pm * BM + wr * 64 + fr, col0 = u.pn * BM + wc * 32 + 8 * fq;
#pragma unroll
        for (int ai = 0; ai < 2; ++ai)
#pragma unroll
            for (int m = 0; m < 4; ++m) { bf16_t* rowp = O + (size_t)(row0 + ai * HALF + m * 16) * ldc + col0;
#pragma unroll
                for (int bj = 0; bj < 2; ++bj) { f32x4 v0 = acc[ai][bj][m][0], v1 = acc[ai][bj][m][1];
                    if (ACT == 1) {
#pragma unroll
                        for (int e = 0; e < 4; ++e) { float a = v0[e] > 0.f ? v0[e] : 0.f, b = v1[e] > 0.f ? v1[e] : 0.f; v0[e] = a * a; v1[e] = b * b; } }
                    u32x4 w; w.x = cvt_pk_bf16(v0[0], v0[1]); w.y = cvt_pk_bf16(v0[2], v0[3]); w.z = cvt_pk_bf16(v1[0], v1[1]); w.w = cvt_pk_bf16(v1[2], v1[3]);
                    *(u32x4*)(rowp + bj * HALF) = w; } }
    }
};
struct EpiQup {
    static constexpr bool PERM = false, AFTER_DRAIN = false;
    bf16_t* O; const float* cosB; const float* sinB; float scale;
    __device__ __forceinline__ void operator()(const f32x4 (&acc)[2][2][4][2], const Unit& u, int wr, int wc, int fr, int fq) const {
        typedef unsigned u32x2v __attribute__((ext_vector_type(2)));
        const int row0 = u.pm * BM + wr * 64 + fr;
#pragma unroll
        for (int bj = 0; bj < 2; ++bj) {
            const int cg = u.pn * BM + bj * HALF + wc * 32;
            if (cg >= 384) continue;
            const bool pe = ((cg >> 5) % 3) == 2;
#pragma unroll
            for (int ai = 0; ai < 2; ++ai)
#pragma unroll
                for (int m = 0; m < 4; ++m) {
                    const int row = row0 + ai * HALF + m * 16; const int j = row % TPB_;
                    f32x4 v0 = acc[ai][bj][m][0], v1 = acc[ai][bj][m][1];
                    if (pe && j < 4096) {
                        const int pos = (fq < 2) ? (j >> 6) : (j & 63);
                        const f32x4 cs = *(const f32x4*)(cosB + pos * 8 + 4 * (fq & 1)), sn = *(const f32x4*)(sinB + pos * 8 + 4 * (fq & 1));
                        const f32x4 a = v0 * cs - v1 * sn, b = v1 * cs + v0 * sn; v0 = a; v1 = b;
                    }
                    v0 = v0 * scale; v1 = v1 * scale;
                    bf16_t* p = O + (size_t)row * 384 + cg + 4 * fq;
                    u32x2v w0, w1; w0.x = cvt_pk_bf16(v0[0], v0[1]); w0.y = cvt_pk_bf16(v0[2], v0[3]); w1.x = cvt_pk_bf16(v1[0], v1[1]); w1.y = cvt_pk_bf16(v1[2], v1[3]);
                    *(u32x2v*)p = w0; *(u32x2v*)(p + 16) = w1;
                    asm volatile("" ::: "memory");
                }
        }
    }
};
struct EpiKVup {
    static constexpr bool PERM = true, AFTER_DRAIN = false;
    bf16_t* KB; bf16_t* VB;
    __device__ __forceinline__ void operator()(const f32x4 (&acc)[2][2][4][2], const Unit& u, int wr, int wc, int fr, int fq) const {
        const int row0 = u.pm * BM + wr * 64 + fr;
#pragma unroll
        for (int bj = 0; bj < 2; ++bj) {
            const int head = u.pn * 2 + bj; const int within = wc * 32 + 8 * fq;
#pragma unroll
            for (int ai = 0; ai < 2; ++ai)
#pragma unroll
                for (int m = 0; m < 4; ++m) {
                    const int row = row0 + ai * HALF + m * 16;
                    const f32x4 v0 = acc[ai][bj][m][0], v1 = acc[ai][bj][m][1];
                    u32x4 w; w.x = cvt_pk_bf16(v0[0], v0[1]); w.y = cvt_pk_bf16(v0[2], v0[3]); w.z = cvt_pk_bf16(v1[0], v1[1]); w.w = cvt_pk_bf16(v1[2], v1[3]);
                    bf16_t* p = (within < 64) ? (KB + (size_t)row * 384 + head * 96 + within) : (VB + (size_t)row * 256 + head * 64 + (within - 64));
                    *(u32x4*)p = w;
                }
        }
    }
};

struct EpiFeat {
    static constexpr bool PERM = true, AFTER_DRAIN = false;
    bf16_t* FEAT; int ldf; bf16_t* CFQ; bf16_t* CKF; bf16_t* CKB; bf16_t* CFV; bf16_t* CFG; const float* clb; int layer;
    __device__ __forceinline__ void operator()(const f32x4 (&acc)[2][2][4][2], const Unit& u, int wr, int wc, int fr, int fq) const {
        const int row0 = u.pm * BM + wr * 64 + fr;
#pragma unroll
        for (int bj = 0; bj < 2; ++bj) {
            const int c0 = u.pn * BM + bj * HALF + wc * 32 + 8 * fq;
            if (c0 >= 2400) continue;
            const int seg = (c0 < 1120) ? -1 : ((c0 - 1120) >> 8); const int ch = (c0 - 1120) & 255;
            float om[8];
#pragma unroll
            for (int e = 0; e < 8; ++e) om[e] = 1.0f;
            if (layer > 0 && (seg == 1 || seg == 2)) {
                const float* c1 = clb + 512 + (seg - 1) * 256 + ch; const float* c0p = clb + (seg - 1) * 256 + ch;
#pragma unroll
                for (int e = 0; e < 8; ++e) om[e] = 1.0f - 1.0f / (1.0f + __expf(-(c1[e] - c0p[e])));
            }
            bf16_t* dst; int ld;
            if (seg < 0) { dst = FEAT + c0; ld = ldf; } else { dst = (seg == 0 ? CFQ : seg == 1 ? CKF : seg == 2 ? CKB : seg == 3 ? CFV : CFG) + ch; ld = 256; }
#pragma unroll
            for (int ai = 0; ai < 2; ++ai)
#pragma unroll
                for (int m = 0; m < 4; ++m) {
                    const int row = row0 + ai * HALF + m * 16;
                    f32x4 v0 = acc[ai][bj][m][0], v1 = acc[ai][bj][m][1];
                    if (seg == 0) {
#pragma unroll
                        for (int e = 0; e < 4; ++e) { v0[e] = v0[e] / (1.0f + __expf(-v0[e])); v1[e] = v1[e] / (1.0f + __expf(-v1[e])); }
                    } else if (seg == 1 || seg == 2) {
#pragma unroll
                        for (int e = 0; e < 4; ++e) { v0[e] = om[e] / (1.0f + __expf(v0[e])); v1[e] = om[4 + e] / (1.0f + __expf(v1[e])); }
                    }
                    u32x4 w; w.x = cvt_pk_bf16(v0[0], v0[1]); w.y = cvt_pk_bf16(v0[2], v0[3]); w.z = cvt_pk_bf16(v1[0], v1[1]); w.w = cvt_pk_bf16(v1[2], v1[3]);
                    *(u32x4*)(dst + (size_t)row * ld) = w;
                }
        }
    }
};
template <class Epi, class Sched, bool ALIGN_EPI = false, bool SP2 = false>
__device__ __forceinline__ void gemm_phase(PG8_LAS unsigned char* lds, const Gemm g, const Sched& S, const Epi& E) {
    int tid_l = threadIdx.x; asm volatile("" : "+v"(tid_l)); const int tid = tid_l, wid = __builtin_amdgcn_readfirstlane(tid >> 6), lane = tid & 63, wr = wid >> 2, wc = wid & 3, fr = lane & 15, fq = lane >> 4;
    const int K = g.K, nt = K / BK;
    unsigned voffA[2], voffB[2];
#pragma unroll
    for (int i = 0; i < 2; ++i) { int R, C; stage_rc(tid * 16 + i * 8192, R, C); const int Rb = Epi::PERM ? ((R & ~31) + perm32(R & 31)) : R;
        voffA[i] = (unsigned)(R * K + C) * 2u; voffB[i] = (unsigned)(Rb * K + C) * 2u; }
    const size_t kstep = (size_t)(BK * 2);
    const size_t hstep = (size_t)HALF * K * 2;
    const size_t tstep = 2 * hstep;
    const unsigned ldsw = (unsigned)wid * 1024u;
    const int aoff = lds_byte(wr * 64 + fr, fq * 8), boff = lds_byte(wc * 32 + fr, fq * 8);
#define PG8_SA(b, h) (((b) * 2 + (h)) * HTB)
#define PG8_SB(b, h) ((4 + (b) * 2 + (h)) * HTB)
#define PG8_STAGE(bufoff, gbase, voff) do { _Pragma("unroll") for (int _i = 0; _i < 2; ++_i) \
        __builtin_amdgcn_global_load_lds((const unsigned*)((const char*)(gbase) + (voff)[_i]), (PG8_LAS unsigned*)(lds + (bufoff) + ldsw + _i * 8192), 16, 0, 0); } while (0)
#define PG8_LDA(dst, b, h) do { _Pragma("unroll") for (int m = 0; m < 4; ++m) _Pragma("unroll") for (int k = 0; k < 2; ++k) dst[m][k] = *(const PG8_LAS bf16x8*)(lds + PG8_SA(b, h) + aoff + m * 2048 + k * 1024); } while (0)
#define PG8_LDB(dst, b, h) do { _Pragma("unroll") for (int n = 0; n < 2; ++n) _Pragma("unroll") for (int k = 0; k < 2; ++k) dst[n][k] = *(const PG8_LAS bf16x8*)(lds + PG8_SB(b, h) + boff + n * 2048 + k * 1024); } while (0)
#define PG8_MMA(ai, bj, At, Bt) do { __builtin_amdgcn_s_setprio(1); _Pragma("unroll") for (int m = 0; m < 4; ++m) _Pragma("unroll") for (int n = 0; n < 2; ++n) _Pragma("unroll") for (int k = 0; k < 2; ++k) \
        acc[ai][bj][m][n] = __builtin_amdgcn_mfma_f32_16x16x32_bf16(Bt[n][k], At[m][k], acc[ai][bj][m][n], 0, 0, 0); __builtin_amdgcn_s_setprio(0); } while (0)
#define PG8_WAIT_V(n) asm volatile("s_waitcnt vmcnt(" #n ")" ::: "memory")
#define PG8_WAIT_L(n) asm volatile("s_waitcnt lgkmcnt(" #n ")" ::: "memory")
#define PG8_BAR __builtin_amdgcn_s_barrier()
#define PG8_SCHED __builtin_amdgcn_sched_barrier(0)
    Unit cur, nxt; int ui = 0;
    if (!S.next(0, cur)) return;
    f32x4 acc[2][2][4][2];
#pragma unroll
    for (int a = 0; a < 2; ++a)
#pragma unroll
        for (int b = 0; b < 2; ++b)
#pragma unroll
            for (int m = 0; m < 4; ++m)
#pragma unroll
                for (int n = 0; n < 2; ++n) acc[a][b][m][n] = (f32x4){0.f, 0.f, 0.f, 0.f};
    bf16x8 At[4][2], B0[2][2], B1[2][2];
    const char* cA = (const char*)g.A + (size_t)cur.pm * tstep; const char* cB = (const char*)g.Bt + (size_t)cur.pn * tstep;
    S.a_ready(cur);
    if constexpr (SP2) {
        PG8_STAGE(PG8_SB(0, 0), cB, voffB); PG8_STAGE(PG8_SB(0, 1), cB + hstep, voffB); PG8_STAGE(PG8_SA(0, 0), cA, voffA); PG8_STAGE(PG8_SA(0, 1), cA + hstep, voffA);
        if (wr == 1) PG8_BAR;
        PG8_WAIT_V(2); PG8_BAR;
        PG8_STAGE(PG8_SB(1, 0), cB + kstep, voffB); PG8_STAGE(PG8_SA(1, 0), cA + kstep, voffA); PG8_STAGE(PG8_SB(1, 1), cB + hstep + kstep, voffB);
        PG8_WAIT_V(6); PG8_BAR;
    } else {
        PG8_STAGE(PG8_SB(0, 0), cB, voffB); PG8_STAGE(PG8_SA(0, 0), cA, voffA); PG8_STAGE(PG8_SB(0, 1), cB + hstep, voffB); PG8_STAGE(PG8_SA(0, 1), cA + hstep, voffA);
        if (wr == 1) PG8_BAR;
        PG8_WAIT_V(4); PG8_BAR;
        PG8_STAGE(PG8_SB(1, 0), cB + kstep, voffB); PG8_STAGE(PG8_SA(1, 0), cA + kstep, voffA); PG8_STAGE(PG8_SB(1, 1), cB + hstep + kstep, voffB);
        PG8_WAIT_V(6); PG8_BAR;
    }
    for (;;) {
        const bool has_next = S.next(ui + 1, nxt);
        const char* nA = has_next ? (const char*)g.A + (size_t)nxt.pm * tstep : cA; const char* nB = has_next ? (const char*)g.Bt + (size_t)nxt.pn * tstep : cB;
        for (int t = 0; t < nt; t += 2) {
            const bool last = (t == nt - 2);
            const char* a1 = cA + (size_t)(t + 1) * kstep;
            const char* a2 = last ? nA : cA + (size_t)(t + 2) * kstep; const char* b2 = last ? nB : cB + (size_t)(t + 2) * kstep;
            const char* a3 = a2 + kstep; const char* b3 = b2 + kstep;
            if (last && has_next) S.a_ready(nxt);
            if constexpr (SP2) {
            PG8_LDB(B0, 0, 0); PG8_LDB(B1, 0, 1); PG8_SCHED; PG8_LDA(At, 0, 0); PG8_STAGE(PG8_SA(1, 1), a1 + hstep, voffA);
            PG8_WAIT_V(8); PG8_WAIT_L(0); PG8_BAR; PG8_MMA(0, 0, At, B0); PG8_MMA(0, 1, At, B1); PG8_BAR; PG8_SCHED;
            PG8_LDA(At, 0, 1); PG8_STAGE(PG8_SB(0, 0), b2, voffB); PG8_STAGE(PG8_SB(0, 1), b2 + hstep, voffB); PG8_STAGE(PG8_SA(0, 0), a2, voffA);
            PG8_WAIT_V(8); PG8_WAIT_L(0); PG8_BAR; PG8_MMA(1, 0, At, B0); PG8_MMA(1, 1, At, B1); PG8_BAR; PG8_SCHED;
            PG8_LDB(B0, 1, 0); PG8_LDB(B1, 1, 1); PG8_SCHED; PG8_LDA(At, 1, 0); PG8_STAGE(PG8_SA(0, 1), a2 + hstep, voffA);
            PG8_WAIT_V(8); PG8_WAIT_L(0); PG8_BAR; PG8_MMA(0, 0, At, B0); PG8_MMA(0, 1, At, B1); PG8_BAR; PG8_SCHED;
            PG8_LDA(At, 1, 1); PG8_STAGE(PG8_SB(1, 0), b3, voffB); PG8_STAGE(PG8_SB(1, 1), b3 + hstep, voffB); PG8_STAGE(PG8_SA(1, 0), a3, voffA);
            PG8_WAIT_V(8); PG8_WAIT_L(0); PG8_BAR; PG8_MMA(1, 0, At, B0); PG8_MMA(1, 1, At, B1); PG8_BAR; PG8_SCHED;
            } else {
            PG8_LDB(B0, 0, 0); PG8_SCHED; PG8_LDA(At, 0, 0); PG8_STAGE(PG8_SA(1, 1), a1 + hstep, voffA);
            PG8_WAIT_L(8); PG8_BAR; PG8_WAIT_L(0); PG8_MMA(0, 0, At, B0); PG8_BAR; PG8_SCHED;
            PG8_LDB(B1, 0, 1); PG8_STAGE(PG8_SB(0, 0), b2, voffB);
            PG8_BAR; PG8_WAIT_L(0); PG8_MMA(0, 1, At, B1); PG8_BAR;
            PG8_LDA(At, 0, 1); PG8_STAGE(PG8_SA(0, 0), a2, voffA);
            PG8_BAR; PG8_WAIT_L(0); PG8_MMA(1, 0, At, B0); PG8_BAR; PG8_SCHED;
            PG8_STAGE(PG8_SB(0, 1), b2 + hstep, voffB);
            PG8_WAIT_V(6); PG8_BAR; PG8_MMA(1, 1, At, B1); PG8_BAR;
            PG8_LDB(B0, 1, 0); PG8_SCHED; PG8_LDA(At, 1, 0); PG8_STAGE(PG8_SA(0, 1), a2 + hstep, voffA);
            PG8_WAIT_L(8); PG8_BAR; PG8_WAIT_L(0); PG8_MMA(0, 0, At, B0); PG8_BAR; PG8_SCHED;
            PG8_LDB(B1, 1, 1); PG8_STAGE(PG8_SB(1, 0), b3, voffB);
            PG8_BAR; PG8_WAIT_L(0); PG8_MMA(0, 1, At, B1); PG8_BAR;
            PG8_LDA(At, 1, 1); PG8_STAGE(PG8_SA(1, 0), a3, voffA);
            PG8_BAR; PG8_WAIT_L(0); PG8_MMA(1, 0, At, B0); PG8_BAR; PG8_SCHED;
            PG8_STAGE(PG8_SB(1, 1), b3 + hstep, voffB);
            PG8_WAIT_V(6); PG8_BAR; PG8_MMA(1, 1, At, B1); PG8_BAR;
            }
        }
        if constexpr (ALIGN_EPI) { if (wr == 0) PG8_BAR; }
        if constexpr (!Epi::AFTER_DRAIN) { E(acc, cur, wr, wc, fr, fq); S.done(cur); }
        if (!has_next) break;
#pragma unroll
        for (int a = 0; a < 2; ++a)
#pragma unroll
            for (int b = 0; b < 2; ++b)
#pragma unroll
                for (int m = 0; m < 4; ++m)
#pragma unroll
                    for (int n = 0; n < 2; ++n) acc[a][b][m][n] = (f32x4){0.f, 0.f, 0.f, 0.f};
        cur = nxt; cA = nA; cB = nB; ++ui;
        if constexpr (ALIGN_EPI) { if (wr == 1) PG8_BAR; }
    }
    PG8_WAIT_V(0);
    if constexpr (!ALIGN_EPI) { if (wr == 0) PG8_BAR; }
    PG8_BAR;
    if constexpr (Epi::AFTER_DRAIN) { E.fused(acc, cur, wr, wc, fr, fq, lds, wid, lane); S.done(cur); }
#undef PG8_SA
#undef PG8_SB
#undef PG8_STAGE
#undef PG8_LDA
#undef PG8_LDB
#undef PG8_MMA
#undef PG8_WAIT_V
#undef PG8_WAIT_L
#undef PG8_BAR
#undef PG8_SCHED
}
}

#include <hip/hip_cooperative_groups.h>
namespace cg = cooperative_groups;
#define LAS __attribute__((address_space(3)))
typedef unsigned short bf16;
typedef short bf16x8 __attribute__((ext_vector_type(8)));
typedef float f32x4 __attribute__((ext_vector_type(4)));
typedef float f32x16 __attribute__((ext_vector_type(16)));
typedef unsigned u32x4 __attribute__((ext_vector_type(4)));
typedef unsigned u32x2 __attribute__((ext_vector_type(2)));
typedef short s16x4 __attribute__((ext_vector_type(4)));

constexpr int NB = 16, SEQ = 4096, CTX = 256, TPB = 4352, MROWS = NB * TPB, DM = 1024, DIN = 2400, DINP = 2560, DFF = 4096, DEPTH = 2;
constexpr int NTHR = 512, NWAVES = 8;
constexpr float EPS = 1e-6f;
constexpr float LOG2E = 1.4426950408889634f;
constexpr float QSCALE_A = 0.125f * LOG2E;
constexpr float QSCALE_B = 0.10206207261596577f * LOG2E;
constexpr int C_AQ = 0, C_AK = 512, C_AV = 640, C_BQD = 768, C_BKVD = 960, C_BKR = 1088, C_CQ = 1120, C_CFF = 1376, C_CFB = 1632, C_CI = 1888, C_CG = 2144;

constexpr size_t MiB = 1u << 20;
constexpr size_t WS_CTL = 0;
constexpr size_t WS_ADA = 1 * MiB;
constexpr size_t WS_TAB = 2 * MiB;
constexpr size_t WS_SSQ_Q = 1020 * MiB, WS_SSQ_KV = 1022 * MiB + 262144;
constexpr size_t WS_PART = 1004 * MiB;
constexpr size_t WS_W = 4 * MiB, W_LAYER = 24 * MiB;
constexpr size_t WO_IN = 0, WO_OUT = 5 * MiB, WO_1 = 7 * MiB, WO_2 = 15 * MiB, WO_QU = 23 * MiB, WO_KVU = 23 * MiB + 512 * 1024;
constexpr size_t WS_XC = 52 * MiB;
constexpr size_t WS_HN = 68 * MiB;
constexpr size_t WS_T = 204 * MiB;
constexpr size_t WS_Y = 340 * MiB;
constexpr size_t WS_T2 = WS_Y;
constexpr size_t WS_OV = 476 * MiB;
constexpr size_t WS_HB = WS_OV;
constexpr size_t WS_FEAT = WS_OV;
constexpr size_t WS_QA = 816 * MiB, WS_KB = 884 * MiB, WS_CFQ = 935 * MiB, WS_CFV = 969 * MiB, WS_KA = 1003 * MiB;
constexpr size_t WS_VA = WS_T, WS_CFG = WS_T + 17 * MiB, WS_CKF = WS_T + 51 * MiB, WS_CKB = WS_T + 85 * MiB;
constexpr size_t WS_BQD = WS_Y, WS_BKVD = WS_Y + 34 * MiB;
constexpr size_t WS_QB = WS_OV, WS_VB = WS_OV + 51 * MiB, WS_OF = WS_OV + 85 * MiB, WS_OB = WS_OV + 153 * MiB;
constexpr size_t WS_END = 1024 * MiB;

constexpr int LDS_BYTES = 131072 + 1024;
constexpr int LDS_MISC = 131072;

__device__ __forceinline__ unsigned pk2(float lo, float hi) { return pg8::cvt_pk_bf16(lo, hi); }
__device__ __forceinline__ float bf_lo(unsigned w) { return __uint_as_float(w << 16); }
__device__ __forceinline__ float bf_hi(unsigned w) { return __uint_as_float(w & 0xffff0000u); }
__device__ __forceinline__ void unpack8(const u32x4 w, float (&f)[8]) { f[0] = bf_lo(w.x); f[1] = bf_hi(w.x); f[2] = bf_lo(w.y); f[3] = bf_hi(w.y); f[4] = bf_lo(w.z); f[5] = bf_hi(w.z); f[6] = bf_lo(w.w); f[7] = bf_hi(w.w); }
__device__ __forceinline__ u32x4 pack8(const float (&f)[8]) { u32x4 w; w.x = pk2(f[0], f[1]); w.y = pk2(f[2], f[3]); w.z = pk2(f[4], f[5]); w.w = pk2(f[6], f[7]); return w; }
__device__ __forceinline__ float wave_sum(float v) {
#pragma unroll
    for (int o = 1; o < 64; o <<= 1) v += __shfl_xor(v, o);
    return v;
}
__device__ __forceinline__ float sigmoidf_(float z) { return 1.0f / (1.0f + __expf(-z)); }
__device__ __forceinline__ float siluf_(float z) { return z / (1.0f + __expf(-z)); }

#define XB_TMO      128
#define XB_XCNT(j)  (256  + 64 * (j))
#define XB_XSUB(j)  (1280 + 64 * (j))
#define XB_XGEN(j)  (2304 + 64 * (j))
#define XB_TOP      3328
#define XB_TOPGEN   3392
#define XCD_BAR_WORDS 3456
#define XB_SPIN_CAP (1u << 18)

__device__ __forceinline__ unsigned xb_ld(unsigned* p)              { return __hip_atomic_load(p, __ATOMIC_RELAXED, __HIP_MEMORY_SCOPE_AGENT); }
__device__ __forceinline__ unsigned xb_add(unsigned* p, unsigned v) { return __hip_atomic_fetch_add(p, v, __ATOMIC_RELAXED, __HIP_MEMORY_SCOPE_AGENT); }
__device__ __forceinline__ unsigned xb_xcc_id() { return (unsigned)__builtin_amdgcn_s_getreg((3 << 11) | 20) & 0xFu; }
#define XB_SPIN(cond, bar) do { unsigned _sp = 0; while (cond) { __builtin_amdgcn_s_sleep(1); \
    if ((++_sp & 255u) == 0u) { if (xb_ld(&(bar)[XB_TMO])) break; if (_sp > XB_SPIN_CAP) { atomicAdd(&(bar)[XB_TMO], 1u); break; } } } } while (0)

struct XcdBarrier {
    unsigned* bar; unsigned x;
    volatile LAS unsigned* st;
};

__device__ __forceinline__ XcdBarrier xcd_barrier_post(unsigned* bar, volatile LAS unsigned* st) {
    XcdBarrier b; b.bar = bar; b.x = xb_xcc_id(); b.st = st;
    if (threadIdx.x == 0) (void)xb_add(&bar[XB_XCNT(b.x)], 1u);
    return b;
}
__device__ __forceinline__ void xcd_barrier_complete(unsigned* bar, unsigned x, unsigned& nloc, unsigned& nx) {
    const unsigned G = gridDim.x * gridDim.y * gridDim.z;
    unsigned sum, cnt, mine, sp = 0u;
    for (;;) {
        sum = 0u; cnt = 0u; mine = 0u;
#pragma unroll
        for (unsigned j = 0; j < 16; ++j) { const unsigned c = xb_ld(&bar[XB_XCNT(j)]); sum += c; cnt += (c > 0u) ? 1u : 0u; mine = (j == x) ? c : mine; }
        if (sum == G) break;
        __builtin_amdgcn_s_sleep(1);
        if ((++sp & 255u) == 0u) { if (xb_ld(&bar[XB_TMO])) break; if (sp > XB_SPIN_CAP) { atomicAdd(&bar[XB_TMO], 1u); break; } }
    }
    nloc = mine > 0u ? mine : 1u; nx = cnt > 0u ? cnt : 1u;
}

__device__ __forceinline__ void xcd_barrier(const XcdBarrier& b) {
    asm volatile("s_waitcnt vmcnt(0)" ::: "memory");
    __syncthreads();
    if (threadIdx.x == 0) {
        unsigned* bar = b.bar;
        __builtin_amdgcn_s_waitcnt(0);
        unsigned nloc = b.st[0], nx = b.st[1];
        if (nloc == 0u) { xcd_barrier_complete(bar, b.x, nloc, nx); b.st[0] = nloc; b.st[1] = nx; }
        const unsigned old = xb_add(&bar[XB_XSUB(b.x)], 1u);
        const unsigned gen = old / nloc;
        if (old + 1u == (gen + 1u) * nloc) {
            __builtin_amdgcn_fence(__ATOMIC_RELEASE, "agent");
            asm volatile("s_waitcnt vmcnt(0)" ::: "memory");
            const unsigned og = xb_add(&bar[XB_TOP], 1u);
            const unsigned tg = og / nx;
            if (og + 1u == (tg + 1u) * nx) xb_add(&bar[XB_TOPGEN], 1u);
            else XB_SPIN(xb_ld(&bar[XB_TOPGEN]) == tg, bar);
            __builtin_amdgcn_fence(__ATOMIC_ACQUIRE, "agent");
            xb_add(&bar[XB_XGEN(b.x)], 1u);
            asm volatile("s_waitcnt vmcnt(0)" ::: "memory");
        } else {
            XB_SPIN(xb_ld(&bar[XB_XGEN(b.x)]) == gen, bar);
            __builtin_amdgcn_fence(__ATOMIC_ACQUIRE, "agent");
            asm volatile("s_waitcnt vmcnt(0)" ::: "memory");
        }
    }
    __syncthreads();
}

struct Args {
    const float* in[22];
    float* out; unsigned char* ws;
    int ph_lo, ph_hi, coop, pad;
};
enum { I_X = 0, I_C, I_CTX, I_CCTX, I_WADA, I_BADA, I_GPREMIX, I_GPOSTMIX, I_GPREFFN, I_GPOSTFFN, I_WIN, I_AQN, I_AKN, I_BQN, I_WQUP, I_BKVN, I_WKVUP, I_CLB, I_CON, I_WOUT, I_WFF1, I_WFF2 };

__device__ __forceinline__ void transpose_item(const float* W, int K, int N, bf16* WT, int Kp, int Np, LAS float* scr, int item, int lane, const float* kscale = nullptr, bool headsplit = false) {
    const int nblk = Np / 32, kb = item / nblk, nb = item % nblk, k0 = 64 * kb, n0 = 32 * nb;
    const int n0o = (headsplit && n0 < 768) ? ((n0 & ~255) + ((n0 >> 5) & 1) * 128 + ((n0 >> 6) & 3) * 32) : n0;
    const int n = n0 + (lane & 31);
#pragma unroll
    for (int i = 0; i < 32; ++i) { const int kk = 2 * i + (lane >> 5); const int k = k0 + kk; scr[kk * 33 + (lane & 31)] = (k < K && n < N) ? W[(size_t)k * N + n] * (kscale ? kscale[k] : 1.0f) : 0.f; }
    asm volatile("s_waitcnt lgkmcnt(0)" ::: "memory");
    const int c = lane & 7;
#pragma unroll
    for (int j = 0; j < 4; ++j) { const int nn = (lane >> 3) + 8 * j; const LAS float* s = scr + (8 * c) * 33 + nn;
        u32x4 o; o.x = pk2(s[0 * 33], s[1 * 33]); o.y = pk2(s[2 * 33], s[3 * 33]); o.z = pk2(s[4 * 33], s[5 * 33]); o.w = pk2(s[6 * 33], s[7 * 33]);
        *(u32x4*)(WT + (size_t)(n0o + nn) * Kp + k0 + 8 * c) = o; }
    asm volatile("s_waitcnt lgkmcnt(0)" ::: "memory");
}
__device__ __forceinline__ void phase0(const Args& a, LAS unsigned char* lds, int gw, int NGW, int wave, int lane, int tid) {
    LAS float* scr = (LAS float*)(lds + wave * 16384);
    constexpr int I_IN = 16 * 80, I_OUT = 16 * 32, I_1 = 16 * 128, I_2 = 64 * 32, I_QU = 4 * 16, I_KVU = 2 * 16, I_L = I_IN + I_OUT + I_1 + I_2 + I_QU + I_KVU;
    for (int it = gw; it < 2 * I_L; it += NGW) {
        const int l = it / I_L; int r = it % I_L; unsigned char* wb = a.ws + WS_W + (size_t)l * W_LAYER;
        if (r < I_IN) { transpose_item(a.in[I_WIN] + (size_t)l * DM * DIN, DM, DIN, (bf16*)(wb + WO_IN), DM, DINP, scr, r, lane, nullptr, true); continue; } r -= I_IN;
        if (r < I_OUT) { transpose_item(a.in[I_WOUT] + (size_t)l * DM * DM, DM, DM, (bf16*)(wb + WO_OUT), DM, DM, scr, r, lane); continue; } r -= I_OUT;
        if (r < I_1) { transpose_item(a.in[I_WFF1] + (size_t)l * DM * DFF, DM, DFF, (bf16*)(wb + WO_1), DM, DFF, scr, r, lane); continue; } r -= I_1;
        if (r < I_2) { transpose_item(a.in[I_WFF2] + (size_t)l * DFF * DM, DFF, DM, (bf16*)(wb + WO_2), DFF, DM, scr, r, lane); continue; } r -= I_2;
        if (r < I_QU) { transpose_item(a.in[I_WQUP] + (size_t)l * 192 * 384, 192, 384, (bf16*)(wb + WO_QU), 256, 512, scr, r, lane, a.in[I_BQN] + l * 192); continue; } r -= I_QU;
        transpose_item(a.in[I_WKVUP] + (size_t)l * 128 * 512, 128, 512, (bf16*)(wb + WO_KVU), 128, 512, scr, r, lane, a.in[I_BKVN] + l * 128);
    }
    float* PART = (float*)(a.ws + WS_PART);
    for (int it = gw; it < 16 * 2 * 96; it += NGW) {
        const int nb = it % 96, l = (it / 96) % 2, ks = it / 192; const int n = nb * 64 + lane;
        float creg[17];
#pragma unroll
        for (int r = 0; r < 17; ++r) { const float cv = (r < 16) ? a.in[I_C][r * DM + ks * 64 + lane] : a.in[I_CCTX][ks * 64 + lane]; creg[r] = siluf_(cv); }
        float acc[17];
#pragma unroll
        for (int r = 0; r < 17; ++r) acc[r] = 0.f;
        const float* wp = a.in[I_WADA] + ((size_t)l * DM + ks * 64) * 6144 + n;
#pragma unroll 32
        for (int kk = 0; kk < 64; ++kk) { const float w = wp[(size_t)kk * 6144];
#pragma unroll
            for (int r = 0; r < 17; ++r) acc[r] += __shfl(creg[r], kk) * w; }
#pragma unroll
        for (int r = 0; r < 17; ++r) PART[(((size_t)ks * 2 + l) * 17 + r) * 6144 + n] = acc[r];
    }
    if (blockIdx.x == 0) {
        float* tab = (float*)(a.ws + WS_TAB);
        for (int e = tid; e < 64 * 16 + 64 * 8; e += NTHR) {
            int pos, f, nf; float* cdst; float* sdst;
            if (e < 1024) { pos = e >> 4; f = e & 15; nf = 16; cdst = tab + e; sdst = tab + 1024 + e; }
            else { const int e2 = e - 1024; pos = e2 >> 3; f = e2 & 7; nf = 8; cdst = tab + 2048 + e2; sdst = tab + 2560 + e2; }
            const float inv = exp2f(-(float)f / (float)nf * 13.287712379549449f);
            const float ang = (float)pos * inv;
            const float kf = rintf(ang * 0.15915494309189535f);
            float rr = fmaf(-kf, 6.28125f, ang); rr = fmaf(-kf, 1.9353071795864769e-3f, rr);
            *cdst = __cosf(rr); *sdst = __sinf(rr);
        }
    }
}
__device__ __forceinline__ void phase_ada_reduce(const Args& a, int tid) {
    const float* PART = (const float*)(a.ws + WS_PART); float* ADA = (float*)(a.ws + WS_ADA);
    for (int e = blockIdx.x * NTHR + tid; e < 2 * 17 * 6144; e += gridDim.x * NTHR) {
        const int n = e % 6144, l = e / (17 * 6144);
        float s = a.in[I_BADA][l * 6144 + n];
#pragma unroll
        for (int ks = 0; ks < 16; ++ks) s += PART[(size_t)ks * (2 * 17 * 6144) + e];
        ADA[e] = s;
    }
}

__device__ __forceinline__ const float* ada_ptr(const Args& a, int l, int R, int chunk) { const int b = R / TPB, j = R % TPB; const int r = (j < SEQ) ? b : 16; return (const float*)(a.ws + WS_ADA) + ((size_t)l * 17 + r) * 6144 + chunk * DM; }
__device__ __forceinline__ size_t xrow_off(int R, bool& lat) { const int b = R / TPB, j = R % TPB; lat = j < SEQ; return lat ? ((size_t)b * SEQ + j) * DM : ((size_t)b * CTX + (j - SEQ)) * DM; }
#define RCOL(q) (8 * lane + 512 * ((q) >> 1) + 4 * ((q) & 1))
struct RowIn { f32x4 x[4]; u32x4 t[2]; u32x4 t2[2]; };
__device__ __forceinline__ void row_load(const Args& a, int R, int lane, bool has_upd, bool xin_from_inputs, RowIn& r, bool has_upd2 = false) {
    bool lat; const size_t xo = xrow_off(R, lat);
    const float* xin = xin_from_inputs ? (lat ? a.in[I_X] : a.in[I_CTX]) : (lat ? (const float*)a.out : (const float*)(a.ws + WS_XC));
#pragma unroll
    for (int q = 0; q < 4; ++q) r.x[q] = *(const f32x4*)(xin + xo + RCOL(q));
    if (has_upd) { const bf16* T = (const bf16*)(a.ws + WS_T) + (size_t)R * DM;
#pragma unroll
        for (int h = 0; h < 2; ++h) r.t[h] = *(const u32x4*)(T + 8 * lane + 512 * h); }
    if (has_upd2) { const bf16* T2 = (const bf16*)(a.ws + WS_T2) + (size_t)R * DM;
#pragma unroll
        for (int h = 0; h < 2; ++h) r.t2[h] = *(const u32x4*)(T2 + 8 * lane + 512 * h); }
}
__device__ __forceinline__ void row_compute(const Args& a, int R, int lane, const RowIn& in, bool has_upd, const float* gpost, int l_gate, int gate_chunk,
                                            bool write_x, bool has_hn, const float* gpre, int l_mod, int sh_chunk, bool has_upd2 = false, const float* gpost2 = nullptr, int gate_chunk2 = 0) {
    bool lat; const size_t xo = xrow_off(R, lat);
    float* xout = lat ? a.out : (float*)(a.ws + WS_XC);
    f32x4 v[4];
#pragma unroll
    for (int q = 0; q < 4; ++q) v[q] = in.x[q];
    if (has_upd) {
        f32x4 t[4]; float ss = 0.f;
#pragma unroll
        for (int q = 0; q < 4; ++q) { const u32x4 w4 = in.t[q >> 1]; const unsigned wx = (q & 1) ? w4.z : w4.x, wy = (q & 1) ? w4.w : w4.y; t[q] = (f32x4){bf_lo(wx), bf_hi(wx), bf_lo(wy), bf_hi(wy)}; ss += t[q].x * t[q].x + t[q].y * t[q].y + t[q].z * t[q].z + t[q].w * t[q].w; }
        const float rinv = rsqrtf(wave_sum(ss) * (1.0f / DM) + EPS);
        const float* gate = ada_ptr(a, l_gate, R, gate_chunk);
#pragma unroll
        for (int q = 0; q < 4; ++q) { const f32x4 g = *(const f32x4*)(gpost + RCOL(q)), gt = *(const f32x4*)(gate + RCOL(q)); v[q] = v[q] + gt * (t[q] * rinv * g); }
    }
    if (has_upd2) {
        f32x4 t[4]; float ss = 0.f;
#pragma unroll
        for (int q = 0; q < 4; ++q) { const u32x4 w4 = in.t2[q >> 1]; const unsigned wx = (q & 1) ? w4.z : w4.x, wy = (q & 1) ? w4.w : w4.y; t[q] = (f32x4){bf_lo(wx), bf_hi(wx), bf_lo(wy), bf_hi(wy)}; ss += t[q].x * t[q].x + t[q].y * t[q].y + t[q].z * t[q].z + t[q].w * t[q].w; }
        const float rinv = rsqrtf(wave_sum(ss) * (1.0f / DM) + EPS);
        const float* gate = ada_ptr(a, l_gate, R, gate_chunk2);
#pragma unroll
        for (int q = 0; q < 4; ++q) { const f32x4 g = *(const f32x4*)(gpost2 + RCOL(q)), gt = *(const f32x4*)(gate + RCOL(q)); v[q] = v[q] + gt * (t[q] * rinv * g); }
    }
    if (has_upd || has_upd2) {
        if (write_x) {
#pragma unroll
            for (int q = 0; q < 4; ++q) *(f32x4*)(xout + xo + RCOL(q)) = v[q];
        }
    }
    if (has_hn) {
        float ss = 0.f;
#pragma unroll
        for (int q = 0; q < 4; ++q) ss += v[q].x * v[q].x + v[q].y * v[q].y + v[q].z * v[q].z + v[q].w * v[q].w;
        const float rinv = rsqrtf(wave_sum(ss) * (1.0f / DM) + EPS);
        const float* sh = ada_ptr(a, l_mod, R, sh_chunk); const float* sc = sh + DM;
        bf16* HN = (bf16*)(a.ws + WS_HN) + (size_t)R * DM; u32x2 hw[4];
#pragma unroll
        for (int q = 0; q < 4; ++q) { const f32x4 g = *(const f32x4*)(gpre + RCOL(q)), s1 = *(const f32x4*)(sc + RCOL(q)), s0 = *(const f32x4*)(sh + RCOL(q));
            const f32x4 h = (v[q] * rinv * g) * (s1 + 1.0f) + s0; hw[q].x = pk2(h.x, h.y); hw[q].y = pk2(h.z, h.w); }
#pragma unroll
        for (int h2 = 0; h2 < 2; ++h2) *(u32x4*)(HN + 8 * lane + 512 * h2) = (u32x4){hw[2 * h2].x, hw[2 * h2].y, hw[2 * h2 + 1].x, hw[2 * h2 + 1].y};
    }
}
__device__ __forceinline__ void rows_update(const Args& a, int gw, int NGW, int lane, bool has_upd, bool xin_from_inputs, const float* gpost, int l_gate, int gate_chunk,
                                            bool write_x, bool has_hn, const float* gpre, int l_mod, int sh_chunk, bool lat_only = false, bool has_upd2 = false, const float* gpost2 = nullptr, int gate_chunk2 = 0) {
    const int NR = lat_only ? NB * SEQ : MROWS;
#define ROWMAP(i) (lat_only ? (((i) >> 12) * TPB + ((i) & 4095)) : (i))
    int Ri = gw; if (Ri >= NR) return;
    int R = ROWMAP(Ri);
    RowIn cur, nxt; row_load(a, R, lane, has_upd, xin_from_inputs, cur, has_upd2);
    nxt = cur; { const int Ri1 = Ri + NGW; if (Ri1 < NR) row_load(a, ROWMAP(Ri1), lane, has_upd, xin_from_inputs, nxt, has_upd2); }
    for (;;) {
        const int Ri2 = Ri + 2 * NGW; RowIn nx2 = nxt;
        if (Ri2 < NR) row_load(a, ROWMAP(Ri2), lane, has_upd, xin_from_inputs, nx2, has_upd2);
        row_compute(a, R, lane, cur, has_upd, gpost, l_gate, gate_chunk, write_x, has_hn, gpre, l_mod, sh_chunk, has_upd2, gpost2, gate_chunk2);
        Ri += NGW; if (Ri >= NR) break;
        R = ROWMAP(Ri); cur = nxt; nxt = nx2;
    }
#undef ROWMAP
}

struct FeatIn { u32x4 w[5]; };
__device__ __forceinline__ void feat_load(const Args& a, int R, int lane, FeatIn& in) {
    const bf16* F = (const bf16*)(a.ws + WS_FEAT) + (size_t)R * DINP; const u32x4 zero4 = (u32x4){0u, 0u, 0u, 0u};
    in.w[0] = *(const u32x4*)(F + C_AQ + 8 * lane);
    in.w[1] = (lane < 32) ? *(const u32x4*)(F + C_AK + 8 * lane) : zero4;
    in.w[2] = (lane < 24) ? *(const u32x4*)(F + C_BQD + 8 * lane) : zero4;
    in.w[3] = (lane < 16) ? *(const u32x4*)(F + C_BKVD + 8 * lane) : zero4;
    in.w[4] = (lane < 4) ? *(const u32x4*)(F + C_BKR + 8 * lane) : zero4;
}
__device__ __forceinline__ void feat_row(const Args& a, int l, int R, int lane, const FeatIn& in) {
    const float* tab = (const float*)(a.ws + WS_TAB); const float* cosA = tab, *sinA = tab + 1024, *cosB = tab + 2048, *sinB = tab + 2560;
    const int j = R % TPB; const bool lat = j < SEQ; const int rowid = j >> 6, colid = j & 63;
    {
        float f[8]; unpack8(in.w[0], f);
        float ss = 0.f;
#pragma unroll
        for (int e = 0; e < 8; ++e) ss += f[e] * f[e];
        ss += __shfl_xor(ss, 1); ss += __shfl_xor(ss, 2); ss += __shfl_xor(ss, 4);
        const float rinv = rsqrtf(ss * (1.0f / 64.0f) + EPS);
        const float* gn = a.in[I_AQN] + l * 64 + 8 * (lane & 7);
#pragma unroll
        for (int e = 0; e < 8; ++e) f[e] = f[e] * rinv * gn[e];
        float pr[8];
#pragma unroll
        for (int e = 0; e < 8; ++e) pr[e] = __shfl_xor(f[e], 4);
        if (lat) {
            const int blk = lane & 3; const int pos = (blk < 2) ? rowid : colid; const float* cp = cosA + pos * 16 + 8 * (blk & 1), *sp = sinA + pos * 16 + 8 * (blk & 1);
            const float sg = ((lane & 7) < 4) ? -1.0f : 1.0f;
#pragma unroll
            for (int e = 0; e < 8; ++e) f[e] = f[e] * cp[e] + sg * pr[e] * sp[e];
        }
#pragma unroll
        for (int e = 0; e < 8; ++e) f[e] *= QSCALE_A;
        *(u32x4*)((bf16*)(a.ws + WS_QA) + (size_t)R * 512 + 8 * lane) = pack8(f);
    }
    {
        float f[8]; const u32x4 w = in.w[1]; unpack8(w, f);
        float ss = 0.f;
#pragma unroll
        for (int e = 0; e < 8; ++e) ss += f[e] * f[e];
        ss += __shfl_xor(ss, 1); ss += __shfl_xor(ss, 2); ss += __shfl_xor(ss, 4);
        const float rinv = rsqrtf(ss * (1.0f / 64.0f) + EPS);
        const float* gn = a.in[I_AKN] + l * 64 + 8 * (lane & 7);
        float g[8];
#pragma unroll
        for (int e = 0; e < 8; ++e) g[e] = f[e] * rinv * gn[e];
        float pr[8];
#pragma unroll
        for (int e = 0; e < 8; ++e) pr[e] = __shfl_xor(g[e], 4);
        if (lat) {
            const int blk = lane & 3; const int pos = (blk < 2) ? rowid : colid; const float* cp = cosA + pos * 16 + 8 * (blk & 1), *sp = sinA + pos * 16 + 8 * (blk & 1);
            const float sg = ((lane & 7) < 4) ? -1.0f : 1.0f;
#pragma unroll
            for (int e = 0; e < 8; ++e) g[e] = g[e] * cp[e] + sg * pr[e] * sp[e];
        }
        if (lane < 16) *(u32x4*)((bf16*)(a.ws + WS_KA) + (size_t)R * 128 + 8 * lane) = pack8(g);
        else if (lane < 32) *(u32x4*)((bf16*)(a.ws + WS_VA) + (size_t)R * 128 + 8 * (lane - 16)) = w;
    }
    {
        float f[8]; unpack8(in.w[2], f);
        float ss = 0.f;
#pragma unroll
        for (int e = 0; e < 8; ++e) ss += f[e] * f[e];
        const float rinv = rsqrtf(wave_sum(ss) * (1.0f / 192.0f) + EPS);
        if (lane < 24) { const float* gn = a.in[I_BQN] + l * 192 + 8 * lane;
#pragma unroll
            for (int e = 0; e < 8; ++e) f[e] = f[e] * rinv * gn[e]; }
        if (lane < 32) *(u32x4*)((bf16*)(a.ws + WS_BQD) + (size_t)R * 256 + 8 * lane) = pack8(f);
    }
    {
        float f[8]; unpack8(in.w[3], f);
        float ss = 0.f;
#pragma unroll
        for (int e = 0; e < 8; ++e) ss += f[e] * f[e];
        const float rinv = rsqrtf(wave_sum(ss) * (1.0f / 128.0f) + EPS);
        if (lane < 16) { const float* gn = a.in[I_BKVN] + l * 128 + 8 * lane;
#pragma unroll
            for (int e = 0; e < 8; ++e) f[e] = f[e] * rinv * gn[e];
            *(u32x4*)((bf16*)(a.ws + WS_BKVD) + (size_t)R * 128 + 8 * lane) = pack8(f); }
    }
    {
        float f[8]; unpack8(in.w[4], f);
        float pr[8];
#pragma unroll
        for (int e = 0; e < 8; ++e) pr[e] = __shfl_xor(f[e], 2);
        if (lat) {
            const int pos = ((lane & 1) == 0) ? rowid : colid; const float* cp = cosB + pos * 8, *sp = sinB + pos * 8;
            const float sg = ((lane & 3) < 2) ? -1.0f : 1.0f;
#pragma unroll
            for (int e = 0; e < 8; ++e) f[e] = f[e] * cp[e] + sg * pr[e] * sp[e];
        }
        if (lane < 4) { const u32x4 o = pack8(f); bf16* kb = (bf16*)(a.ws + WS_KB) + (size_t)R * 384 + 64 + 8 * lane;
#pragma unroll
            for (int h = 0; h < 4; ++h) *(u32x4*)(kb + h * 96) = o; }
    }
}

struct ReadIn { f32x4 of, ob; u32x2 g; };
__device__ __forceinline__ void readout_load(const Args& a, int R, int lane, ReadIn& in) {
    in.of = *(const f32x4*)((const float*)(a.ws + WS_OF) + (size_t)R * 256 + 4 * lane); in.ob = *(const f32x4*)((const float*)(a.ws + WS_OB) + (size_t)R * 256 + 4 * lane);
    in.g = *(const u32x2*)((const bf16*)(a.ws + WS_CFG) + (size_t)R * 256 + 4 * lane);
}
__device__ __forceinline__ void readout_row(const Args& a, int l, int R, int lane, const ReadIn& in) {
    const f32x4 of = in.of, ob = in.ob;
    const f32x4 o = of + ob;
    float ss = o.x * o.x + o.y * o.y + o.z * o.z + o.w * o.w;
    ss += __shfl_xor(ss, 1); ss += __shfl_xor(ss, 2); ss += __shfl_xor(ss, 4); ss += __shfl_xor(ss, 8);
    const float rinv = rsqrtf(ss * (1.0f / 64.0f) + EPS);
    const f32x4 gn = *(const f32x4*)(a.in[I_CON] + l * 64 + 4 * (lane & 15));
    const u32x2 gw = in.g;
    const f32x4 y = o * rinv * gn;
    u32x2 w; w.x = pk2(y.x * siluf_(bf_lo(gw.x)), y.y * siluf_(bf_hi(gw.x))); w.y = pk2(y.z * siluf_(bf_lo(gw.y)), y.w * siluf_(bf_hi(gw.y)));
    *(u32x2*)((bf16*)(a.ws + WS_Y) + (size_t)R * DM + 768 + 4 * lane) = w;
}

typedef float att_f32x2 __attribute__((ext_vector_type(2)));
__device__ __forceinline__ int att_imax(int a, int b) { return a > b ? a : b; }
typedef short att_v4i16 __attribute__((ext_vector_type(4)));
__device__ __forceinline__ s16x4 att_vtr(const LAS unsigned char* p) { return __builtin_bit_cast(s16x4, __builtin_amdgcn_ds_read_tr16_b64_v4i16((LAS att_v4i16*)p)); }
template <int DQ>
__device__ __forceinline__ void attn_unit(LAS unsigned char* lds, const bf16* Q, int qpitch, const bf16* K, int kpitch, const bf16* V, int vpitch, bf16* O, int opitch, int ns, float kmax2 = 0.f) {
    constexpr int KS = DQ * 2 + 16, VS = 144  , NKC = DQ / 8  , NKL = (128 * NKC) / NTHR, KBYTES = 128 * KS, BUF = KBYTES + 128 * VS;
    constexpr float THR = 64.0f;
    int tid_l = threadIdx.x; asm volatile("" : "+v"(tid_l)); const int tid = tid_l, lane = tid & 63, wid = tid >> 6, r32 = lane & 31, hi = lane >> 5;
    bf16x8 qf[DQ / 16];
#pragma unroll
    for (int d0 = 0; d0 < DQ / 16; ++d0) qf[d0] = *(const bf16x8*)(Q + (size_t)(wid * 32 + r32) * qpitch + d0 * 16 + hi * 8);
    f32x16 o0, o1;
#pragma unroll
    for (int r = 0; r < 16; ++r) { o0[r] = 0.f; o1[r] = 0.f; }
    bool mz = true;
    bool safe = false;
    if (DQ == 64 && kmax2 > 0.f) {
        float q2 = 0.f;
#pragma unroll
        for (int d0 = 0; d0 < DQ / 16; ++d0) { const u32x4 w_ = __builtin_bit_cast(u32x4, qf[d0]); float f_[8]; unpack8(w_, f_);
#pragma unroll
            for (int e = 0; e < 8; ++e) q2 += f_[e] * f_[e]; }
        q2 += __shfl_xor(q2, 32);
        safe = __all(q2 * kmax2 <= 3600.0f);
    }
    float mrun = 0.f, lrun = 0.f;
    u32x4 kreg[NKL], vreg[2];
#define ATT_LOAD(t) do { _Pragma("unroll") for (int i_ = 0; i_ < NKL; ++i_) { const int c_ = tid + NTHR * i_; kreg[i_] = *(const u32x4*)(K + (size_t)((t) * 128 + c_ / NKC) * kpitch + (c_ % NKC) * 8); } \
        _Pragma("unroll") for (int j_ = 0; j_ < 2; ++j_) { const int c_ = tid + NTHR * j_; vreg[j_] = *(const u32x4*)(V + (size_t)((t) * 128 + (c_ >> 3)) * vpitch + (c_ & 7) * 8); } } while (0)
#define ATT_PUT(buf) do { LAS unsigned char* kb_ = lds + (buf) * BUF; \
        _Pragma("unroll") for (int i_ = 0; i_ < NKL; ++i_) { const int c_ = tid + NTHR * i_; *(LAS u32x4*)(kb_ + (c_ / NKC) * KS + (c_ % NKC) * 16) = kreg[i_]; } \
        _Pragma("unroll") for (int j_ = 0; j_ < 2; ++j_) { const int c_ = tid + NTHR * j_; *(LAS u32x4*)(kb_ + KBYTES + (c_ >> 3) * VS + (c_ & 7) * 16) = vreg[j_]; } } while (0)
    ATT_LOAD(0);
    ATT_PUT(0);
    if (ns > 1) ATT_LOAD(1);
    __syncthreads();
    for (int t = 0; t < ns; ++t) {
        if (t + 1 < ns) { ATT_PUT((t + 1) & 1); if (t + 2 < ns) ATT_LOAD(t + 2); }
        const LAS unsigned char* Ks = lds + (t & 1) * BUF; const LAS unsigned char* Vt = Ks + KBYTES;
        constexpr int ND = DQ / 16;
#define ATT_KRD(SUB, KF) do { _Pragma("unroll") for (int d0 = 0; d0 < ND; ++d0) { KF[2 * d0] = *(const LAS bf16x8*)(Ks + (64 * (SUB) + r32) * KS + d0 * 32 + hi * 16); KF[2 * d0 + 1] = *(const LAS bf16x8*)(Ks + (64 * (SUB) + 32 + r32) * KS + d0 * 32 + hi * 16); } } while (0)
#define ATT_VRD(SUB, VF) do { const LAS unsigned char* vl_ = Vt + ((((lane & 15) >> 2) + 4 * hi) * VS + (16 * ((lane >> 4) & 1) + 4 * (lane & 3)) * 2); \
            _Pragma("unroll") for (int ks = 0; ks < 4; ++ks) { const LAS unsigned char* vr_ = vl_ + (64 * (SUB) + 16 * ks) * VS; \
            VF[4 * ks + 0] = att_vtr(vr_); VF[4 * ks + 1] = att_vtr(vr_ + 8 * VS); VF[4 * ks + 2] = att_vtr(vr_ + 64); VF[4 * ks + 3] = att_vtr(vr_ + 8 * VS + 64); } } while (0)
#define ATT_QK(KF, S0, S1) do { _Pragma("unroll") for (int d0 = 0; d0 < ND; ++d0) { \
            if (d0 == 0) { if (mz) { const f32x16 z_ = {0.f, 0.f, 0.f, 0.f, 0.f, 0.f, 0.f, 0.f, 0.f, 0.f, 0.f, 0.f, 0.f, 0.f, 0.f, 0.f}; \
                    S0 = __builtin_amdgcn_mfma_f32_32x32x16_bf16(KF[0], qf[0], z_, 0, 0, 0); S1 = __builtin_amdgcn_mfma_f32_32x32x16_bf16(KF[1], qf[0], z_, 0, 0, 0); } \
                else { f32x16 nm_; _Pragma("unroll") for (int r = 0; r < 16; ++r) nm_[r] = -mrun; \
                    S0 = __builtin_amdgcn_mfma_f32_32x32x16_bf16(KF[0], qf[0], nm_, 0, 0, 0); S1 = __builtin_amdgcn_mfma_f32_32x32x16_bf16(KF[1], qf[0], nm_, 0, 0, 0); } } \
            else { S0 = __builtin_amdgcn_mfma_f32_32x32x16_bf16(KF[2 * d0], qf[d0], S0, 0, 0, 0); S1 = __builtin_amdgcn_mfma_f32_32x32x16_bf16(KF[2 * d0 + 1], qf[d0], S1, 0, 0, 0); } } } while (0)
#define ATT_MAX(S0, S1, RM) do { float a_ = fmaxf(fmaxf(S0[0], S0[1]), S1[0]), b_ = fmaxf(fmaxf(S0[2], S0[3]), S1[1]); a_ = fmaxf(fmaxf(a_, S1[2]), S1[3]); \
            _Pragma("unroll") for (int r = 4; r < 16; r += 4) { a_ = fmaxf(fmaxf(a_, S0[r]), S0[r + 1]); b_ = fmaxf(fmaxf(b_, S0[r + 2]), S0[r + 3]); a_ = fmaxf(fmaxf(a_, S1[r]), S1[r + 1]); b_ = fmaxf(fmaxf(b_, S1[r + 2]), S1[r + 3]); } \
            RM = fmaxf(a_, b_); auto rr_ = __builtin_amdgcn_permlane32_swap(__float_as_uint(RM), __float_as_uint(RM), false, false); RM = fmaxf(__uint_as_float(rr_[0]), __uint_as_float(rr_[1])); } while (0)
#define ATT_IMAX3(a, b, c) att_imax(att_imax((a), (b)), (c))
#define ATT_SCREEN(S0, S1, HOT) do { int a_ = ATT_IMAX3(__float_as_int(S0[0]), __float_as_int(S0[1]), __float_as_int(S1[0])), b_ = ATT_IMAX3(__float_as_int(S0[2]), __float_as_int(S0[3]), __float_as_int(S1[1])); \
            a_ = ATT_IMAX3(a_, __float_as_int(S1[2]), __float_as_int(S1[3])); \
            _Pragma("unroll") for (int r = 4; r < 16; r += 4) { a_ = ATT_IMAX3(a_, __float_as_int(S0[r]), __float_as_int(S0[r + 1])); b_ = ATT_IMAX3(b_, __float_as_int(S0[r + 2]), __float_as_int(S0[r + 3])); \
                a_ = ATT_IMAX3(a_, __float_as_int(S1[r]), __float_as_int(S1[r + 1])); b_ = ATT_IMAX3(b_, __float_as_int(S1[r + 2]), __float_as_int(S1[r + 3])); } \
            HOT = __any(att_imax(a_, b_) > 0x42800000); } while (0)
#define ATT_RESC(FIRST, S0, S1, RM) do { if ((FIRST) ? __any(fabsf(RM) > THR) : __any(RM > THR)) { const float dl_ = (FIRST) ? RM : fmaxf(RM, 0.f); mrun += dl_; mz = false; \
            _Pragma("unroll") for (int r = 0; r < 16; ++r) { S0[r] -= dl_; S1[r] -= dl_; } \
            if (!(FIRST)) { const float f_ = __builtin_amdgcn_exp2f(-dl_); lrun *= f_; _Pragma("unroll") for (int r = 0; r < 16; ++r) { o0[r] *= f_; o1[r] *= f_; } } } } while (0)
#define ATT_EXP(S0, S1, PB) do { _Pragma("unroll") for (int r = 0; r < 16; ++r) { S0[r] = __builtin_amdgcn_exp2f(S0[r]); S1[r] = __builtin_amdgcn_exp2f(S1[r]); } \
            { att_f32x2 pa_ = (att_f32x2){S0[0], S0[1]} + (att_f32x2){S1[0], S1[1]}, pb_ = (att_f32x2){S0[2], S0[3]} + (att_f32x2){S1[2], S1[3]}; \
              _Pragma("unroll") for (int r = 4; r < 16; r += 4) { pa_ += (att_f32x2){S0[r], S0[r + 1]}; pb_ += (att_f32x2){S0[r + 2], S0[r + 3]}; pa_ += (att_f32x2){S1[r], S1[r + 1]}; pb_ += (att_f32x2){S1[r + 2], S1[r + 3]}; } \
              pa_ += pb_; lrun += pa_.x + pa_.y; } \
            _Pragma("unroll") for (int ks = 0; ks < 4; ++ks) { u32x4 w_; const int b_ = 8 * (ks & 1); \
                if (ks < 2) { w_.x = pk2(S0[b_ + 0], S0[b_ + 1]); w_.y = pk2(S0[b_ + 2], S0[b_ + 3]); w_.z = pk2(S0[b_ + 4], S0[b_ + 5]); w_.w = pk2(S0[b_ + 6], S0[b_ + 7]); } \
                else { w_.x = pk2(S1[b_ + 0], S1[b_ + 1]); w_.y = pk2(S1[b_ + 2], S1[b_ + 3]); w_.z = pk2(S1[b_ + 4], S1[b_ + 5]); w_.w = pk2(S1[b_ + 6], S1[b_ + 7]); } \
                PB[ks] = __builtin_bit_cast(bf16x8, w_); } } while (0)
#define ATT_PV(VF, PB) do { _Pragma("unroll") for (int ks = 0; ks < 4; ++ks) { \
            const s16x4 a0_ = VF[4 * ks + 0], a1_ = VF[4 * ks + 1], c0_ = VF[4 * ks + 2], c1_ = VF[4 * ks + 3]; \
            const bf16x8 va_ = (bf16x8){a0_[0], a0_[1], a0_[2], a0_[3], a1_[0], a1_[1], a1_[2], a1_[3]}, vc_ = (bf16x8){c0_[0], c0_[1], c0_[2], c0_[3], c1_[0], c1_[1], c1_[2], c1_[3]}; \
            o0 = __builtin_amdgcn_mfma_f32_32x32x16_bf16(va_, PB[ks], o0, 0, 0, 0); o1 = __builtin_amdgcn_mfma_f32_32x32x16_bf16(vc_, PB[ks], o1, 0, 0, 0); } } while (0)
#define ATT_SB() __builtin_amdgcn_sched_barrier(0)
        f32x16 s0, s1; bf16x8 kf[2 * ND], pb[4]; s16x4 vf[16]; float rm;
        ATT_KRD(0, kf); ATT_SB();
        ATT_QK(kf, s0, s1); ATT_SB();
        ATT_VRD(0, vf); ATT_SB();
        if (DQ != 64 || t == 0) { ATT_MAX(s0, s1, rm); ATT_RESC(t == 0, s0, s1, rm); }
        else if (!safe) { bool hot_; ATT_SCREEN(s0, s1, hot_); if (hot_) { ATT_MAX(s0, s1, rm); ATT_RESC(false, s0, s1, rm); } }
        ATT_EXP(s0, s1, pb);
        ATT_PV(vf, pb); ATT_SB();
        ATT_KRD(1, kf); ATT_SB();
        ATT_QK(kf, s0, s1); ATT_SB();
        ATT_VRD(1, vf); ATT_SB();
        if (DQ != 64) { ATT_MAX(s0, s1, rm); ATT_RESC(false, s0, s1, rm); }
        else if (!safe) { bool hot_; ATT_SCREEN(s0, s1, hot_); if (hot_) { ATT_MAX(s0, s1, rm); ATT_RESC(false, s0, s1, rm); } }
        ATT_EXP(s0, s1, pb);
        ATT_PV(vf, pb);
#undef ATT_KRD
#undef ATT_VRD
#undef ATT_QK
#undef ATT_MAX
#undef ATT_RESC
#undef ATT_SCREEN
#undef ATT_IMAX3
#undef ATT_EXP
#undef ATT_PV
#undef ATT_SB
        __syncthreads();
    }
#undef ATT_LOAD
#undef ATT_PUT
    lrun += __shfl_xor(lrun, 32);
    const float linv = 1.0f / lrun;
    bf16* orow = O + (size_t)(wid * 32 + r32) * opitch;
#pragma unroll
    for (int r4 = 0; r4 < 4; ++r4) {
        u32x2 w0, w1;
        w0.x = pk2(o0[4 * r4 + 0] * linv, o0[4 * r4 + 1] * linv); w0.y = pk2(o0[4 * r4 + 2] * linv, o0[4 * r4 + 3] * linv);
        w1.x = pk2(o1[4 * r4 + 0] * linv, o1[4 * r4 + 1] * linv); w1.y = pk2(o1[4 * r4 + 2] * linv, o1[4 * r4 + 3] * linv);
        *(u32x2*)(orow + 8 * r4 + 4 * hi) = w0; *(u32x2*)(orow + 32 + 8 * r4 + 4 * hi) = w1;
    }
}

typedef float f32x2 __attribute__((ext_vector_type(2)));
__device__ __forceinline__ float dpp_xor1(float v) { return __int_as_float(__builtin_amdgcn_update_dpp(0, __float_as_int(v), 0xB1, 0xF, 0xF, true)); }
__device__ __forceinline__ float dpp_xor2(float v) { return __int_as_float(__builtin_amdgcn_update_dpp(0, __float_as_int(v), 0x4E, 0xF, 0xF, true)); }
__device__ __forceinline__ float dpp_hmir(float v) { return __int_as_float(__builtin_amdgcn_update_dpp(0, __float_as_int(v), 0x141, 0xF, 0xF, true)); }
__device__ __forceinline__ void scan_unit(LAS unsigned char* lds, const Args& a, int l, int b, int h) {
    int tid_l = threadIdx.x; asm volatile("" : "+v"(tid_l)); const int tid = tid_l, lane = tid & 63, wid = tid >> 6, dvl = lane >> 3, dkg = lane & 7;
    const int cw = __builtin_amdgcn_readfirstlane(wid); const int dir = (cw >> 1) & 1, wq = cw & 1;
    LAS float* myq = (LAS float*)(lds + dir * 65536); LAS float* myk = myq + 4096; LAS float* myv = myk + 4096; LAS float* myo = myv + 4096;
    const bf16* CQ = (const bf16*)(a.ws + WS_CFQ); const bf16* CKF = (const bf16*)(a.ws + WS_CKF); const bf16* CKB = (const bf16*)(a.ws + WS_CKB); const bf16* CV = (const bf16*)(a.ws + WS_CFV);
    float* OF = (float*)(a.ws + WS_OF); float* OB = (float*)(a.ws + WS_OB);
    const int rb = b * TPB, col = h * 64;
    f32x2 S[16];
#pragma unroll
    for (int e = 0; e < 16; ++e) S[e] = (f32x2){0.f, 0.f};
    const int li = tid >> 3, lc = tid & 7;
    u32x4 rq0, rk0, rv0, rq1, rk1, rv1;
#define SCAN_FB(c) (((c) < 4) ? (SEQ + 64 * (c)) : 64 * ((c) - 4))
#define SCAN_BB(c) (((c) < 4) ? (TPB - 1 - 64 * (c)) : (SEQ - 1 - 64 * ((c) - 4)))
#define SCAN_LOAD(c) do { const size_t rf_ = (size_t)(rb + SCAN_FB(c) + li) * 256 + col + 8 * lc, rb_ = (size_t)(rb + SCAN_BB(c) - li) * 256 + col + 8 * lc; \
        rq0 = *(const u32x4*)(CQ + rf_); rk0 = *(const u32x4*)(CKF + rf_); rv0 = *(const u32x4*)(CV + rf_); rq1 = *(const u32x4*)(CQ + rb_); rk1 = *(const u32x4*)(CKB + rb_); rv1 = *(const u32x4*)(CV + rb_); } while (0)
#define SCAN_PUT(base, w) do { float f_[8]; unpack8(w, f_); *(LAS f32x4*)((base) + li * 64 + 8 * lc) = (f32x4){f_[0], f_[1], f_[2], f_[3]}; *(LAS f32x4*)((base) + li * 64 + 8 * lc + 4) = (f32x4){f_[4], f_[5], f_[6], f_[7]}; } while (0)
#define SCAN_FLUSH(c) do { LAS float* o0_ = (LAS float*)(lds + 49152) + li * 64 + 8 * lc; LAS float* o1_ = (LAS float*)(lds + 65536 + 49152) + li * 64 + 8 * lc; \
        float* pf_ = OF + (size_t)(rb + SCAN_FB(c) + li) * 256 + col + 8 * lc; float* pb_ = OB + (size_t)(rb + SCAN_BB(c) - li) * 256 + col + 8 * lc; \
        *(f32x4*)pf_ = *(const LAS f32x4*)o0_; *(f32x4*)(pf_ + 4) = *(const LAS f32x4*)(o0_ + 4); *(f32x4*)pb_ = *(const LAS f32x4*)o1_; *(f32x4*)(pb_ + 4) = *(const LAS f32x4*)(o1_ + 4); } while (0)
    SCAN_LOAD(0);
    for (int c = 0; c < 68; ++c) {
        __syncthreads();
        if (c > 0) SCAN_FLUSH(c - 1);
        { LAS float* q0_ = (LAS float*)lds; LAS float* q1_ = (LAS float*)(lds + 65536);
          SCAN_PUT(q0_, rq0); SCAN_PUT(q0_ + 4096, rk0); SCAN_PUT(q0_ + 8192, rv0); SCAN_PUT(q1_, rq1); SCAN_PUT(q1_ + 4096, rk1); SCAN_PUT(q1_ + 8192, rv1); }
        __syncthreads();
        if (c + 1 < 68) SCAN_LOAD(c + 1);
        if (cw < 4) {
        f32x4 q0 = *(const LAS f32x4*)(myq + 8 * dkg), q1 = *(const LAS f32x4*)(myq + 8 * dkg + 4);
        f32x4 k0 = *(const LAS f32x4*)(myk + 8 * dkg), k1 = *(const LAS f32x4*)(myk + 8 * dkg + 4);
        f32x4 vv = *(const LAS f32x4*)(myv + 32 * wq + 4 * dvl);
        const bool lb0 = (lane & 1) != 0, lb1 = (lane & 2) != 0, lb2 = (lane & 4) != 0;
        for (int i0 = 0; i0 < 64; i0 += 4) {
            float val[4][4];
#pragma unroll
            for (int j = 0; j < 4; ++j) {
                const int in_ = (i0 + j + 1) & 63;
                const f32x4 nq0 = *(const LAS f32x4*)(myq + in_ * 64 + 8 * dkg), nq1 = *(const LAS f32x4*)(myq + in_ * 64 + 8 * dkg + 4);
                const f32x4 nk0 = *(const LAS f32x4*)(myk + in_ * 64 + 8 * dkg), nk1 = *(const LAS f32x4*)(myk + in_ * 64 + 8 * dkg + 4);
                const f32x4 nvv = *(const LAS f32x4*)(myv + in_ * 64 + 32 * wq + 4 * dvl);
                const f32x2 va = (f32x2){vv.x, vv.y}, vb = (f32x2){vv.z, vv.w};
                f32x2 acca = (f32x2){0.f, 0.f}, accb = acca;
#pragma unroll
                for (int e = 0; e < 4; ++e) {
                    const f32x2 kk0 = (f32x2){k0[e], k0[e]}, qq0 = (f32x2){q0[e], q0[e]}, kk1 = (f32x2){k1[e], k1[e]}, qq1 = (f32x2){q1[e], q1[e]};
                    S[e] = kk0 * (va - S[e]) + S[e];             acca = S[e] * qq0 + acca;
                    S[8 + e] = kk0 * (vb - S[8 + e]) + S[8 + e];   accb = S[8 + e] * qq0 + accb;
                    S[4 + e] = kk1 * (va - S[4 + e]) + S[4 + e];   acca = S[4 + e] * qq1 + acca;
                    S[12 + e] = kk1 * (vb - S[12 + e]) + S[12 + e]; accb = S[12 + e] * qq1 + accb;
                }
                val[j][0] = acca.x; val[j][1] = acca.y; val[j][2] = accb.x; val[j][3] = accb.y;
                q0 = nq0; q1 = nq1; k0 = nk0; k1 = nk1; vv = nvv;
            }
            float r1[8];
#pragma unroll
            for (int jl = 0; jl < 2; ++jl)
#pragma unroll
                for (int c = 0; c < 4; ++c) { const float lo = val[jl][c], hi = val[2 + jl][c]; const float keep = lb0 ? hi : lo, send = lb0 ? lo : hi; r1[jl * 4 + c] = keep + dpp_xor1(send); }
            float r2[4];
#pragma unroll
            for (int c = 0; c < 4; ++c) { const float lo = r1[c], hi = r1[4 + c]; const float keep = lb1 ? hi : lo, send = lb1 ? lo : hi; r2[c] = keep + dpp_xor2(send); }
            f32x2 r3;
            { const float k0_ = lb2 ? r2[2] : r2[0], s0_ = lb2 ? r2[0] : r2[2], k1_ = lb2 ? r2[3] : r2[1], s1_ = lb2 ? r2[1] : r2[3];
              r3.x = k0_ + __shfl_xor(s0_, 4); r3.y = k1_ + __shfl_xor(s1_, 4); }
            *(LAS f32x2*)(myo + (i0 + 2 * (lane & 1) + ((lane >> 1) & 1)) * 64 + 32 * wq + 4 * dvl + 2 * ((lane >> 2) & 1)) = r3;
        }
        }
    }
    __syncthreads();
    SCAN_FLUSH(67);
    __threadfence();
    __syncthreads();
    {
        const int rl = tid >> 4, c4 = (tid & 15) * 4;
        const f32x4 gn = *(const f32x4*)(a.in[I_CON] + l * 64 + c4);
        const bf16* CG = (const bf16*)(a.ws + WS_CFG); bf16* Y = (bf16*)(a.ws + WS_Y);
        for (int r0 = 0; r0 < TPB; r0 += 128) {
            f32x4 of[4], ob4[4]; u32x2 gw4[4];
#pragma unroll
            for (int p = 0; p < 4; ++p) { const size_t ro = (size_t)(rb + r0 + 32 * p + rl) * 256 + col + c4; of[p] = *(const f32x4*)(OF + ro); ob4[p] = *(const f32x4*)(OB + ro); gw4[p] = *(const u32x2*)(CG + ro); }
#pragma unroll
            for (int p = 0; p < 4; ++p) {
                const f32x4 o = of[p] + ob4[p];
                float ss = o.x * o.x + o.y * o.y + o.z * o.z + o.w * o.w;
                ss += __shfl_xor(ss, 1); ss += __shfl_xor(ss, 2); ss += __shfl_xor(ss, 4); ss += __shfl_xor(ss, 8);
                const float rinv = rsqrtf(ss * (1.0f / 64.0f) + EPS);
                const f32x4 y = o * rinv * gn; const u32x2 g2 = gw4[p];
                u32x2 w; w.x = pk2(y.x * siluf_(bf_lo(g2.x)), y.y * siluf_(bf_hi(g2.x))); w.y = pk2(y.z * siluf_(bf_lo(g2.y)), y.w * siluf_(bf_hi(g2.y)));
                *(u32x2*)(Y + (size_t)(rb + r0 + 32 * p + rl) * DM + 768 + col + c4) = w;
            }
        }
    }
    __syncthreads();
#undef SCAN_FB
#undef SCAN_BB
#undef SCAN_LOAD
#undef SCAN_PUT
#undef SCAN_FLUSH
}

template <class Epi>
__device__ __forceinline__ void run_gemm(LAS unsigned char* lds, const pg8::Gemm& g, const Epi& E, int G, bool lat_only) {
    if (lat_only) { pg8::LatOrder S; S.init(g.N, G, (int)blockIdx.x); pg8::gemm_phase<Epi, pg8::LatOrder, true, true>(lds, g, S, E); }
    else { pg8::StaticOrder S; S.init(g.M, g.N, G, (int)blockIdx.x); pg8::gemm_phase<Epi, pg8::StaticOrder, true, true>(lds, g, S, E); }
}
struct EpiFeat2 {
    static constexpr bool PERM = true, AFTER_DRAIN = false;
    unsigned char* ws; const float* aqn; const float* akn; const float* clb; int layer;
    __device__ __forceinline__ void operator()(const f32x4 (&acc)[2][2][4][2], const pg8::Unit& u, int wr, int wc, int fr, int fq) const {
        const int row0 = u.pm * 256 + wr * 64 + fr, pn = u.pn;
        const float* tab = (const float*)(ws + WS_TAB);
        if (pn <= 2) {
            const bool is_v = (pn == 2 && wc >= 2);
            const float* gain = (pn < 2) ? aqn : akn;
            f32x4 g[2][2];
#pragma unroll
            for (int bj = 0; bj < 2; ++bj)
#pragma unroll
                for (int n = 0; n < 2; ++n) g[bj][n] = *(const f32x4*)(gain + 32 * bj + 8 * fq + 4 * n);
            bf16* dst; int ld;
            if (pn < 2) { dst = (bf16*)(ws + WS_QA) + (4 * pn + wc) * 64; ld = 512; } else if (wc < 2) { dst = (bf16*)(ws + WS_KA) + wc * 64; ld = 128; } else { dst = (bf16*)(ws + WS_VA) + (wc - 2) * 64; ld = 128; }
            const float osc = (pn < 2) ? QSCALE_A : 1.0f;
#pragma unroll
            for (int ai = 0; ai < 2; ++ai)
#pragma unroll
                for (int mm = 0; mm < 4; ++mm) {
                    const int row = row0 + ai * 128 + mm * 16; const int j = row % TPB;
                    f32x4 x[2][2];
#pragma unroll
                    for (int bj = 0; bj < 2; ++bj)
#pragma unroll
                        for (int n = 0; n < 2; ++n) x[bj][n] = acc[ai][bj][mm][n];
                    if (!is_v) {
                        float ss = 0.f;
#pragma unroll
                        for (int bj = 0; bj < 2; ++bj)
#pragma unroll
                            for (int n = 0; n < 2; ++n) ss += x[bj][n].x * x[bj][n].x + x[bj][n].y * x[bj][n].y + x[bj][n].z * x[bj][n].z + x[bj][n].w * x[bj][n].w;
                        ss += __shfl_xor(ss, 16); ss += __shfl_xor(ss, 32);
                        const float rinv = rsqrtf(ss * (1.0f / 64.0f) + EPS);
#pragma unroll
                        for (int bj = 0; bj < 2; ++bj)
#pragma unroll
                            for (int n = 0; n < 2; ++n) x[bj][n] = x[bj][n] * rinv * g[bj][n];
                        if (j < SEQ) {
                            const int pos = (fq < 2) ? (j >> 6) : (j & 63);
#pragma unroll
                            for (int n = 0; n < 2; ++n) { const f32x4 cs = *(const f32x4*)(tab + pos * 16 + 8 * (fq & 1) + 4 * n), sn = *(const f32x4*)(tab + 1024 + pos * 16 + 8 * (fq & 1) + 4 * n);
                                const f32x4 a_ = x[0][n] * cs - x[1][n] * sn, b_ = x[1][n] * cs + x[0][n] * sn; x[0][n] = a_; x[1][n] = b_; }
                        }
#pragma unroll
                        for (int bj = 0; bj < 2; ++bj)
#pragma unroll
                            for (int n = 0; n < 2; ++n) x[bj][n] = x[bj][n] * osc;
                    }
#pragma unroll
                    for (int bj = 0; bj < 2; ++bj) { u32x4 w; w.x = pk2(x[bj][0].x, x[bj][0].y); w.y = pk2(x[bj][0].z, x[bj][0].w); w.z = pk2(x[bj][1].x, x[bj][1].y); w.w = pk2(x[bj][1].z, x[bj][1].w);
                        *(u32x4*)(dst + (size_t)row * ld + 32 * bj + 8 * fq) = w; }
                    asm volatile("" ::: "memory");
                }
            return;
        }
#pragma unroll
        for (int bj = 0; bj < 2; ++bj) {
            const int c0 = pn * 256 + bj * 128 + wc * 32 + 8 * fq;
            if (c0 >= 2400) continue;
            if (c0 < 1088) {
                const bool isq = c0 < 960; const int dd = isq ? (c0 - 768) : (c0 - 960);
                bf16* dst = isq ? ((bf16*)(ws + WS_BQD) + dd) : ((bf16*)(ws + WS_BKVD) + dd); const int ld = isq ? 256 : 128;
                float* ssq = isq ? (float*)(ws + WS_SSQ_Q) : (float*)(ws + WS_SSQ_KV);
                const int grp = dd >> 5;
#pragma unroll
                for (int ai = 0; ai < 2; ++ai)
#pragma unroll
                    for (int mm = 0; mm < 4; ++mm) {
                        const int row = row0 + ai * 128 + mm * 16;
                        const f32x4 v0 = acc[ai][bj][mm][0], v1 = acc[ai][bj][mm][1];
                        float ss = v0.x * v0.x + v0.y * v0.y + v0.z * v0.z + v0.w * v0.w + v1.x * v1.x + v1.y * v1.y + v1.z * v1.z + v1.w * v1.w;
                        ss += __shfl_xor(ss, 16); ss += __shfl_xor(ss, 32);
                        if (fq == 0) ssq[(size_t)row * (isq ? 8 : 4) + grp] = ss;
                        u32x4 w; w.x = pk2(v0.x, v0.y); w.y = pk2(v0.z, v0.w); w.z = pk2(v1.x, v1.y); w.w = pk2(v1.z, v1.w);
                        *(u32x4*)(dst + (size_t)row * ld) = w;
                        if (!isq && grp < 2) *(u32x4*)((bf16*)(ws + WS_BQD) + (size_t)row * 256 + 192 + dd) = (u32x4){0u, 0u, 0u, 0u};
                    }
                continue;
            }
            if (c0 < 1120) {
                const float* cosB = tab + 2048; const float* sinB = tab + 2560;
#pragma unroll
                for (int ai = 0; ai < 2; ++ai)
#pragma unroll
                    for (int mm = 0; mm < 4; ++mm) {
                        const int row = row0 + ai * 128 + mm * 16; const int j = row % TPB;
                        f32x4 v0 = acc[ai][bj][mm][0], v1 = acc[ai][bj][mm][1];
                        f32x4 p0, p1;
#pragma unroll
                        for (int e = 0; e < 4; ++e) { p0[e] = __shfl_xor(v0[e], 32); p1[e] = __shfl_xor(v1[e], 32); }
                        if (j < SEQ) {
                            const int pos = ((fq & 1) == 0) ? (j >> 6) : (j & 63);
                            const f32x4 c0v = *(const f32x4*)(cosB + pos * 8), c1v = *(const f32x4*)(cosB + pos * 8 + 4), s0v = *(const f32x4*)(sinB + pos * 8), s1v = *(const f32x4*)(sinB + pos * 8 + 4);
                            const float sg = (fq < 2) ? -1.0f : 1.0f;
                            v0 = v0 * c0v + p0 * s0v * sg; v1 = v1 * c1v + p1 * s1v * sg;
                        }
                        u32x4 w; w.x = pk2(v0.x, v0.y); w.y = pk2(v0.z, v0.w); w.z = pk2(v1.x, v1.y); w.w = pk2(v1.z, v1.w);
                        bf16* kb = (bf16*)(ws + WS_KB) + (size_t)row * 384 + 64 + 8 * fq;
#pragma unroll
                        for (int h = 0; h < 4; ++h) *(u32x4*)(kb + h * 96) = w;
                    }
                continue;
            }
            const int seg = (c0 - 1120) >> 8; const int ch = (c0 - 1120) & 255;
            float om[8];
#pragma unroll
            for (int e = 0; e < 8; ++e) om[e] = 1.0f;
            if (layer > 0 && (seg == 1 || seg == 2)) {
                const float* c1 = clb + 512 + (seg - 1) * 256 + ch; const float* c0p = clb + (seg - 1) * 256 + ch;
#pragma unroll
                for (int e = 0; e < 8; ++e) om[e] = 1.0f - 1.0f / (1.0f + __expf(-(c1[e] - c0p[e])));
            }
            bf16* dst = (bf16*)(ws + (seg == 0 ? WS_CFQ : seg == 1 ? WS_CKF : seg == 2 ? WS_CKB : seg == 3 ? WS_CFV : WS_CFG)) + ch;
#pragma unroll
            for (int ai = 0; ai < 2; ++ai)
#pragma unroll
                for (int mm = 0; mm < 4; ++mm) {
                    const int row = row0 + ai * 128 + mm * 16;
                    f32x4 v0 = acc[ai][bj][mm][0], v1 = acc[ai][bj][mm][1];
                    if (seg == 0) {
#pragma unroll
                        for (int e = 0; e < 4; ++e) { v0[e] = v0[e] / (1.0f + __expf(-v0[e])); v1[e] = v1[e] / (1.0f + __expf(-v1[e])); }
                    } else if (seg == 1 || seg == 2) {
#pragma unroll
                        for (int e = 0; e < 4; ++e) { v0[e] = om[e] / (1.0f + __expf(v0[e])); v1[e] = om[4 + e] / (1.0f + __expf(v1[e])); }
                    }
                    u32x4 w; w.x = pk2(v0.x, v0.y); w.y = pk2(v0.z, v0.w); w.z = pk2(v1.x, v1.y); w.w = pk2(v1.z, v1.w);
                    *(u32x4*)(dst + (size_t)row * 256) = w;
                }
        }
    }
};
struct EpiQup2 {
    static constexpr bool PERM = false, AFTER_DRAIN = false;
    unsigned char* ws;
    __device__ __forceinline__ void operator()(const f32x4 (&acc)[2][2][4][2], const pg8::Unit& u, int wr, int wc, int fr, int fq) const {
        const int row0 = u.pm * 256 + wr * 64 + fr; const float* tab = (const float*)(ws + WS_TAB); const float* cosB = tab + 2048; const float* sinB = tab + 2560;
        const float* ssq = (const float*)(ws + WS_SSQ_Q); bf16* O = (bf16*)(ws + WS_QB);
#pragma unroll
        for (int bj = 0; bj < 2; ++bj) {
            const int cg_ = u.pn * 256 + bj * 128 + wc * 32;
            if (cg_ >= 384) continue;
            const bool pe = ((cg_ >> 5) % 3) == 2;
#pragma unroll
            for (int ai = 0; ai < 2; ++ai)
#pragma unroll
                for (int mm = 0; mm < 4; ++mm) {
                    const int row = row0 + ai * 128 + mm * 16; const int j = row % TPB;
                    const f32x4 sa = *(const f32x4*)(ssq + (size_t)row * 8), sb = *(const f32x4*)(ssq + (size_t)row * 8 + 4);
                    const float sc = QSCALE_B * rsqrtf((sa.x + sa.y + sa.z + sa.w + sb.x + sb.y) * (1.0f / 192.0f) + EPS);
                    f32x4 v0 = acc[ai][bj][mm][0], v1 = acc[ai][bj][mm][1];
                    if (pe && j < SEQ) {
                        const int pos = (fq < 2) ? (j >> 6) : (j & 63);
                        const f32x4 cs = *(const f32x4*)(cosB + pos * 8 + 4 * (fq & 1)), sn = *(const f32x4*)(sinB + pos * 8 + 4 * (fq & 1));
                        const f32x4 a_ = v0 * cs - v1 * sn, b_ = v1 * cs + v0 * sn; v0 = a_; v1 = b_;
                    }
                    v0 = v0 * sc; v1 = v1 * sc;
                    bf16* p = O + (size_t)row * 384 + cg_ + 4 * fq;
                    u32x2 w0, w1; w0.x = pk2(v0.x, v0.y); w0.y = pk2(v0.z, v0.w); w1.x = pk2(v1.x, v1.y); w1.y = pk2(v1.z, v1.w);
                    *(u32x2*)p = w0; *(u32x2*)(p + 16) = w1;
                    asm volatile("" ::: "memory");
                }
        }
    }
};
struct EpiKVup2 {
    static constexpr bool PERM = true, AFTER_DRAIN = false;
    unsigned char* ws;
    __device__ __forceinline__ void operator()(const f32x4 (&acc)[2][2][4][2], const pg8::Unit& u, int wr, int wc, int fr, int fq) const {
        const int row0 = u.pm * 256 + wr * 64 + fr; const float* ssq = (const float*)(ws + WS_SSQ_KV);
        bf16* KB = (bf16*)(ws + WS_KB); bf16* VB = (bf16*)(ws + WS_VB);
#pragma unroll
        for (int bj = 0; bj < 2; ++bj) {
            const int head = u.pn * 2 + bj; const int within = wc * 32 + 8 * fq;
#pragma unroll
            for (int ai = 0; ai < 2; ++ai)
#pragma unroll
                for (int mm = 0; mm < 4; ++mm) {
                    const int row = row0 + ai * 128 + mm * 16;
                    const f32x4 sa = *(const f32x4*)(ssq + (size_t)row * 4);
                    const float sc = rsqrtf((sa.x + sa.y + sa.z + sa.w) * (1.0f / 128.0f) + EPS);
                    const f32x4 v0 = acc[ai][bj][mm][0] * sc, v1 = acc[ai][bj][mm][1] * sc;
                    u32x4 w; w.x = pk2(v0.x, v0.y); w.y = pk2(v0.z, v0.w); w.z = pk2(v1.x, v1.y); w.w = pk2(v1.z, v1.w);
                    bf16* p = (within < 64) ? (KB + (size_t)row * 384 + head * 96 + within) : (VB + (size_t)row * 256 + head * 64 + (within - 64));
                    *(u32x4*)p = w;
                    asm volatile("" ::: "memory");
                }
        }
    }
};
__device__ __forceinline__ void mixer_phase(const Args& a, LAS unsigned char* lds, int l, unsigned char* wb, int G, int cidx = 0, int ustart = 0) {
    volatile LAS unsigned* misc = (volatile LAS unsigned*)(lds + LDS_MISC);
    unsigned* ctr = (unsigned*)(a.ws + WS_CTL) + 8 * l + cidx;
    const int n_units = 64 + 1024 + 2048 + ((l + 1 < DEPTH) ? 192 : 0);
    const bf16* QA = (const bf16*)(a.ws + WS_QA); const bf16* KA = (const bf16*)(a.ws + WS_KA); const bf16* VA = (const bf16*)(a.ws + WS_VA);
    const bf16* QB = (const bf16*)(a.ws + WS_QB); const bf16* KB = (const bf16*)(a.ws + WS_KB); const bf16* VB = (const bf16*)(a.ws + WS_VB);
    bf16* Y = (bf16*)(a.ws + WS_Y);
    unsigned* gdone = (unsigned*)(a.ws + WS_CTL) + 8 * l + 2;
    { int kq = 256; asm volatile("" : "+s"(kq)); pg8::Gemm g{(const bf16*)(a.ws + WS_BQD), (const bf16*)(wb + WO_QU), MROWS, 512, kq}; pg8::StaticOrder S; S.init(MROWS, 512, G, (int)blockIdx.x);
      EpiQup2 E{a.ws};
      pg8::gemm_phase<EpiQup2, pg8::StaticOrder, true, true>(lds, g, S, E); }
    { int kq = 128; asm volatile("" : "+s"(kq)); pg8::Gemm g{(const bf16*)(a.ws + WS_BKVD), (const bf16*)(wb + WO_KVU), MROWS, 512, kq}; pg8::StaticOrder S; S.init(MROWS, 512, G, (int)blockIdx.x);
      EpiKVup2 E{a.ws};
      pg8::gemm_phase<EpiKVup2, pg8::StaticOrder, true, true>(lds, g, S, E); }
    asm volatile("s_waitcnt vmcnt(0)" ::: "memory");
    __syncthreads();
    if (threadIdx.x == 0) { __builtin_amdgcn_fence(__ATOMIC_RELEASE, "agent"); asm volatile("s_waitcnt vmcnt(0)" ::: "memory"); __hip_atomic_fetch_add(gdone, 1u, __ATOMIC_RELAXED, __HIP_MEMORY_SCOPE_AGENT); }
    float kmax2A; { const float g_ = a.in[I_AKN][l * 64 + (threadIdx.x & 63)]; float mx_ = g_ * g_;
#pragma unroll
        for (int o_ = 1; o_ < 64; o_ <<= 1) mx_ = fmaxf(mx_, __shfl_xor(mx_, o_));
        kmax2A = 64.0f * mx_; }
    bool b_ready = false;
    for (;;) {
        __syncthreads();
        if (threadIdx.x == 0) misc[0] = atomicAdd(ctr, 1u);
        __syncthreads();
        int u = (int)misc[0] + ustart;
        if (u >= n_units) break;
        if (u < 64) { scan_unit(lds, a, l, u >> 2, u & 3); continue; }
        u -= 64;
        int ua = -1;
        if (u < 1024) ua = u; else if (u >= 2048 && u < 3072) ua = u - 1024;
        if (ua >= 0) { const int b = ua >> 7, kvh = (ua >> 6) & 1, qb = (ua >> 2) & 15, g = ua & 3, h = kvh * 4 + g; const size_t r0 = (size_t)b * TPB;
            attn_unit<64>(lds, QA + (r0 + qb * 256) * 512 + h * 64, 512, KA + r0 * 128 + kvh * 64, 128, VA + r0 * 128 + kvh * 64, 128, Y + (r0 + qb * 256) * DM + h * 64, DM, 34, kmax2A); continue; }
        const int n_actx = (l + 1 < DEPTH) ? 128 : 0;
        if (u >= 3072 && u < 3072 + n_actx) { const int uc = u - 3072; const int b = uc >> 3, h = uc & 7, kvh = h >> 2; const size_t r0 = (size_t)b * TPB + SEQ;
            attn_unit<64>(lds, QA + r0 * 512 + h * 64, 512, KA + r0 * 128 + kvh * 64, 128, VA + r0 * 128 + kvh * 64, 128, Y + r0 * DM + h * 64, DM, 2, kmax2A); continue; }
        if (!b_ready) {
            if (threadIdx.x == 0) { unsigned sp = 0; while (__hip_atomic_load(gdone, __ATOMIC_RELAXED, __HIP_MEMORY_SCOPE_AGENT) < (unsigned)G) { __builtin_amdgcn_s_sleep(2); if (++sp > (1u << 22)) break; }
                __builtin_amdgcn_fence(__ATOMIC_ACQUIRE, "agent"); asm volatile("s_waitcnt vmcnt(0)" ::: "memory"); }
            __syncthreads(); b_ready = true;
        }
        if (u < 2048) { const int ub = u - 1024; const int b = ub >> 6, h = (ub >> 4) & 3, qb = ub & 15; const size_t r0 = (size_t)b * TPB;
            attn_unit<96>(lds, QB + (r0 + qb * 256) * 384 + h * 96, 384, KB + r0 * 384 + h * 96, 384, VB + r0 * 256 + h * 64, 256, Y + (r0 + qb * 256) * DM + 512 + h * 64, DM, 34); continue; }
        u -= 3072 + n_actx;
        { const int b = u >> 2, h = u & 3; const size_t r0 = (size_t)b * TPB + SEQ;
            attn_unit<96>(lds, QB + r0 * 384 + h * 96, 384, KB + r0 * 384 + h * 96, 384, VB + r0 * 256 + h * 64, 256, Y + r0 * DM + 512 + h * 64, DM, 2); }
    }
}

constexpr int N_PHASES = 3 + 7 * DEPTH;
#ifndef ONLY
#define ONLY -1
#endif
#ifndef SKIP
#define SKIP -2
#endif
#define EN(id) ((ONLY < 0 || ONLY == (id)) && SKIP != (id))
__global__ void __launch_bounds__(NTHR, 2) fwd_kernel(Args a_in) {
    extern __shared__ __attribute__((aligned(16))) unsigned char lds_raw[];
    LAS unsigned char* lds = (LAS unsigned char*)lds_raw;
    const int G = gridDim.x, NGW = G * NWAVES;
    { volatile LAS unsigned* mz = (volatile LAS unsigned*)(lds + LDS_MISC); if (threadIdx.x < 64) mz[threadIdx.x] = 0u; }
    __syncthreads();
    const XcdBarrier xbar = xcd_barrier_post((unsigned*)(a_in.ws + WS_CTL) + 1024, (volatile LAS unsigned*)(lds + LDS_MISC) + 8);
    bool rep_done = false;
    if (a_in.coop) cg::this_grid().sync();
    for (int ph = a_in.ph_lo; ph < a_in.ph_hi; ++ph) {
        Args a = a_in; { unsigned long long w_ = (unsigned long long)a_in.ws; asm volatile("" : "+s"(w_)); a.ws = (unsigned char*)(__attribute__((address_space(1))) unsigned char*)w_; }
        int tid_l = threadIdx.x; asm volatile("" : "+v"(tid_l));
        const int tid = tid_l, lane = tid & 63, wave = __builtin_amdgcn_readfirstlane(tid >> 6), gw = blockIdx.x * NWAVES + wave;
        if (ph > a.ph_lo) { if (a.coop) xcd_barrier(xbar); }
#if defined(PROBE_SYNCS)
        if (ph == 3) { for (int i_ = 0; i_ < PROBE_SYNCS; ++i_) cg::this_grid().sync(); }
#endif
#if defined(PROBE_PRO)
        if (ph < 3 && !rep_done) { rep_done = true; --ph; } else if (ph < 3) rep_done = false;
#endif
        if (ph == 0) { if constexpr (EN(100)) phase0(a, lds, gw, NGW, wave, lane, tid); continue; }
        if (ph == 1) { if constexpr (EN(101)) phase_ada_reduce(a, tid); continue; }
        if (ph == 2) { if constexpr (EN(102)) rows_update(a, gw, NGW, lane, false, true, nullptr, 0, 0, false, true, a.in[I_GPREMIX], 0, 0); continue; }
        const int l = (ph - 3) / 7, s = (ph - 3) % 7;
#if defined(PROBE_REP)
        if (l == 0 && ((PROBE_REP >> s) & 1) && !rep_done) { rep_done = true; --ph; } else rep_done = false;
#endif
        unsigned char* wb = a.ws + WS_W + (size_t)l * W_LAYER;
        if (s == 0) { if constexpr (EN(0)) {
            pg8::Gemm g{(const bf16*)(a.ws + WS_HN), (const bf16*)(wb + WO_IN), MROWS, DINP, DM}; pg8::StaticOrder S; S.init(MROWS, DINP, G, (int)blockIdx.x);
            EpiFeat2 E{a.ws, a.in[I_AQN] + l * 64, a.in[I_AKN] + l * 64, a.in[I_CLB], l};
            pg8::gemm_phase<EpiFeat2, pg8::StaticOrder, true, true>(lds, g, S, E);
        } } else if (s == 1) { if constexpr (EN(1)) {
            mixer_phase(a, lds, l, wb, G);
#if defined(PROBE_MIXER2)
            if (l == 0) { cg::this_grid().sync(); mixer_phase(a, lds, l, wb, G, 4, PROBE_MIXER2); }
#endif
        } } else if (s == 2) { if constexpr (EN(2)) {
            pg8::Gemm g{(const bf16*)(a.ws + WS_Y), (const bf16*)(wb + WO_OUT), MROWS, DM, DM};
            pg8::EpiStore<0> E{(bf16*)(a.ws + WS_T), DM};
            run_gemm(lds, g, E, G, l + 1 == DEPTH);
        } } else if (s == 3) { if constexpr (EN(3)) {
            rows_update(a, gw, NGW, lane, true, l == 0, a.in[I_GPOSTMIX] + l * DM, l, 2, false, true, a.in[I_GPREFFN] + l * DM, l, 3, l + 1 == DEPTH);
        } } else if (s == 4) { if constexpr (EN(4)) {
            pg8::Gemm g{(const bf16*)(a.ws + WS_HN), (const bf16*)(wb + WO_1), MROWS, DFF, DM};
            pg8::EpiStore<1> E{(bf16*)(a.ws + WS_HB), DFF};
            if (l + 1 < DEPTH && G == 256) {
                const int c = (int)blockIdx.x;
                unsigned* pcnt = (unsigned*)(a.ws + WS_CTL) + 8192 + 1024 * l;
                { pg8::OneUnit S1{(c >> 4) * 17 + 16, c & 15}; pg8::gemm_phase<pg8::EpiStore<1>, pg8::OneUnit, true, true>(lds, g, S1, E); }
                asm volatile("s_waitcnt vmcnt(0)" ::: "memory");
                __syncthreads();
                if (tid == 0) { __builtin_amdgcn_fence(__ATOMIC_RELEASE, "agent"); asm volatile("s_waitcnt vmcnt(0)" ::: "memory"); __hip_atomic_fetch_add(pcnt + 64 * (c >> 4), 1u, __ATOMIC_RELAXED, __HIP_MEMORY_SCOPE_AGENT); }
                if (c < 64) {
                    if (tid == 0) { unsigned sp = 0; while (__hip_atomic_load(pcnt + 64 * (c >> 2), __ATOMIC_RELAXED, __HIP_MEMORY_SCOPE_AGENT) < 16u) { __builtin_amdgcn_s_sleep(2); if (++sp > (1u << 22)) break; }
                        __builtin_amdgcn_fence(__ATOMIC_ACQUIRE, "agent"); asm volatile("s_waitcnt vmcnt(0)" ::: "memory"); }
                    __syncthreads();
                    { pg8::Gemm g2{(const bf16*)(a.ws + WS_HB), (const bf16*)(wb + WO_2), MROWS, DM, DFF}; pg8::EpiStore<0> E2{(bf16*)(a.ws + WS_T2), DM};
                      pg8::OneUnit S2{(c >> 2) * 17 + 16, c & 3}; pg8::gemm_phase<pg8::EpiStore<0>, pg8::OneUnit, true, true>(lds, g2, S2, E2); }
                    { pg8::LatRange S3; S3.init(52, DFF, 64, c, 204); pg8::gemm_phase<pg8::EpiStore<1>, pg8::LatRange, true, true>(lds, g, S3, E); }
                } else {
                    pg8::LatRange S3; S3.init(204, DFF, 192, c - 64, 0); pg8::gemm_phase<pg8::EpiStore<1>, pg8::LatRange, true, true>(lds, g, S3, E);
                }
            } else run_gemm(lds, g, E, G, l + 1 == DEPTH);
        } } else if (s == 5) { if constexpr (EN(5)) {
            pg8::Gemm g{(const bf16*)(a.ws + WS_HB), (const bf16*)(wb + WO_2), MROWS, DM, DFF};
            pg8::EpiStore<0> E{(bf16*)(a.ws + WS_T2), DM};
            run_gemm(lds, g, E, G, (l + 1 == DEPTH) || G == 256);
        } } else { if constexpr (EN(6)) {
            const bool more = (l + 1 < DEPTH);
            rows_update(a, gw, NGW, lane, true, l == 0, a.in[I_GPOSTMIX] + l * DM, l, 2, true, more, a.in[I_GPREMIX] + (more ? (l + 1) : l) * DM, more ? (l + 1) : l, 0, !more, true, a.in[I_GPOSTFFN] + l * DM, 5);
        } }
    }
}

#ifndef ONE_LAUNCH
#define ONE_LAUNCH 1
#endif
extern "C" void kernel_launch(void* const* d_in, const int* in_sizes, int n_in, void* d_out, int out_size, void* d_ws, size_t ws_size, hipStream_t stream) {
    static int grid = 0;
    if (grid == 0) {
        if (n_in != 22 || ws_size < WS_END) { fprintf(stderr, "kernel_launch: expected 22 inputs and >= %zu bytes of workspace (got %d, %zu)\n", (size_t)WS_END, n_in, ws_size); grid = -1; return; }
        int dev = 0, cus = 0, per_cu = 0;
        hipGetDevice(&dev); hipDeviceGetAttribute(&cus, hipDeviceAttributeMultiprocessorCount, dev);
        hipFuncSetAttribute((const void*)fwd_kernel, hipFuncAttributeMaxDynamicSharedMemorySize, LDS_BYTES);
        hipOccupancyMaxActiveBlocksPerMultiprocessor(&per_cu, (const void*)fwd_kernel, NTHR, LDS_BYTES);
        if (per_cu < 1) per_cu = 1;
        grid = cus * 1;
        (void)hipGetLastError();
    }
    if (grid < 0) return;
    (void)hipMemsetAsync((char*)d_ws + WS_CTL, 0, 65536, stream);
    Args a{};
    for (int i = 0; i < 22; ++i) a.in[i] = (const float*)d_in[i];
    a.out = (float*)d_out; a.ws = (unsigned char*)d_ws; a.pad = 0;
#if ONE_LAUNCH
    a.ph_lo = 0; a.ph_hi = N_PHASES; a.coop = 1;
    void* args[] = {&a};
    hipError_t e = hipLaunchCooperativeKernel((const void*)fwd_kernel, dim3(grid), dim3(NTHR), args, LDS_BYTES, stream);
    if (e != hipSuccess) fprintf(stderr, "cooperative launch failed: %s (grid %d)\n", hipGetErrorString(e), grid);
#else
    for (int ph = 0; ph < N_PHASES; ++ph) { a.ph_lo = ph; a.ph_hi = ph + 1; a.coop = 0; hipLaunchKernelGGL(fwd_kernel, dim3(grid), dim3(NTHR), LDS_BYTES, stream, a); }
#endif
}
```
